# Optimizing an MI355X kernel written in HIP

```python
import jax
import jax.numpy as jnp
from jax import lax
import numpy as np

D_MODEL = 1024
BATCH = 4
SEQ = 8192
DEPTH = 2

CHUNK = 64
POOL_WIDTH = D_MODEL // 4
POOL_WINDOWS = (2, 4, 8, 16)
POOL_GROUP_DIM = POOL_WIDTH // len(POOL_WINDOWS)
CONV_WIDTH = D_MODEL // 4
CONV_KERNEL = 31
RWKV_WIDTH = D_MODEL - POOL_WIDTH - CONV_WIDTH
RWKV_HEAD_DIM = 64
RWKV_HEADS = RWKV_WIDTH // RWKV_HEAD_DIM
DECAY_RANK = 64
ICLR_RANK = 64
GATE_RANK = 128
VRES_RANK = 32
N_RWKV_COLS = 3 * RWKV_WIDTH + DECAY_RANK + ICLR_RANK + GATE_RANK
N_IN = POOL_WIDTH + 2 * CONV_WIDTH + N_RWKV_COLS
D_FF = ((8 * D_MODEL // 3 + 255) // 256) * 256
N_EXPERTS = 8
TOP_K = 2
D_FF_EXPERT = 7 * D_MODEL // 2
MOE_BLOCK = 256
N_DENSE = (DEPTH + 1) // 2
N_MOE = DEPTH // 2
RMS_EPS = 1e-6
LN_EPS = 1e-5
GN_EPS = 64e-5

kernel_name = 'hybrid_pool_conv_rwkv7_moe_block'


def rmsnorm(x, g):
    xf = x.astype(jnp.float32)
    y = xf * lax.rsqrt(jnp.mean(xf * xf, axis=-1, keepdims=True) + RMS_EPS)
    return (y * g.astype(jnp.float32)).astype(x.dtype)


def pool_mixer(u, w, scale):
    bsz, t, _ = u.shape
    uf = u.astype(jnp.float32)
    csum = jnp.pad(jnp.cumsum(uf, axis=1), ((0, 0), (1, 0), (0, 0)))
    pos = jnp.arange(1, t + 1, dtype=jnp.float32)[None, :, None]
    groups = []
    for gi, win in enumerate(POOL_WINDOWS):
        sl = slice(gi * POOL_GROUP_DIM, (gi + 1) * POOL_GROUP_DIM)
        c = csum[..., sl]
        lower = jnp.pad(c[:, : t - win + 1], ((0, 0), (win - 1, 0), (0, 0)))
        trailing_mean = (c[:, 1:] - lower) / jnp.minimum(pos, float(win))
        groups.append(trailing_mean - uf[..., sl])
    d = jnp.stack(groups, axis=2)
    y = jnp.einsum('btgc,gcd->btgd', d, w.astype(jnp.float32)).reshape(bsz, t, POOL_WIDTH)
    return (y * scale.astype(jnp.float32)).astype(u.dtype)


def conv_module(p, w, b, ln_g, ln_b):
    u = p[..., :CONV_WIDTH] * jax.nn.sigmoid(p[..., CONV_WIDTH:])
    y = lax.conv_general_dilated(u, w[:, None, :].astype(u.dtype), window_strides=(1,), padding=[(CONV_KERNEL - 1, 0)], dimension_numbers=('NWC', 'WIO', 'NWC'), feature_group_count=CONV_WIDTH)
    yf = y.astype(jnp.float32) + b.astype(jnp.float32)
    mu = jnp.mean(yf, axis=-1, keepdims=True)
    var = jnp.mean(jnp.square(yf - mu), axis=-1, keepdims=True)
    yf = (yf - mu) * lax.rsqrt(var + LN_EPS) * ln_g.astype(jnp.float32) + ln_b.astype(jnp.float32)
    return jax.nn.silu(yf).astype(p.dtype)


def rwkv7_scan(r, decay, k, v, kk, a):
    bsz, t, h, n = r.shape

    def to_chunks(z):
        return jnp.moveaxis(z, 1, 0).reshape(t // CHUNK, CHUNK, bsz, h, n)

    def frame_step(state, inp):
        r_t, w_t, k_t, v_t, kk_t, a_t = inp
        sa = jnp.einsum('bhvk,bhk->bhv', state, -kk_t)
        state = state * w_t[:, :, None, :] + sa[..., None] * (kk_t * a_t)[:, :, None, :] + v_t[..., None] * k_t[:, :, None, :]
        return state, jnp.einsum('bhvk,bhk->bhv', state, r_t)

    def chunk_step(state, chunk_inp):
        return lax.scan(frame_step, state, chunk_inp)

    s0 = jnp.zeros((bsz, h, n, n), jnp.float32)
    _, y = lax.scan(chunk_step, s0, tuple(to_chunks(z) for z in (r, decay, k, v, kk, a)))
    return jnp.moveaxis(y.reshape(t, bsz, h, n), 0, 1)


def rwkv7_mixer(c, mu, w0, w2, a0, a2, g2, k_k, k_a, r_k, gn_g, gn_b, v_first, vres):
    f32 = jnp.float32
    bsz, t, _ = c.shape
    cf = c.astype(f32)
    prev = jnp.pad(cf, ((0, 0), (1, 0), (0, 0)))[:, :-1]
    cf = cf + mu.astype(f32) * (prev - cf)
    wd = RWKV_WIDTH
    r = cf[..., :wd]
    k = cf[..., wd:2 * wd]
    v = cf[..., 2 * wd:3 * wd]
    o = 3 * wd
    xw = cf[..., o:o + DECAY_RANK]
    o += DECAY_RANK
    xa = cf[..., o:o + ICLR_RANK]
    o += ICLR_RANK
    xg = cf[..., o:o + GATE_RANK]
    w_log = -jax.nn.softplus(-(w0.astype(f32) + jnp.tanh(xw) @ w2.astype(f32))) - 0.5
    decay = jnp.exp(-jnp.exp(w_log))
    a = jax.nn.sigmoid(a0.astype(f32) + xa @ a2.astype(f32))
    g = jax.nn.sigmoid(xg) @ g2.astype(f32)
    if vres is not None:
        v0, v1, v2 = vres
        v = v + (v_first - v) * jax.nn.sigmoid(v0.astype(f32) + (v @ v1.astype(f32)) @ v2.astype(f32))

    def heads(z):
        return z.reshape(bsz, t, RWKV_HEADS, RWKV_HEAD_DIM)

    kk = heads(k * k_k.astype(f32))
    kk = kk / jnp.maximum(jnp.sqrt(jnp.sum(kk * kk, axis=-1, keepdims=True)), 1e-12)
    k = k * (1.0 + (a - 1.0) * k_a.astype(f32))
    rh, kh, vh = heads(r), heads(k), heads(v)
    y = rwkv7_scan(rh, heads(decay), kh, vh, kk, heads(a))
    ym = jnp.mean(y, axis=-1, keepdims=True)
    yv = jnp.mean(jnp.square(y - ym), axis=-1, keepdims=True)
    y = ((y - ym) * lax.rsqrt(yv + GN_EPS)).reshape(bsz, t, wd) * gn_g.astype(f32) + gn_b.astype(f32)
    y = heads(y) + jnp.sum(rh * kh * r_k.astype(f32), axis=-1, keepdims=True) * vh
    y = y.reshape(bsz, t, wd) * g
    return y.astype(c.dtype), v


def swiglu(x, w_gate, w_up, w_down):
    return (jax.nn.silu(x @ w_gate) * (x @ w_up)) @ w_down


def moe_swiglu(h, router, w_gate, w_up, w_down):
    bsz, t, d = h.shape
    n = bsz * t
    xf = h.reshape(n, d)
    logits = (xf @ router).astype(jnp.float32)
    top_val, top_idx = lax.top_k(logits, TOP_K)
    gates = jax.nn.softmax(top_val, axis=-1)
    flat_e = top_idx.reshape(-1).astype(jnp.int32)
    flat_tok = jnp.arange(n * TOP_K, dtype=jnp.int32) // TOP_K
    flat_g = gates.reshape(-1)
    order = jnp.argsort(flat_e)
    e_sorted = flat_e[order]
    tok_sorted = flat_tok[order]
    g_sorted = flat_g[order]
    counts = jnp.zeros((N_EXPERTS,), jnp.int32).at[flat_e].add(1)
    starts = jnp.cumsum(counts) - counts
    padded = (counts + MOE_BLOCK - 1) // MOE_BLOCK * MOE_BLOCK
    pad_ends = jnp.cumsum(padded)
    pad_starts = pad_ends - padded
    rank = jnp.arange(n * TOP_K, dtype=jnp.int32) - starts[e_sorted]
    dest = pad_starts[e_sorted] + rank
    n_blocks = (n * TOP_K + MOE_BLOCK - 1) // MOE_BLOCK + N_EXPERTS
    n_rows = n_blocks * MOE_BLOCK
    x_disp = jnp.zeros((n_rows, d), h.dtype).at[dest].set(xf[tok_sorted])
    block_e = jnp.minimum(jnp.searchsorted(pad_ends, jnp.arange(n_blocks, dtype=jnp.int32) * MOE_BLOCK, side='right'), N_EXPERTS - 1)

    def block_fn(args):
        xb, e = args
        return swiglu(xb, w_gate[e], w_up[e], w_down[e])

    y_disp = lax.map(block_fn, (x_disp.reshape(n_blocks, MOE_BLOCK, d), block_e)).reshape(n_rows, d)
    y = jnp.zeros((n, d), h.dtype).at[tok_sorted].add(y_disp[dest] * g_sorted[:, None].astype(h.dtype))
    return y.reshape(bsz, t, d)


def setup_inputs(seed: int = 0) -> dict:
    key = jax.random.key(seed)
    ks = iter(jax.random.split(key, 40))

    def nrm(shape, s):
        return jax.random.normal(next(ks), shape, jnp.float32) * s

    def uni(shape, lo, hi):
        return jax.random.uniform(next(ks), shape, jnp.float32, lo, hi)

    L = DEPTH
    LV = DEPTH - 1
    return {
        'x': nrm((BATCH, SEQ, D_MODEL), 1.0),
        'norm1_g': 1.0 + nrm((L, D_MODEL), 0.02),
        'w_in': nrm((L, D_MODEL, N_IN), D_MODEL ** -0.5),
        'pool_w': nrm((L, len(POOL_WINDOWS), POOL_GROUP_DIM, POOL_GROUP_DIM), POOL_GROUP_DIM ** -0.5),
        'pool_scale': 1.0 + nrm((L, POOL_WIDTH), 0.1),
        'conv_w': nrm((L, CONV_KERNEL, CONV_WIDTH), CONV_KERNEL ** -0.5),
        'conv_b': nrm((L, CONV_WIDTH), 0.02),
        'conv_ln_g': 1.0 + nrm((L, CONV_WIDTH), 0.02),
        'conv_ln_b': nrm((L, CONV_WIDTH), 0.02),
        'shift_mu': uni((L, N_RWKV_COLS), 0.0, 1.0),
        'rwkv_w0': uni((L, RWKV_WIDTH), -4.0, 0.0),
        'rwkv_w2': nrm((L, DECAY_RANK, RWKV_WIDTH), 0.5 * DECAY_RANK ** -0.5),
        'rwkv_a0': nrm((L, RWKV_WIDTH), 0.1),
        'rwkv_a2': nrm((L, ICLR_RANK, RWKV_WIDTH), 0.5 * ICLR_RANK ** -0.5),
        'rwkv_g2': nrm((L, GATE_RANK, RWKV_WIDTH), GATE_RANK ** -0.5),
        'rwkv_k_k': 0.85 + nrm((L, RWKV_WIDTH), 0.05),
        'rwkv_k_a': 1.0 + nrm((L, RWKV_WIDTH), 0.05),
        'rwkv_r_k': nrm((L, RWKV_HEADS, RWKV_HEAD_DIM), 0.1),
        'rwkv_gn_g': 1.0 + nrm((L, RWKV_WIDTH), 0.02),
        'rwkv_gn_b': nrm((L, RWKV_WIDTH), 0.02),
        'rwkv_v0': 1.0 + nrm((LV, RWKV_WIDTH), 0.1),
        'rwkv_v1': nrm((LV, RWKV_WIDTH, VRES_RANK), RWKV_WIDTH ** -0.5),
        'rwkv_v2': nrm((LV, VRES_RANK, RWKV_WIDTH), 0.5 * VRES_RANK ** -0.5),
        'w_out': nrm((L, D_MODEL, D_MODEL), D_MODEL ** -0.5),
        'norm2_g': 1.0 + nrm((L, D_MODEL), 0.02),
        'ffn_w_gate': nrm((N_DENSE, D_MODEL, D_FF), D_MODEL ** -0.5),
        'ffn_w_up': nrm((N_DENSE, D_MODEL, D_FF), D_MODEL ** -0.5),
        'ffn_w_down': nrm((N_DENSE, D_FF, D_MODEL), D_FF ** -0.5),
        'moe_router': nrm((N_MOE, D_MODEL, N_EXPERTS), D_MODEL ** -0.5),
        'moe_w_gate': nrm((N_MOE, N_EXPERTS, D_MODEL, D_FF_EXPERT), D_MODEL ** -0.5),
        'moe_w_up': nrm((N_MOE, N_EXPERTS, D_MODEL, D_FF_EXPERT), D_MODEL ** -0.5),
        'moe_w_down': nrm((N_MOE, N_EXPERTS, D_FF_EXPERT, D_MODEL), D_FF_EXPERT ** -0.5),
        'final_g': 1.0 + nrm((D_MODEL,), 0.02),
    }


def reference(x, norm1_g, w_in, pool_w, pool_scale, conv_w, conv_b, conv_ln_g, conv_ln_b, shift_mu, rwkv_w0, rwkv_w2, rwkv_a0, rwkv_a2, rwkv_g2, rwkv_k_k, rwkv_k_a, rwkv_r_k, rwkv_gn_g, rwkv_gn_b, rwkv_v0, rwkv_v1, rwkv_v2, w_out, norm2_g, ffn_w_gate, ffn_w_up, ffn_w_down, moe_router, moe_w_gate, moe_w_up, moe_w_down, final_g):
    h = x
    v_first = None
    for l in range(DEPTH):
        hn = rmsnorm(h, norm1_g[l])
        proj = hn @ w_in[l]
        p_pool = proj[..., :POOL_WIDTH]
        p_conv = proj[..., POOL_WIDTH:POOL_WIDTH + 2 * CONV_WIDTH]
        p_rwkv = proj[..., POOL_WIDTH + 2 * CONV_WIDTH:]
        y_pool = pool_mixer(p_pool, pool_w[l], pool_scale[l])
        y_conv = conv_module(p_conv, conv_w[l], conv_b[l], conv_ln_g[l], conv_ln_b[l])
        vres = None if l == 0 else (rwkv_v0[l - 1], rwkv_v1[l - 1], rwkv_v2[l - 1])
        y_rwkv, v_l = rwkv7_mixer(p_rwkv, shift_mu[l], rwkv_w0[l], rwkv_w2[l], rwkv_a0[l], rwkv_a2[l], rwkv_g2[l], rwkv_k_k[l], rwkv_k_a[l], rwkv_r_k[l], rwkv_gn_g[l], rwkv_gn_b[l], v_first, vres)
        if l == 0:
            v_first = v_l
        h = h + jnp.concatenate([y_pool, y_conv, y_rwkv], axis=-1) @ w_out[l]
        hn = rmsnorm(h, norm2_g[l])
        i = l // 2
        if l % 2 == 0:
            h = h + swiglu(hn, ffn_w_gate[i], ffn_w_up[i], ffn_w_down[i])
        else:
            h = h + moe_swiglu(hn, moe_router[i], moe_w_gate[i], moe_w_up[i], moe_w_down[i])
    return rmsnorm(h, final_g)
```

```cpp
#include <hip/hip_runtime.h>
#include <cstdio>
#include <cstdint>

#define DI __device__ __forceinline__
#define LAS __attribute__((address_space(3)))
typedef unsigned short bf16;
typedef short bf16x8 __attribute__((ext_vector_type(8)));
typedef float f32x4 __attribute__((ext_vector_type(4)));
typedef float f32x2 __attribute__((ext_vector_type(2)));
typedef unsigned u32x4 __attribute__((ext_vector_type(4)));
typedef unsigned u32x2 __attribute__((ext_vector_type(2)));
typedef __bf16 bf2_t __attribute__((ext_vector_type(2)));

#ifndef PROBE_PHASES
#define PROBE_PHASES 0x0u
#endif
#ifndef N_LAUNCH_MODE
#define N_LAUNCH_MODE 1
#endif

constexpr int BATCH = 4, T = 8192, D = 1024, M = BATCH * T;
constexpr int NIN = 2560, RW = 512, NH = 8;
constexpr int C_CONVA = 256, C_CONVB = 512, C_R = 768, C_K = 1280, C_V = 1792, C_XW = 2304, C_XA = 2368, C_XG = 2432;
constexpr int NRC = 1792;
constexpr int FF = 2816, FE = 3584, NE = 8;
constexpr int MOE_ROWS = M + NE * 256;
constexpr int MOE_TILES = MOE_ROWS / 256;
constexpr float RMS_EPS = 1e-6f, LN_EPS = 1e-5f, GN_EPS = 64e-5f;
constexpr int NWAVES = 8, NTHR = 512, GRID = 256;

DI unsigned pk2(float lo, float hi) { f32x2 v = {lo, hi}; return __builtin_bit_cast(unsigned, __builtin_convertvector(v, bf2_t)); }
DI float bflo(unsigned u) { return __uint_as_float(u << 16); }
DI float bfhi(unsigned u) { return __uint_as_float(u & 0xffff0000u); }
DI float fast_exp(float x) { return __builtin_amdgcn_exp2f(x * 1.44269504088896f); }
DI float sigmoidf_(float x) { return __builtin_amdgcn_rcpf(1.0f + fast_exp(-x)); }
DI float siluf_(float x) { return x * sigmoidf_(x); }
template <int D> DI float row_shr(float x) { return __builtin_bit_cast(float, __builtin_amdgcn_update_dpp(0, __builtin_bit_cast(int, x), 0x110 + D, 0xf, 0xf, false)); }
DI float row_scan16(float x) { x += row_shr<1>(x); x += row_shr<2>(x); x += row_shr<4>(x); x += row_shr<8>(x); return x; }
DI float wave_sum(float v) {
    v = row_scan16(v);
    const int iv = __builtin_bit_cast(int, v);
    const float a = __builtin_bit_cast(float, __builtin_amdgcn_readlane(iv, 15)), b = __builtin_bit_cast(float, __builtin_amdgcn_readlane(iv, 31));
    const float c = __builtin_bit_cast(float, __builtin_amdgcn_readlane(iv, 47)), d = __builtin_bit_cast(float, __builtin_amdgcn_readlane(iv, 63));
    return (a + b) + (c + d);
}
DI void unpack8(const u32x4 w, float (&f)[8]) { f[0] = bflo(w.x); f[1] = bfhi(w.x); f[2] = bflo(w.y); f[3] = bfhi(w.y); f[4] = bflo(w.z); f[5] = bfhi(w.z); f[6] = bflo(w.w); f[7] = bfhi(w.w); }
DI u32x4 pack8(const float (&f)[8]) { u32x4 w; w.x = pk2(f[0], f[1]); w.y = pk2(f[2], f[3]); w.z = pk2(f[4], f[5]); w.w = pk2(f[6], f[7]); return w; }
#define MFMA16(a, b, c) __builtin_amdgcn_mfma_f32_16x16x32_bf16((a), (b), (c), 0, 0, 0)
typedef int i32x8 __attribute__((ext_vector_type(8)));
typedef int i32x4 __attribute__((ext_vector_type(4)));
constexpr float F8S_X = 4.f, F8S_WGU = 64.f, F8S_H = 8.f, F8S_WDN = 128.f;
constexpr float F8_GU_INV = 1.f / (F8S_X * F8S_WGU), F8_DN_INV = 1.f / (F8S_H * F8S_WDN);
DI float f8clamp(float x) { return __builtin_amdgcn_fmed3f(x, -448.f, 448.f); }
DI unsigned pk4_f8(float a, float b, float c, float d) { int p = __builtin_amdgcn_cvt_pk_fp8_f32(f8clamp(a), f8clamp(b), 0, false); p = __builtin_amdgcn_cvt_pk_fp8_f32(f8clamp(c), f8clamp(d), p, true); return (unsigned)p; }
DI i32x8 cat8(const bf16x8 a, const bf16x8 b) { return __builtin_shufflevector(__builtin_bit_cast(i32x4, a), __builtin_bit_cast(i32x4, b), 0, 1, 2, 3, 4, 5, 6, 7); }

namespace pg8 {
constexpr int BM = 256, BK = 64, HALF = 128, HTB = HALF * BK * 2, STAGE_BYTES = 8 * HTB, NXCD = 8, WGM = 8;
DI int lds_byte(int r, int c) { const int st = (r >> 4) * 2 + (c >> 5), rr = r & 15, cc = c & 31, ob = rr * 64 + cc * 2; return st * 1024 + (ob ^ (((ob >> 9) & 1) << 5)); }
DI void stage_rc(int b, int& R, int& C) { const int st = b / 1024, sb = b % 1024, swz = sb ^ (((sb >> 9) & 1) << 5); R = (st >> 1) * 16 + swz / 64; C = (st & 1) * 32 + (swz % 64) / 2; }
DI int perm32(int rho) { const int n = rho >> 4, i = rho & 15; return 8 * (i >> 2) + 4 * n + (i & 3); }
struct Unit { int pm, pn; };
struct OrderBase {
    int nM, nN, nwg, G, c;
    DI void init(int nM_, int nN_, int G_, int c_) { nM = nM_; nN = nN_; nwg = nM * nN; G = G_; c = c_; }
    DI void map(const long L, Unit& u) const {
        int wgid = (int)L; { const int q = nwg / NXCD, r = nwg % NXCD, xcd = wgid % NXCD, off = wgid / NXCD; wgid = (xcd < r ? xcd * (q + 1) : r * (q + 1) + (xcd - r) * q) + off; }
        const int nig = WGM * nN, gid = wgid / nig, fm = gid * WGM, gsz = (nM - fm) < WGM ? (nM - fm) : WGM;
        u.pm = fm + ((wgid % nig) % gsz); u.pn = (wgid % nig) / gsz;
    }
    DI bool next(int i, Unit& u) const { const long L = (long)i * G + c; if (L >= nwg) return false; map(L, u); return true; }
};
struct DenseSched : OrderBase {
    static constexpr bool GATHER = false;
    const char* A; const char* Bt; size_t tstep;
    DI const char* a_base(const Unit& u) const { return A + (size_t)u.pm * tstep; }
    DI const char* b_base(const Unit& u) const { return Bt + (size_t)u.pn * tstep; }
    DI void a_offs(const Unit&, const int (&)[2], const int (&)[2], unsigned (&)[2][2]) const {}
};
struct MoeGuSched : OrderBase {
    static constexpr bool GATHER = true;
    const char* A; const char* Bt; const int* row_tok; const int* tile_e;
    DI const char* a_base(const Unit&) const { return A; }
    DI const char* b_base(const Unit& u) const { const int e = __builtin_amdgcn_readfirstlane(tile_e[u.pm]); return Bt + ((size_t)e * (2 * FE) + (size_t)u.pn * 256) * (size_t)D; }
    DI void a_offs(const Unit& u, const int (&R)[2], const int (&C)[2], unsigned (&o)[2][2]) const {
#pragma unroll
        for (int h = 0; h < 2; ++h)
#pragma unroll
            for (int i = 0; i < 2; ++i) { int tok = row_tok[u.pm * 256 + h * 128 + R[i]]; tok = tok < 0 ? M : tok; o[h][i] = (unsigned)tok * (unsigned)D + (unsigned)(C[i] * 2); }
    }
};
struct MoeDnSched : OrderBase {
    static constexpr bool GATHER = false;
    const char* A; const char* Bt; const int* tile_e; size_t tstep;
    DI bool next(int i, Unit& u) const { if (i >= nwg / G) return false; map((long)i * G + c, u); return true; }
    DI const char* a_base(const Unit& u) const { return A + (size_t)u.pm * tstep; }
    DI const char* b_base(const Unit& u) const { const int e = __builtin_amdgcn_readfirstlane(tile_e[u.pm]); return Bt + ((size_t)e * D + (size_t)u.pn * 256) * (size_t)FE; }
    DI void a_offs(const Unit&, const int (&)[2], const int (&)[2], unsigned (&)[2][2]) const {}
};
constexpr int DN_KSPLIT = 7, DN_KT = FE / 128 / DN_KSPLIT;
struct MoeDnLeftSched : OrderBase {
    static constexpr bool GATHER = false;
    const char* A; const char* Bt; const int* tile_e; size_t tstep;
    DI bool next(int i, Unit& u) const { const int main = (nwg / G) * G, left = nwg - main; if (i > 0 || c >= DN_KSPLIT * left) return false; map((long)main + (c / DN_KSPLIT), u); return true; }
    DI const char* a_base(const Unit& u) const { return A + (size_t)u.pm * tstep + (size_t)(c % DN_KSPLIT) * (DN_KT * 128); }
    DI const char* b_base(const Unit& u) const { const int e = __builtin_amdgcn_readfirstlane(tile_e[u.pm]); return Bt + ((size_t)e * D + (size_t)u.pn * 256) * (size_t)FE + (size_t)(c % DN_KSPLIT) * (DN_KT * 128); }
    DI void a_offs(const Unit&, const int (&)[2], const int (&)[2], unsigned (&)[2][2]) const {}
};

struct EpiBf16 {
    static constexpr bool PERM = true;
    bf16* O; int ldc;
    DI void operator()(const f32x4 (&acc)[2][2][4][2], const Unit& u, int wr, int wc, int fr, int fq) const {
        const int row0 = u.pm * BM + wr * 64 + fr, col0 = u.pn * BM + wc * 32 + 8 * fq;
#pragma unroll
        for (int ai = 0; ai < 2; ++ai)
#pragma unroll
            for (int m = 0; m < 4; ++m) { bf16* rowp = O + (size_t)(row0 + ai * HALF + m * 16) * ldc + col0;
#pragma unroll
                for (int bj = 0; bj < 2; ++bj) { const f32x4 v0 = acc[ai][bj][m][0], v1 = acc[ai][bj][m][1];
                    u32x4 w; w.x = pk2(v0[0], v0[1]); w.y = pk2(v0[2], v0[3]); w.z = pk2(v1[0], v1[1]); w.w = pk2(v1[2], v1[3]);
                    *(u32x4*)(rowp + bj * HALF) = w; } }
    }
};
struct EpiSwiglu {
    static constexpr bool PERM = true;
    bf16* O; int ldc;
    DI void operator()(const f32x4 (&acc)[2][2][4][2], const Unit& u, int wr, int wc, int fr, int fq) const {
        const int row0 = u.pm * BM + wr * 64 + fr, col0 = u.pn * HALF + wc * 32 + 8 * fq;
#pragma unroll
        for (int ai = 0; ai < 2; ++ai)
#pragma unroll
            for (int m = 0; m < 4; ++m) { bf16* rowp = O + (size_t)(row0 + ai * HALF + m * 16) * ldc + col0;
                float h[8];
#pragma unroll
                for (int n = 0; n < 2; ++n)
#pragma unroll
                    for (int j = 0; j < 4; ++j) { const float g = acc[ai][0][m][n][j], up = acc[ai][1][m][n][j]; h[n * 4 + j] = siluf_(g) * up; }
                *(u32x4*)rowp = pack8(h); }
    }
};
struct EpiSwigluF8 {
    static constexpr bool PERM = true;
    unsigned char* O; int ldc;
    DI void operator()(const f32x4 (&acc)[2][2][4][2], const Unit& u, int wr, int wc, int fr, int fq) const {
        const int row0 = u.pm * BM + wr * 64 + fr, col0 = u.pn * HALF + wc * 32 + 8 * fq;
#pragma unroll
        for (int ai = 0; ai < 2; ++ai)
#pragma unroll
            for (int m = 0; m < 4; ++m) { unsigned char* rowp = O + (size_t)(row0 + ai * HALF + m * 16) * ldc + col0;
                float h[8];
#pragma unroll
                for (int n = 0; n < 2; ++n)
#pragma unroll
                    for (int j = 0; j < 4; ++j) { const float ag = acc[ai][0][m][n][j], au = acc[ai][1][m][n][j];
                        constexpr float KK = 1.f / (F8S_H * F8_GU_INV * F8_GU_INV), LK = 13.f; static_assert(KK == 8192.f, "log2 of K");
                        h[n * 4 + j] = (ag * au) * __builtin_amdgcn_rcpf(KK + __builtin_amdgcn_exp2f(__builtin_fmaf(ag, -1.44269504088896f * F8_GU_INV, LK))); }
                u32x2 w; w.x = pk4_f8(h[0], h[1], h[2], h[3]); w.y = pk4_f8(h[4], h[5], h[6], h[7]);
                *(u32x2*)rowp = w; }
    }
};
template <bool BASE_F32> struct EpiResid {
    static constexpr bool PERM = true;
    const void* base; bf16* out; int ldc;
    DI void operator()(const f32x4 (&acc)[2][2][4][2], const Unit& u, int wr, int wc, int fr, int fq) const {
        const int row0 = u.pm * BM + wr * 64 + fr, col0 = u.pn * BM + wc * 32 + 8 * fq;
#pragma unroll
        for (int ai = 0; ai < 2; ++ai) {
            f32x4 bf[BASE_F32 ? 4 : 1][2][2]; u32x4 bb[4][2];
#pragma unroll
            for (int m = 0; m < 4; ++m) { const size_t off = (size_t)(row0 + ai * HALF + m * 16) * ldc + col0;
#pragma unroll
                for (int bj = 0; bj < 2; ++bj) { if (BASE_F32) { bf[BASE_F32 ? m : 0][bj][0] = *(const f32x4*)((const float*)base + off + bj * HALF); bf[BASE_F32 ? m : 0][bj][1] = *(const f32x4*)((const float*)base + off + bj * HALF + 4); }
                                                 else bb[m][bj] = *(const u32x4*)((const bf16*)base + off + bj * HALF); } }
            asm volatile("" ::: "memory");
#pragma unroll
            for (int m = 0; m < 4; ++m) { const size_t off = (size_t)(row0 + ai * HALF + m * 16) * ldc + col0;
#pragma unroll
                for (int bj = 0; bj < 2; ++bj) { float h[8];
                    if (BASE_F32) {
#pragma unroll
                        for (int j = 0; j < 4; ++j) { h[j] = bf[BASE_F32 ? m : 0][bj][0][j]; h[4 + j] = bf[BASE_F32 ? m : 0][bj][1][j]; } }
                    else unpack8(bb[m][bj], h);
#pragma unroll
                    for (int j = 0; j < 4; ++j) { h[j] += acc[ai][bj][m][0][j]; h[4 + j] += acc[ai][bj][m][1][j]; }
                    *(u32x4*)(out + off + bj * HALF) = pack8(h); } }
            asm volatile("" ::: "memory");
        }
    }
};
struct EpiMoeDown {
    static constexpr bool PERM = true;
    const bf16* hin; bf16* hout; const int* row_tok; const float* row_gate; float sc;
    DI void operator()(const f32x4 (&acc)[2][2][4][2], const Unit& u, int wr, int wc, int fr, int fq) const {
        const int row0 = u.pm * BM + wr * 64 + fr, col0 = u.pn * BM + wc * 32 + 8 * fq;
        int tok[2][4]; float g[2][4];
#pragma unroll
        for (int ai = 0; ai < 2; ++ai)
#pragma unroll
            for (int m = 0; m < 4; ++m) { const int r = row0 + ai * HALF + m * 16; tok[ai][m] = row_tok[r]; g[ai][m] = row_gate[r] * sc; }
#pragma unroll
        for (int ai = 0; ai < 2; ++ai) {
            u32x4 bb[4][2];
#pragma unroll
            for (int m = 0; m < 4; ++m) { const int tk = tok[ai][m]; const bf16* hp = hin + (size_t)(tk < 0 ? 0 : tk) * D + col0;
#pragma unroll
                for (int bj = 0; bj < 2; ++bj) bb[m][bj] = *(const u32x4*)(hp + bj * HALF); }
            asm volatile("" ::: "memory");
#pragma unroll
            for (int m = 0; m < 4; ++m) { const int tk = tok[ai][m]; if (tk >= 0) { bf16* hp = hout + (size_t)tk * D + col0; const float gg = g[ai][m];
#pragma unroll
                for (int bj = 0; bj < 2; ++bj) { float h[8]; unpack8(bb[m][bj], h);
#pragma unroll
                    for (int j = 0; j < 4; ++j) { h[j] += acc[ai][bj][m][0][j] * gg; h[4 + j] += acc[ai][bj][m][1][j] * gg; }
                    *(u32x4*)(hp + bj * HALF) = pack8(h); } } }
            asm volatile("" ::: "memory");
        }
    }
};

struct EpiPartTile {
    static constexpr bool PERM = true;
    float* slab;
    DI void operator()(const f32x4 (&acc)[2][2][4][2], const Unit&, int wr, int wc, int fr, int fq) const {
        float* base = slab + (size_t)(wr * 64 + fr) * 256 + wc * 32 + 8 * fq;
#pragma unroll
        for (int ai = 0; ai < 2; ++ai)
#pragma unroll
            for (int m = 0; m < 4; ++m)
#pragma unroll
                for (int bj = 0; bj < 2; ++bj) { float* p = base + (size_t)(ai * HALF + m * 16) * 256 + bj * HALF; *(f32x4*)p = acc[ai][bj][m][0]; *(f32x4*)(p + 4) = acc[ai][bj][m][1]; }
    }
};

template <class Epi, class Sched, bool ALIGN_EPI, bool SP2, bool F8 = false>
DI void gemm_phase(LAS unsigned char* lds, const int K, const Sched& S, const Epi& E, const int ktiles = 0) {
    const int tid = threadIdx.x, wid = __builtin_amdgcn_readfirstlane(tid >> 6), lane = tid & 63, wr = wid >> 2, wc = wid & 3, fr = lane & 15, fq = lane >> 4;
    const int nt = ktiles ? ktiles : K / BK;
    unsigned voffA[2], voffB[2]; int RA[2], CA[2];
#pragma unroll
    for (int i = 0; i < 2; ++i) { int R, C; stage_rc(tid * 16 + i * 8192, R, C); const int Rb = Epi::PERM ? ((R & ~31) + perm32(R & 31)) : R;
        RA[i] = R; CA[i] = C; voffA[i] = (unsigned)(R * K + C) * 2u; voffB[i] = (unsigned)(Rb * K + C) * 2u; }
    unsigned gc[2][2] = {{0u, 0u}, {0u, 0u}}, gn[2][2] = {{0u, 0u}, {0u, 0u}};
    const size_t kstep = (size_t)(BK * 2);
    const size_t hstep = (size_t)HALF * K * 2;
    const unsigned ldsw = (unsigned)wid * 1024u;
    const int aoff = lds_byte(wr * 64 + fr, fq * 8), boff = lds_byte(wc * 32 + fr, fq * 8);
#define PG8_SA(b, h) (((b) * 2 + (h)) * HTB)
#define PG8_SB(b, h) ((4 + (b) * 2 + (h)) * HTB)
#define PG8_STAGE(bufoff, gbase, voff) do { _Pragma("unroll") for (int _i = 0; _i < 2; ++_i) \
        __builtin_amdgcn_global_load_lds((const unsigned*)((const char*)(gbase) + (voff)[_i]), (LAS unsigned*)(lds + (bufoff) + ldsw + _i * 8192), 16, 0, 0); } while (0)
#define PG8_STAGE_A(bufoff, kbase, h, go) do { if constexpr (Sched::GATHER) { PG8_STAGE(bufoff, kbase, (go)[h]); } else { PG8_STAGE(bufoff, (kbase) + (h) * hstep, voffA); } } while (0)
#define PG8_LDA(dst, b, h) do { _Pragma("unroll") for (int m = 0; m < 4; ++m) { if constexpr (F8) dst##8[m] = __builtin_shufflevector(*(const LAS i32x4*)(lds + PG8_SA(b, h) + aoff + m * 2048), *(const LAS i32x4*)(lds + PG8_SA(b, h) + aoff + m * 2048 + 1024), 0, 1, 2, 3, 4, 5, 6, 7); \
        else { _Pragma("unroll") for (int k = 0; k < 2; ++k) dst[m][k] = *(const LAS bf16x8*)(lds + PG8_SA(b, h) + aoff + m * 2048 + k * 1024); } } } while (0)
#define PG8_LDB(dst, b, h) do { _Pragma("unroll") for (int n = 0; n < 2; ++n) { if constexpr (F8) dst##8[n] = __builtin_shufflevector(*(const LAS i32x4*)(lds + PG8_SB(b, h) + boff + n * 2048), *(const LAS i32x4*)(lds + PG8_SB(b, h) + boff + n * 2048 + 1024), 0, 1, 2, 3, 4, 5, 6, 7); \
        else { _Pragma("unroll") for (int k = 0; k < 2; ++k) dst[n][k] = *(const LAS bf16x8*)(lds + PG8_SB(b, h) + boff + n * 2048 + k * 1024); } } } while (0)
#define PG8_MMA(ai, bj, At, Bt) do { __builtin_amdgcn_s_setprio(1); _Pragma("unroll") for (int m = 0; m < 4; ++m) _Pragma("unroll") for (int n = 0; n < 2; ++n) { \
        if constexpr (F8) asm volatile("v_mfma_f32_16x16x128_f8f6f4 %0, %1, %2, %0" : "+v"(acc[ai][bj][m][n]) : "v"(Bt##8[n]), "v"(At##8[m])); \
        else { _Pragma("unroll") for (int k = 0; k < 2; ++k) acc[ai][bj][m][n] = __builtin_amdgcn_mfma_f32_16x16x32_bf16(Bt[n][k], At[m][k], acc[ai][bj][m][n], 0, 0, 0); } } __builtin_amdgcn_s_setprio(0); } while (0)
#define PG8_WAIT_V(n) asm volatile("s_waitcnt vmcnt(" #n ")" ::: "memory")
#define PG8_WAIT_L(n) asm volatile("s_waitcnt lgkmcnt(" #n ")" ::: "memory")
#define PG8_BAR __builtin_amdgcn_s_barrier()
#define PG8_SCHED __builtin_amdgcn_sched_barrier(0)
    Unit cur, nxt; int ui = 0;
    if (!S.next(0, cur)) return;
    f32x4 acc[2][2][4][2];
#pragma unroll
    for (int a = 0; a < 2; ++a)
#pragma unroll
        for (int b = 0; b < 2; ++b)
#pragma unroll
            for (int m = 0; m < 4; ++m)
#pragma unroll
                for (int n = 0; n < 2; ++n) acc[a][b][m][n] = (f32x4){0.f, 0.f, 0.f, 0.f};
    bf16x8 At[4][2], B0[2][2], B1[2][2];
    i32x8 At8[4], B08[2], B18[2];
    const char* cA = S.a_base(cur); const char* cB = S.b_base(cur);
    if constexpr (Sched::GATHER) { S.a_offs(cur, RA, CA, gc); asm volatile("" : "+v"(gc[0][0]), "+v"(gc[0][1]), "+v"(gc[1][0]), "+v"(gc[1][1])); }
    if constexpr (SP2) {
        PG8_STAGE(PG8_SB(0, 0), cB, voffB); PG8_STAGE(PG8_SB(0, 1), cB + hstep, voffB); PG8_STAGE_A(PG8_SA(0, 0), cA, 0, gc); PG8_STAGE_A(PG8_SA(0, 1), cA, 1, gc);
        if (wr == 1) PG8_BAR;
        PG8_WAIT_V(2); PG8_BAR;
        PG8_STAGE(PG8_SB(1, 0), cB + kstep, voffB); PG8_STAGE_A(PG8_SA(1, 0), cA + kstep, 0, gc); PG8_STAGE(PG8_SB(1, 1), cB + hstep + kstep, voffB);
        PG8_WAIT_V(6); PG8_BAR;
    } else {
        PG8_STAGE(PG8_SB(0, 0), cB, voffB); PG8_STAGE_A(PG8_SA(0, 0), cA, 0, gc); PG8_STAGE(PG8_SB(0, 1), cB + hstep, voffB); PG8_STAGE_A(PG8_SA(0, 1), cA, 1, gc);
        if (wr == 1) PG8_BAR;
        PG8_WAIT_V(4); PG8_BAR;
        PG8_STAGE(PG8_SB(1, 0), cB + kstep, voffB); PG8_STAGE_A(PG8_SA(1, 0), cA + kstep, 0, gc); PG8_STAGE(PG8_SB(1, 1), cB + hstep + kstep, voffB);
        PG8_WAIT_V(6); PG8_BAR;
    }
    for (;;) {
        const bool has_next = S.next(ui + 1, nxt);
        const char* nA = has_next ? S.a_base(nxt) : cA; const char* nB = has_next ? S.b_base(nxt) : cB;
        if constexpr (Sched::GATHER) {
            if (has_next) { S.a_offs(nxt, RA, CA, gn); asm volatile("" : "+v"(gn[0][0]), "+v"(gn[0][1]), "+v"(gn[1][0]), "+v"(gn[1][1])); }
            else { gn[0][0] = gc[0][0]; gn[0][1] = gc[0][1]; gn[1][0] = gc[1][0]; gn[1][1] = gc[1][1]; }
        }
#pragma unroll 1
        for (int t = 0; t < nt; t += 2) {
            const bool last = (t == nt - 2);
            const char* a1 = cA + (size_t)(t + 1) * kstep;
            const char* a2 = last ? nA : cA + (size_t)(t + 2) * kstep; const char* b2 = last ? nB : cB + (size_t)(t + 2) * kstep;
            const char* a3 = a2 + kstep; const char* b3 = b2 + kstep;
            unsigned g2[2][2];
            if constexpr (Sched::GATHER) {
#pragma unroll
                for (int h = 0; h < 2; ++h)
#pragma unroll
                    for (int i = 0; i < 2; ++i) g2[h][i] = last ? gn[h][i] : gc[h][i];
            }
            if constexpr (SP2) {
            PG8_LDB(B0, 0, 0); PG8_LDB(B1, 0, 1); PG8_SCHED; PG8_LDA(At, 0, 0); PG8_STAGE_A(PG8_SA(1, 1), a1, 1, gc);
            PG8_WAIT_V(8); PG8_WAIT_L(0); PG8_BAR; PG8_MMA(0, 0, At, B0); PG8_MMA(0, 1, At, B1); PG8_BAR; PG8_SCHED;
            PG8_LDA(At, 0, 1); PG8_STAGE(PG8_SB(0, 0), b2, voffB); PG8_STAGE(PG8_SB(0, 1), b2 + hstep, voffB); PG8_STAGE_A(PG8_SA(0, 0), a2, 0, g2);
            PG8_WAIT_V(8); PG8_WAIT_L(0); PG8_BAR; PG8_MMA(1, 0, At, B0); PG8_MMA(1, 1, At, B1); PG8_BAR; PG8_SCHED;
            PG8_LDB(B0, 1, 0); PG8_LDB(B1, 1, 1); PG8_SCHED; PG8_LDA(At, 1, 0); PG8_STAGE_A(PG8_SA(0, 1), a2, 1, g2);
            PG8_WAIT_V(8); PG8_WAIT_L(0); PG8_BAR; PG8_MMA(0, 0, At, B0); PG8_MMA(0, 1, At, B1); PG8_BAR; PG8_SCHED;
            PG8_LDA(At, 1, 1); PG8_STAGE(PG8_SB(1, 0), b3, voffB); PG8_STAGE(PG8_SB(1, 1), b3 + hstep, voffB); PG8_STAGE_A(PG8_SA(1, 0), a3, 0, g2);
            PG8_WAIT_V(8); PG8_WAIT_L(0); PG8_BAR; PG8_MMA(1, 0, At, B0); PG8_MMA(1, 1, At, B1); PG8_BAR; PG8_SCHED;
            } else {
            PG8_LDB(B0, 0, 0); PG8_SCHED; PG8_LDA(At, 0, 0); PG8_STAGE_A(PG8_SA(1, 1), a1, 1, gc);
            PG8_WAIT_L(8); PG8_BAR; PG8_WAIT_L(0); PG8_MMA(0, 0, At, B0); PG8_BAR; PG8_SCHED;
            PG8_LDB(B1, 0, 1); PG8_STAGE(PG8_SB(0, 0), b2, voffB);
            PG8_BAR; PG8_WAIT_L(0); PG8_MMA(0, 1, At, B1); PG8_BAR;
            PG8_LDA(At, 0, 1); PG8_STAGE_A(PG8_SA(0, 0), a2, 0, g2);
            PG8_BAR; PG8_WAIT_L(0); PG8_MMA(1, 0, At, B0); PG8_BAR; PG8_SCHED;
            PG8_STAGE(PG8_SB(0, 1), b2 + hstep, voffB);
            PG8_WAIT_V(6); PG8_BAR; PG8_MMA(1, 1, At, B1); PG8_BAR;
            PG8_LDB(B0, 1, 0); PG8_SCHED; PG8_LDA(At, 1, 0); PG8_STAGE_A(PG8_SA(0, 1), a2, 1, g2);
            PG8_WAIT_L(8); PG8_BAR; PG8_WAIT_L(0); PG8_MMA(0, 0, At, B0); PG8_BAR; PG8_SCHED;
            PG8_LDB(B1, 1, 1); PG8_STAGE(PG8_SB(1, 0), b3, voffB);
            PG8_BAR; PG8_WAIT_L(0); PG8_MMA(0, 1, At, B1); PG8_BAR;
            PG8_LDA(At, 1, 1); PG8_STAGE_A(PG8_SA(1, 0), a3, 0, g2);
            PG8_BAR; PG8_WAIT_L(0); PG8_MMA(1, 0, At, B0); PG8_BAR; PG8_SCHED;
            PG8_STAGE(PG8_SB(1, 1), b3 + hstep, voffB);
            PG8_WAIT_V(6); PG8_BAR; PG8_MMA(1, 1, At, B1); PG8_BAR;
            }
        }
        if constexpr (ALIGN_EPI) { if (wr == 0) PG8_BAR; }
        if constexpr (F8) asm volatile("s_nop 15\n\ts_nop 15" ::: "memory");
        E(acc, cur, wr, wc, fr, fq);
        if (!has_next) break;
#pragma unroll
        for (int a = 0; a < 2; ++a)
#pragma unroll
            for (int b = 0; b < 2; ++b)
#pragma unroll
                for (int m = 0; m < 4; ++m)
#pragma unroll
                    for (int n = 0; n < 2; ++n) acc[a][b][m][n] = (f32x4){0.f, 0.f, 0.f, 0.f};
        cur = nxt; cA = nA; cB = nB; ++ui;
        if constexpr (Sched::GATHER) { gc[0][0] = gn[0][0]; gc[0][1] = gn[0][1]; gc[1][0] = gn[1][0]; gc[1][1] = gn[1][1]; }
        if constexpr (ALIGN_EPI) { if (wr == 1) PG8_BAR; }
    }
    PG8_WAIT_V(0);
    if constexpr (!ALIGN_EPI) { if (wr == 0) PG8_BAR; }
    PG8_BAR;
#undef PG8_SA
#undef PG8_SB
#undef PG8_STAGE
#undef PG8_STAGE_A
#undef PG8_LDA
#undef PG8_LDB
#undef PG8_MMA
#undef PG8_WAIT_V
#undef PG8_WAIT_L
#undef PG8_BAR
#undef PG8_SCHED
}
}

constexpr size_t MiB = 1u << 20;
constexpr size_t WS_CTL = 0, CTL_ZERO_BYTES = 64 * 1024;
constexpr size_t WS_SMALL = 1 * MiB;
constexpr size_t SM_POOLT = WS_SMALL;
constexpr size_t SM_W2T = SM_POOLT + 2 * 4 * 64 * 64 * 2;
constexpr size_t SM_A2T = SM_W2T + 2 * 512 * 64 * 2;
constexpr size_t SM_G2T = SM_A2T + 2 * 512 * 64 * 2;
constexpr size_t SM_V1T = SM_G2T + 2 * 512 * 128 * 2;
constexpr size_t SM_V2T = SM_V1T + 32 * 512 * 2;
constexpr size_t SM_END = SM_V2T + 512 * 32 * 2;
constexpr size_t TB_TKE = 2 * MiB;
constexpr size_t TB_TKG = TB_TKE + 2 * M * 4;
constexpr size_t TB_CNT = TB_TKG + 2 * M * 4;
constexpr size_t TB_ROWTOK = TB_CNT + 256 * 16 * 4;
constexpr size_t TB_ROWGATE = TB_ROWTOK + 2 * MOE_ROWS * 4;
constexpr size_t TB_TILEE = TB_ROWGATE + 2 * MOE_ROWS * 4;
constexpr size_t TB_NTILES = TB_TILEE + 2 * MOE_TILES * 4;
constexpr size_t TB_END = TB_NTILES + 64;
static_assert(SM_END <= TB_TKE && TB_END <= 4 * MiB, "small region");
constexpr size_t WS_WIN = 4 * MiB;
constexpr size_t WS_WOUT = WS_WIN + (size_t)2 * NIN * D * 2;
constexpr size_t WS_WGU = WS_WOUT + (size_t)2 * D * D * 2;
constexpr size_t WS_WDN = WS_WGU + (size_t)2 * FF * D * 2;
constexpr size_t WS_WEND = WS_WDN + (size_t)D * FF * 2;
static_assert(WS_WEND <= 36 * MiB, "main weights");
constexpr size_t WS_HN = 36 * MiB;
constexpr size_t WS_MIX = 101 * MiB;
constexpr size_t WS_VF = 165 * MiB;
constexpr size_t WS_VV1 = 197 * MiB;
constexpr size_t WS_PROJ = 204 * MiB;
constexpr size_t WS_ZB = 364 * MiB, WS_Y0B = 396 * MiB, WS_PTB = 428 * MiB, WS_QB = 460 * MiB;
constexpr size_t WS_SB = 492 * MiB;
constexpr size_t WS_RKB = 524 * MiB;
constexpr size_t WS_GB = 36 * MiB;
constexpr size_t WS_VMB = 68 * MiB;
constexpr size_t WS_HID = 204 * MiB;
constexpr size_t WS_WMGU = 165 * MiB;
constexpr size_t WS_WMDN = 101 * MiB;
constexpr size_t WS_MHID = 277 * MiB;
constexpr size_t WS_PART = 221 * MiB;
constexpr size_t WS_NEED = 526 * MiB;
static_assert(WS_WMGU + (size_t)NE * 2 * FE * D <= WS_PART && WS_PART + (size_t)32 * 7 * 65536 * 4 <= WS_MHID && WS_WMDN + (size_t)NE * D * FE <= 165 * MiB && WS_MHID + (size_t)2 * MOE_ROWS * FE <= 526 * MiB && WS_RKB + (size_t)M * 8 * 4 <= 526 * MiB, "moe map");
static_assert(WS_HN + (size_t)(M + 1) * D * 2 <= WS_MIX && WS_PROJ + (size_t)M * NIN * 2 <= 364 * MiB && WS_HID + (size_t)M * FF * 2 <= 526 * MiB, "map");
constexpr int CW_LEFT = 8192;
constexpr int CW_BAR = 1024;

constexpr int LDS_BYTES = 163840 - 1024;
constexpr int MISC_OFF = LDS_BYTES - 256;

#define XB_TMO      128
#define XB_XCNT(j)  (256  + 64 * (j))
#define XB_XSUB(j)  (1280 + 64 * (j))
#define XB_XGEN(j)  (2304 + 64 * (j))
#define XB_TOP      3328
#define XB_TOPGEN   3392
#define XCD_BAR_WORDS 3456
#define XB_SPIN_CAP (1u << 22)
DI unsigned xb_ld(unsigned* p)              { return __hip_atomic_load(p, __ATOMIC_RELAXED, __HIP_MEMORY_SCOPE_AGENT); }
DI unsigned xb_add(unsigned* p, unsigned v) { return __hip_atomic_fetch_add(p, v, __ATOMIC_RELAXED, __HIP_MEMORY_SCOPE_AGENT); }
DI unsigned xb_xcc_id() { return (unsigned)__builtin_amdgcn_s_getreg((3 << 11) | 20) & 0xFu; }
#define XB_SPIN(cond, bar) do { unsigned _sp = 0; while (cond) { __builtin_amdgcn_s_sleep(1); \
    if ((++_sp & 255u) == 0u) { if (xb_ld(&(bar)[XB_TMO])) break; if (_sp > XB_SPIN_CAP) { atomicAdd(&(bar)[XB_TMO], 1u); break; } } } } while (0)
struct XcdBarrier { unsigned* bar; unsigned x; volatile LAS unsigned* st; };
DI XcdBarrier xcd_barrier_post(unsigned* bar, volatile LAS unsigned* st) {
    XcdBarrier b; b.bar = bar; b.x = xb_xcc_id(); b.st = st;
    if (threadIdx.x == 0) (void)xb_add(&bar[XB_XCNT(b.x)], 1u);
    return b;
}
DI void xcd_barrier_complete(unsigned* bar, unsigned x, unsigned& nloc, unsigned& nx) {
    const unsigned G = gridDim.x * gridDim.y * gridDim.z;
    unsigned sum, cnt, mine, sp = 0u;
    for (;;) {
        sum = 0u; cnt = 0u; mine = 0u;
#pragma unroll
        for (unsigned j = 0; j < 16; ++j) { const unsigned c = xb_ld(&bar[XB_XCNT(j)]); sum += c; cnt += (c > 0u) ? 1u : 0u; mine = (j == x) ? c : mine; }
        if (sum == G) break;
        __builtin_amdgcn_s_sleep(1);
        if ((++sp & 255u) == 0u) { if (xb_ld(&bar[XB_TMO])) break; if (sp > XB_SPIN_CAP) { atomicAdd(&bar[XB_TMO], 1u); break; } }
    }
    nloc = mine > 0u ? mine : 1u; nx = cnt > 0u ? cnt : 1u;
}
DI void xcd_barrier(const XcdBarrier& b) {
    asm volatile("s_waitcnt vmcnt(0)" ::: "memory");
    __syncthreads();
    if (threadIdx.x == 0) {
        unsigned* bar = b.bar;
        __builtin_amdgcn_s_waitcnt(0);
        unsigned nloc = b.st[0], nx = b.st[1];
        if (nloc == 0u) { xcd_barrier_complete(bar, b.x, nloc, nx); b.st[0] = nloc; b.st[1] = nx; }
        const unsigned old = xb_add(&bar[XB_XSUB(b.x)], 1u);
        const unsigned gen = old / nloc;
        if (old + 1u == (gen + 1u) * nloc) {
            __builtin_amdgcn_fence(__ATOMIC_RELEASE, "agent");
            asm volatile("s_waitcnt vmcnt(0)" ::: "memory");
            const unsigned og = xb_add(&bar[XB_TOP], 1u);
            const unsigned tg = og / nx;
            if (og + 1u == (tg + 1u) * nx) xb_add(&bar[XB_TOPGEN], 1u);
            else XB_SPIN(xb_ld(&bar[XB_TOPGEN]) == tg, bar);
            __builtin_amdgcn_fence(__ATOMIC_ACQUIRE, "agent");
            xb_add(&bar[XB_XGEN(b.x)], 1u);
            asm volatile("s_waitcnt vmcnt(0)" ::: "memory");
        } else {
            XB_SPIN(xb_ld(&bar[XB_XGEN(b.x)]) == gen, bar);
            __builtin_amdgcn_fence(__ATOMIC_ACQUIRE, "agent");
            asm volatile("s_waitcnt vmcnt(0)" ::: "memory");
        }
    }
    __syncthreads();
}

struct Args { const float* in[33]; float* out; unsigned char* ws; int ph_lo, ph_hi; };
struct Frame {
    LAS unsigned char* lds;
    int wave, wg, G;
    const struct Args* A; float* out; unsigned char* ws;
};
enum In { I_X = 0, I_N1G, I_WIN, I_POOLW, I_POOLS, I_CONVW, I_CONVB, I_CLNG, I_CLNB, I_MU, I_W0, I_W2, I_A0, I_A2, I_G2, I_KK, I_KA, I_RK, I_GNG, I_GNB, I_V0, I_V1, I_V2, I_WOUT, I_N2G,
          I_FG, I_FU, I_FD, I_ROUTER, I_MG, I_MU2, I_MD, I_FINALG };

#define LDS_WAIT() asm volatile("s_waitcnt lgkmcnt(0)" ::: "memory")
#define LDS_BAR() do { asm volatile("s_waitcnt lgkmcnt(0)" ::: "memory"); __builtin_amdgcn_s_barrier(); asm volatile("" ::: "memory"); } while (0)
#define PIN_MEM() asm volatile("" ::: "memory")
DI u32x4 ldg16(const bf16* p) { return *(const u32x4*)p; }
struct CvItem { const float* W; bf16* WT; int K, N, k0, n0, drow0; };
DI void cv_load(const CvItem& c, const int lane, f32x4 (&r)[16]) {
#pragma unroll
    for (int i = 0; i < 16; ++i) r[i] = __builtin_nontemporal_load((const f32x4*)(c.W + (size_t)(c.k0 + 4 * i + (lane >> 4)) * c.N + c.n0 + 4 * (lane & 15)));
}
DI bf16x8 cv_trfrag(const LAS unsigned char* img, const int c0, const int kb, const int lane);
template <int F8SC> DI void cv_store(const CvItem& c, const int lane, const f32x4 (&r)[16], LAS unsigned char* img) {
#pragma unroll
    for (int i = 0; i < 16; ++i) { u32x2 w; w.x = pk2(r[i][0], r[i][1]); w.y = pk2(r[i][2], r[i][3]); *(LAS u32x2*)(img + ((4 * i + (lane >> 4)) * 72 + 4 * (lane & 15)) * 2) = w; }
    LDS_WAIT(); asm volatile("" ::: "memory");
#pragma unroll
    for (int nb = 0; nb < 4; ++nb)
#pragma unroll
        for (int kh = 0; kh < 2; ++kh) { const bf16x8 v = cv_trfrag(img, 16 * nb, kh, lane);
            if constexpr (F8SC == 0) *(bf16x8*)(c.WT + (size_t)(c.drow0 + 16 * nb + (lane & 15)) * c.K + c.k0 + 32 * kh + 8 * (lane >> 4)) = v;
            else { float f[8]; unpack8(__builtin_bit_cast(u32x4, v), f); constexpr float sc = (float)F8SC; u32x2 w; w.x = pk4_f8(f[0] * sc, f[1] * sc, f[2] * sc, f[3] * sc); w.y = pk4_f8(f[4] * sc, f[5] * sc, f[6] * sc, f[7] * sc);
                *(u32x2*)((unsigned char*)c.WT + (size_t)(c.drow0 + 16 * nb + (lane & 15)) * c.K + c.k0 + 32 * kh + 8 * (lane >> 4)) = w; } }
    LDS_WAIT(); asm volatile("" ::: "memory");
}
DI CvItem cv_plain(const float* W, int K, int N, bf16* WT, int item) { const int nblk = N / 64, kb = item / nblk, nb = item % nblk; return CvItem{W, WT, K, N, 64 * kb, 64 * nb, 64 * nb}; }
DI CvItem cv_gu(const float* W, int K, int Fh, bf16* WT, int up, int item) { const int nblk = Fh / 64, kb = item / nblk, nb = item % nblk, n0 = 64 * nb; return CvItem{W, WT, K, Fh, 64 * kb, n0, 256 * (n0 / 128) + up * 128 + (n0 % 128)}; }
template <int F8SC, class Desc> DI void cv_run(const Desc& desc, const int nitems, const int first, const int stride, const int lane, LAS float* scr_) {
    if (first >= nitems) return;
    LAS unsigned char* img = (LAS unsigned char*)scr_;
    f32x4 ra[16], rb[16];
    CvItem ca = desc(first), cb = ca;
    cv_load(ca, lane, ra);
    for (int it = first; it < nitems; it += 2 * stride) {
        const bool hb = (it + stride) < nitems;
        if (hb) { cb = desc(it + stride); cv_load(cb, lane, rb); }
        PIN_MEM();
        cv_store<F8SC>(ca, lane, ra, img);
        const bool ha = (it + 2 * stride) < nitems;
        if (ha) { ca = desc(it + 2 * stride); cv_load(ca, lane, ra); }
        PIN_MEM();
        if (hb) cv_store<F8SC>(cb, lane, rb, img);
    }
}

DI void store_row_bf16(bf16* orow, int lane, const f32x4 (&y)[4]) {
    u32x2* o8 = (u32x2*)orow + lane;
#pragma unroll
    for (int j = 0; j < 4; ++j) { u32x2 w; w.x = pk2(y[j].x, y[j].y); w.y = pk2(y[j].z, y[j].w); o8[64 * j] = w; }
}
DI void store_row_f8(unsigned char* orow, int lane, const f32x4 (&y)[4]) {
    unsigned* o4 = (unsigned*)orow + lane;
#pragma unroll
    for (int j = 0; j < 4; ++j) o4[64 * j] = pk4_f8(y[j].x * F8S_X, y[j].y * F8S_X, y[j].z * F8S_X, y[j].w * F8S_X);
}
DI void norm_rows_phase(Frame& F, const float* src, const float* g, bf16* dst) {
    const int lane = (int)threadIdx.x & 63, gw = F.wg * NWAVES + F.wave, NGW = F.G * NWAVES;
    f32x4 cr[2][4], nr[2][4];
#pragma unroll
    for (int q = 0; q < 2; ++q) { const int mq = (gw + q * NGW < M) ? gw + q * NGW : gw;
#pragma unroll
        for (int j = 0; j < 4; ++j) cr[q][j] = ((const f32x4*)(src + (size_t)mq * D) + lane)[64 * j]; }
#pragma unroll 1
    for (int m = gw; m < M; m += 2 * NGW) {
#pragma unroll
        for (int q = 0; q < 2; ++q) { const int mq = (m + (2 + q) * NGW < M) ? m + (2 + q) * NGW : m;
#pragma unroll
            for (int j = 0; j < 4; ++j) nr[q][j] = ((const f32x4*)(src + (size_t)mq * D) + lane)[64 * j]; }
        float ss[2] = {0.f, 0.f};
#pragma unroll
        for (int q = 0; q < 2; ++q)
#pragma unroll
            for (int j = 0; j < 4; ++j) ss[q] += (cr[q][j].x * cr[q][j].x + cr[q][j].y * cr[q][j].y) + (cr[q][j].z * cr[q][j].z + cr[q][j].w * cr[q][j].w);
#pragma unroll
        for (int q = 0; q < 2; ++q) { const float rstd = 1.0f / sqrtf(wave_sum(ss[q]) * (1.f / D) + RMS_EPS); const int mq = m + q * NGW; f32x4 y[4];
#pragma unroll
            for (int j = 0; j < 4; ++j) y[j] = cr[q][j] * rstd * ((const f32x4*)g + lane)[64 * j];
            if (mq < M) store_row_bf16(dst + (size_t)mq * D, lane, y); }
#pragma unroll
        for (int q = 0; q < 2; ++q)
#pragma unroll
            for (int j = 0; j < 4; ++j) cr[q][j] = nr[q][j];
    }
}
template <bool OUT_F32> DI void norm_rows_phase_b(Frame& F, const bf16* src, const float* g, void* dst) {
    const int lane = (int)threadIdx.x & 63, gw = F.wg * NWAVES + F.wave, NGW = F.G * NWAVES;
    f32x4 gg[4];
#pragma unroll
    for (int j = 0; j < 4; ++j) gg[j] = ((const f32x4*)g + lane)[64 * j];
    u32x2 cr[2][4], nr[2][4];
#pragma unroll
    for (int q = 0; q < 2; ++q) { const int mq = (gw + q * NGW < M) ? gw + q * NGW : gw;
#pragma unroll
        for (int j = 0; j < 4; ++j) cr[q][j] = ((const u32x2*)(src + (size_t)mq * D) + lane)[64 * j]; }
#pragma unroll 1
    for (int m = gw; m < M; m += 2 * NGW) {
#pragma unroll
        for (int q = 0; q < 2; ++q) { const int mq = (m + (2 + q) * NGW < M) ? m + (2 + q) * NGW : m;
#pragma unroll
            for (int j = 0; j < 4; ++j) nr[q][j] = ((const u32x2*)(src + (size_t)mq * D) + lane)[64 * j]; }
        f32x4 y[2][4]; float ss[2] = {0.f, 0.f};
#pragma unroll
        for (int q = 0; q < 2; ++q)
#pragma unroll
            for (int j = 0; j < 4; ++j) { const u32x2 v = cr[q][j]; y[q][j] = (f32x4){bflo(v.x), bfhi(v.x), bflo(v.y), bfhi(v.y)}; ss[q] += (y[q][j].x * y[q][j].x + y[q][j].y * y[q][j].y) + (y[q][j].z * y[q][j].z + y[q][j].w * y[q][j].w); }
#pragma unroll
        for (int q = 0; q < 2; ++q) { const float rstd = 1.0f / sqrtf(wave_sum(ss[q]) * (1.f / D) + RMS_EPS); const int mq = m + q * NGW;
#pragma unroll
            for (int j = 0; j < 4; ++j) y[q][j] = y[q][j] * rstd * gg[j];
            if (mq < M) { if constexpr (OUT_F32) { f32x4* o = (f32x4*)((float*)dst + (size_t)mq * D) + lane;
#pragma unroll
                    for (int j = 0; j < 4; ++j) o[64 * j] = y[q][j]; }
                else store_row_bf16((bf16*)dst + (size_t)mq * D, lane, y[q]); } }
#pragma unroll
        for (int q = 0; q < 2; ++q)
#pragma unroll
            for (int j = 0; j < 4; ++j) cr[q][j] = nr[q][j];
    }
}
template <int JOB> DI void convert_main(Frame& F, const int first, const int stride, LAS float* scr) {
    unsigned char* ws = F.ws; const Args* A = F.A;
    constexpr int I_IN = (D / 64) * (NIN / 64), I_OUT = (D / 64) * (D / 64), I_GU = (D / 64) * (FF / 64), I_DN = (FF / 64) * (D / 64);
    if (JOB == 0) {
        auto desc = [=](int it) -> CvItem { return cv_plain(A->in[I_WIN], D, NIN, (bf16*)(ws + WS_WIN), it); };
        cv_run<0>(desc, I_IN, first, stride, ((int)threadIdx.x & 63), scr);
    } else {
        constexpr int NITEMS = I_IN + 2 * I_OUT + 2 * I_GU + I_DN;
        auto desc = [=](int it) -> CvItem {
            int r = it;
            if (r < I_IN) return cv_plain(A->in[I_WIN] + (size_t)D * NIN, D, NIN, (bf16*)(ws + WS_WIN) + (size_t)NIN * D, r); r -= I_IN;
            if (r < 2 * I_OUT) { const int l = r / I_OUT; return cv_plain(A->in[I_WOUT] + (size_t)l * D * D, D, D, (bf16*)(ws + WS_WOUT) + (size_t)l * D * D, r % I_OUT); } r -= 2 * I_OUT;
            if (r < I_GU) return cv_gu(A->in[I_FG], D, FF, (bf16*)(ws + WS_WGU), 0, r); r -= I_GU;
            if (r < I_GU) return cv_gu(A->in[I_FU], D, FF, (bf16*)(ws + WS_WGU), 1, r); r -= I_GU;
            return cv_plain(A->in[I_FD], FF, D, (bf16*)(ws + WS_WDN), r);
        };
        cv_run<0>(desc, NITEMS, first, stride, ((int)threadIdx.x & 63), scr);
    }
}
DI void p0_prologue(Frame& F) {
    LAS float* scr = (LAS float*)(F.lds + F.wave * 16384);
    const int gw = F.wg * NWAVES + F.wave, NGW = F.G * NWAVES;
    unsigned char* ws = F.ws;
    convert_main<0>(F, gw, NGW, scr);
    const int gt = F.wg * NTHR + ((int)threadIdx.x), NGT = F.G * NTHR;
    for (int i = gt; i < 2 * 4 * 64 * 64; i += NGT) { const int c = i & 63, n = (i >> 6) & 63, lg = i >> 12; ((bf16*)(ws + SM_POOLT))[i] = (bf16)(pk2(F.A->in[I_POOLW][(size_t)lg * 4096 + c * 64 + n], 0.f) & 0xffffu); }
    for (int i = gt; i < 2 * 512 * 64; i += NGT) { const int j = i & 63, n = (i >> 6) & 511, l = i >> 15;
        ((bf16*)(ws + SM_W2T))[i] = (bf16)(pk2(F.A->in[I_W2][(size_t)l * 64 * 512 + j * 512 + n], 0.f) & 0xffffu);
        ((bf16*)(ws + SM_A2T))[i] = (bf16)(pk2(F.A->in[I_A2][(size_t)l * 64 * 512 + j * 512 + n], 0.f) & 0xffffu); }
    for (int i = gt; i < 2 * 512 * 128; i += NGT) { const int j = i & 127, n = (i >> 7) & 511, l = i >> 16; ((bf16*)(ws + SM_G2T))[i] = (bf16)(pk2(F.A->in[I_G2][(size_t)l * 128 * 512 + j * 512 + n], 0.f) & 0xffffu); }
    for (int i = gt; i < 32 * 512; i += NGT) { const int c = i & 511, r = i >> 9; ((bf16*)(ws + SM_V1T))[i] = (bf16)(pk2(F.A->in[I_V1][(size_t)c * 32 + r], 0.f) & 0xffffu); }
    for (int i = gt; i < 512 * 32; i += NGT) { const int r = i & 31, n = i >> 5; ((bf16*)(ws + SM_V2T))[i] = (bf16)(pk2(F.A->in[I_V2][(size_t)r * 512 + n], 0.f) & 0xffffu); }
}
template <int JOB> DI void moe_weight_convert(Frame& F, const int first, const int stride, LAS float* scr) {
    constexpr int I_G = (D / 64) * (FE / 64), I_D = (FE / 64) * (D / 64);
    const Args* A = F.A; unsigned char* ws = F.ws;
    if (JOB == 0) {
        auto desc = [=](int it) -> CvItem {
            const int e = it / (2 * I_G); int r = it % (2 * I_G);
            bf16* gu = (bf16*)(ws + WS_WMGU + (size_t)e * 2 * FE * D);
            if (r < I_G) return cv_gu(A->in[I_MG] + (size_t)e * D * FE, D, FE, gu, 0, r);
            return cv_gu(A->in[I_MU2] + (size_t)e * D * FE, D, FE, gu, 1, r - I_G);
        };
        cv_run<(int)F8S_WGU>(desc, NE * 2 * I_G, first, stride, ((int)threadIdx.x & 63), scr);
    } else {
        auto desc = [=](int it) -> CvItem { const int e = it / I_D, r = it % I_D; return cv_plain(A->in[I_MD] + (size_t)e * FE * D, FE, D, (bf16*)(ws + WS_WMDN + (size_t)e * D * FE), r); };
        cv_run<(int)F8S_WDN>(desc, NE * I_D, first, stride, ((int)threadIdx.x & 63), scr);
    }
}

DI void mixc_unit(Frame& F, const int l, const int tile) {
    int tid_ = ((int)threadIdx.x); asm volatile("" : "+v"(tid_));
    const int tid = tid_, lane = tid & 63, wave = __builtin_amdgcn_readfirstlane(tid >> 6);
    const int row0 = tile * 64, tseq = row0 & (T - 1);
    const bf16* proj = (const bf16*)(F.ws + WS_PROJ);
    bf16* mix = (bf16*)(F.ws + WS_MIX);
    u32x4 pv[5]; bool pok[5];
#pragma unroll
    for (int k = 0; k < 5; ++k) { const int idx = tid + k * NTHR, r = idx >> 5, cc = idx & 31; pok[k] = (idx < 79 * 32) && (tseq - 15 + r >= 0); pv[k] = ldg16(proj + (size_t)(pok[k] ? row0 - 15 + r : row0) * NIN + cc * 8); }
    u32x4 ca[6], cb[6]; bool cok[6];
#pragma unroll
    for (int k = 0; k < 6; ++k) { const int idx = tid + k * NTHR, r = idx >> 5, cc = idx & 31; cok[k] = (idx < 94 * 32) && (tseq - 30 + r >= 0); const bf16* p = proj + (size_t)(cok[k] ? row0 - 30 + r : row0) * NIN + cc * 8;
        ca[k] = ldg16(p + C_CONVA); cb[k] = ldg16(p + C_CONVB); }
    const int cch = tid & 255, half = tid >> 8; const float* cw = F.A->in[I_CONVW] + (size_t)l * 31 * 256 + cch; float w[31];
#pragma unroll
    for (int j = 0; j < 31; ++j) w[j] = cw[j * 256];
    const float bias = F.A->in[I_CONVB][l * 256 + cch];
    bf16x8 pfr[4][2]; f32x4 psc[4];
    { const bf16* PT = (const bf16*)(F.ws + SM_POOLT) + (size_t)(l * 4 + (wave >> 1)) * 4096; const float* sc = F.A->in[I_POOLS] + l * 256 + (wave >> 1) * 64;
#pragma unroll
      for (int nt = 0; nt < 4; ++nt) { psc[nt] = *(const f32x4*)(sc + nt * 16 + 4 * (lane >> 4));
#pragma unroll
          for (int ks = 0; ks < 2; ++ks) pfr[nt][ks] = *(const bf16x8*)(PT + (nt * 16 + (lane & 15)) * 64 + ks * 32 + (lane >> 4) * 8); } }
    PIN_MEM();
    LAS bf16* PU = (LAS bf16*)F.lds; LAS bf16* DM = (LAS bf16*)(F.lds + 79 * 264 * 2 + 16);
#pragma unroll
    for (int k = 0; k < 5; ++k) { const int idx = tid + k * NTHR, r = idx >> 5, cc = idx & 31; if (idx < 79 * 32) *(LAS u32x4*)(PU + r * 264 + cc * 8) = pok[k] ? pv[k] : (u32x4){0u, 0u, 0u, 0u}; }
    LDS_BAR();
    {
        const int g = wave >> 1, win = 2 << g, cc = g * 8 + (lane & 7);
#pragma unroll
        for (int it = 0; it < 4; ++it) { const int t = (wave & 1) * 32 + it * 8 + (lane >> 3); const int pos = tseq + t; const int cnt = (pos + 1 < win) ? pos + 1 : win;
            float s[8], u[8];
#pragma unroll
            for (int k = 0; k < 8; ++k) s[k] = 0.f;
            unpack8(*(const LAS u32x4*)(PU + (15 + t) * 264 + cc * 8), u);
            for (int j = 0; j < win; ++j) { float x[8]; unpack8(*(const LAS u32x4*)(PU + (15 + t - j) * 264 + cc * 8), x);
#pragma unroll
                for (int k = 0; k < 8; ++k) s[k] += x[k]; }
            const float inv = 1.0f / (float)cnt;
#pragma unroll
            for (int k = 0; k < 8; ++k) s[k] = s[k] * inv - u[k];
            *(LAS u32x4*)(DM + t * 264 + cc * 8) = pack8(s); }
    }
    LDS_BAR();
    {
        const int g = wave >> 1;
#pragma unroll
        for (int tt2 = 0; tt2 < 2; ++tt2) { const int tt = (wave & 1) * 2 + tt2;
            bf16x8 bfr[2];
#pragma unroll
            for (int ks = 0; ks < 2; ++ks) bfr[ks] = *(const LAS bf16x8*)(DM + (tt * 16 + (lane & 15)) * 264 + g * 64 + ks * 32 + (lane >> 4) * 8);
#pragma unroll
            for (int nt = 0; nt < 4; ++nt) { f32x4 acc = (f32x4){0.f, 0.f, 0.f, 0.f};
#pragma unroll
                for (int ks = 0; ks < 2; ++ks) acc = MFMA16(pfr[nt][ks], bfr[ks], acc);
                const int t = tt * 16 + (lane & 15), col = g * 64 + nt * 16 + 4 * (lane >> 4); const f32x4 s4 = psc[nt];
                u32x2 wv; wv.x = pk2(acc[0] * s4[0], acc[1] * s4[1]); wv.y = pk2(acc[2] * s4[2], acc[3] * s4[3]);
                *(u32x2*)(mix + (size_t)(row0 + t) * D + col) = wv; } }
    }
    LDS_BAR();
    LAS float* U = (LAS float*)F.lds;
#pragma unroll
    for (int k = 0; k < 6; ++k) { const int idx = tid + k * NTHR, r = idx >> 5, cc = idx & 31; float u[8], a[8], b[8]; unpack8(ca[k], a); unpack8(cb[k], b);
#pragma unroll
        for (int e = 0; e < 8; ++e) u[e] = cok[k] ? a[e] * sigmoidf_(b[e]) : 0.f;
        if (idx < 94 * 32) { *(LAS f32x4*)(U + r * 256 + cc * 8) = (f32x4){u[0], u[1], u[2], u[3]}; *(LAS f32x4*)(U + r * 256 + cc * 8 + 4) = (f32x4){u[4], u[5], u[6], u[7]}; } }
    u32x4 vc[8], vp[8];
    if (l == 1) {
#pragma unroll
        for (int k = 0; k < 8; ++k) { const int idx = tid + k * NTHR, t = idx >> 6, cc = idx & 63; const bf16* p = proj + (size_t)(row0 + t) * NIN + C_V + cc * 8; vc[k] = ldg16(p); vp[k] = ldg16(p - ((tseq + t > 0) ? NIN : 0)); }
        PIN_MEM();
    }
    LDS_BAR();
    {
        float y[32];
#pragma unroll
        for (int i = 0; i < 32; ++i) y[i] = bias;
#pragma unroll
        for (int r = 0; r < 62; ++r) { const float val = U[(half * 32 + r) * 256 + cch];
#pragma unroll
            for (int i = 0; i < 32; ++i) { const int j = r - i; if (j >= 0 && j <= 30) y[i] += w[j] * val; } }
        LDS_BAR();
#pragma unroll
        for (int i = 0; i < 32; ++i) U[(half * 32 + i) * 256 + cch] = y[i];
    }
    LDS_BAR();
    {
        const f32x4 lg = *(const f32x4*)(F.A->in[I_CLNG] + l * 256 + lane * 4), lb = *(const f32x4*)(F.A->in[I_CLNB] + l * 256 + lane * 4);
#pragma unroll 2
        for (int i = 0; i < 8; ++i) { const int t = wave * 8 + i; const f32x4 v = *(const LAS f32x4*)(U + t * 256 + lane * 4);
            const float mu = wave_sum((v.x + v.y) + (v.z + v.w)) * (1.f / 256.f); const f32x4 d = v - mu;
            const float var = wave_sum((d.x * d.x + d.y * d.y) + (d.z * d.z + d.w * d.w)) * (1.f / 256.f); const float rstd = 1.0f / sqrtf(var + LN_EPS);
            f32x4 o = d * rstd * lg + lb; u32x2 wv; wv.x = pk2(siluf_(o.x), siluf_(o.y)); wv.y = pk2(siluf_(o.z), siluf_(o.w));
            *(u32x2*)(mix + (size_t)(row0 + t) * D + 256 + lane * 4) = wv; }
    }
    if (l == 1) {
        LDS_BAR();
        LAS bf16* VS = (LAS bf16*)F.lds;
        const float* mu = F.A->in[I_MU] + l * NRC + (C_V - C_R);
#pragma unroll
        for (int k = 0; k < 8; ++k) { const int idx = tid + k * NTHR, t = idx >> 6, cc = idx & 63; float c8[8], p8[8]; unpack8(vc[k], c8); unpack8(vp[k], p8); const bool hp = (tseq + t) > 0;
            const f32x4 m0 = *(const f32x4*)(mu + cc * 8), m1 = *(const f32x4*)(mu + cc * 8 + 4);
#pragma unroll
            for (int e = 0; e < 8; ++e) c8[e] = c8[e] + (e < 4 ? m0[e & 3] : m1[e & 3]) * ((hp ? p8[e] : 0.f) - c8[e]);
            *(LAS u32x4*)(VS + t * 520 + cc * 8) = pack8(c8); }
        LDS_BAR();
        const int tt = wave & 3, rt = wave >> 2; const bf16* V1T = (const bf16*)(F.ws + SM_V1T); f32x4 acc = (f32x4){0.f, 0.f, 0.f, 0.f};
#pragma unroll 4
        for (int ks = 0; ks < 16; ++ks) { const bf16x8 a = *(const bf16x8*)(V1T + (rt * 16 + (lane & 15)) * 512 + ks * 32 + (lane >> 4) * 8);
            const bf16x8 b = *(const LAS bf16x8*)(VS + (tt * 16 + (lane & 15)) * 520 + ks * 32 + (lane >> 4) * 8); acc = MFMA16(a, b, acc); }
        *(f32x4*)((float*)(F.ws + WS_VV1) + (size_t)(row0 + tt * 16 + (lane & 15)) * 32 + rt * 16 + 4 * (lane >> 4)) = acc;
    }
    asm volatile("s_waitcnt vmcnt(0)" ::: "memory");
    LDS_BAR();
}

constexpr int S1_XW = 0, S1_XA = 9216, S1_XG = 18432, S1_XV = 35840;
constexpr int S1_AAB = 40960, S1_AAK = S1_AAB + 9216, S1_ARB = S1_AAK + 9216, S1_ARK = S1_ARB + 9216, S1_MT = S1_ARK + 9216, S1_XT = S1_MT + 9216, S1_TII = S1_XT + 9216;
constexpr int S1_RT = S1_TII + 3072, S1_AT = S1_RT + 9216, S1_BT = S1_AT + 9216, S1_KT = S1_BT + 9216, S1_VN = S1_KT + 9216;
constexpr int S1_WTOT = S1_VN + 9216, S1_NRM = S1_WTOT + 1024, S1_RKX = S1_NRM + 2048, S1_LC = S1_RKX + 2048, S1_MU = S1_LC + 256, S1_END = S1_MU + NRC * 4;
static_assert(S1_XV + 5120 <= S1_AAB && S1_END <= MISC_OFF, "S1 lds map");
#define LD_F8(ptr) (*(const LAS bf16x8*)(ptr))
typedef short s16x4 __attribute__((ext_vector_type(4)));
DI bf16x8 mk8(unsigned a, unsigned b, unsigned c, unsigned d) { u32x4 w = {a, b, c, d}; return __builtin_bit_cast(bf16x8, w); }
DI u32x2 pk4f(const f32x4 v) { u32x2 p; p.x = pk2(v[0], v[1]); p.y = pk2(v[2], v[3]); return p; }
DI f32x4 up4(const u32x2 v) { return (f32x4){bflo(v.x), bfhi(v.x), bflo(v.y), bfhi(v.y)}; }
DI bf16x8 mk8h(const u32x2 p) { return mk8(p.x, p.y, 0u, 0u); }
DI u32x2 tr_read(const LAS unsigned char* p) { return __builtin_bit_cast(u32x2, __builtin_amdgcn_ds_read_tr16_b64_v4i16((LAS s16x4*)p)); }
DI const LAS unsigned char* tr_addr(const LAS unsigned char* img, const int r0, const int c0, const int lane) { return img + ((r0 + ((lane & 15) >> 2)) * 72 + c0 + 4 * (lane & 3)) * 2; }
DI bf16x8 tr_frag(const LAS unsigned char* img, const int c0, const int kb, const int lane) {
    const int r0 = 32 * kb + 8 * (lane >> 4);
    const u32x2 lo = tr_read(tr_addr(img, r0, c0, lane)), hi = tr_read(tr_addr(img, r0 + 4, c0, lane));
    return mk8(lo.x, lo.y, hi.x, hi.y);
}
DI bf16x8 cv_trfrag(const LAS unsigned char* img, const int c0, const int kb, const int lane) { return tr_frag(img, c0, kb, lane); }
DI void shift8(const u32x4 cur, const u32x4 prev, const bool hasprev, const LAS unsigned char* L, const int col, float (&o)[8]) {
    float c8[8], p8[8]; unpack8(cur, c8); unpack8(prev, p8);
    const f32x4 m0 = *(const LAS f32x4*)(L + S1_MU + (col - C_R) * 4), m1 = *(const LAS f32x4*)(L + S1_MU + (col - C_R + 4) * 4);
#pragma unroll
    for (int k = 0; k < 8; ++k) o[k] = c8[k] + (k < 4 ? m0[k & 3] : m1[k & 3]) * ((hasprev ? p8[k] : 0.f) - c8[k]);
}
DI f32x4 shift4(const u32x2 cur, const u32x2 prev, const bool hasprev, const LAS unsigned char* L, const int col) {
    const f32x4 c = up4(cur), p = hasprev ? up4(prev) : (f32x4){0.f, 0.f, 0.f, 0.f}, m = *(const LAS f32x4*)(L + S1_MU + (col - C_R) * 4);
    return c + m * (p - c);
}
DI void s1_stage_mu(Frame& F, const int l) {
    for (int i = ((int)threadIdx.x); i < NRC / 4; i += NTHR) *(LAS f32x4*)(F.lds + S1_MU + i * 16) = *(const f32x4*)(F.A->in[I_MU] + l * NRC + i * 4);
    LDS_BAR();
}
DI void s1_chunk_prep(Frame& F, const int l, const int gchunk) {
    int tid_ = ((int)threadIdx.x); asm volatile("" : "+v"(tid_));
    const int t = tid_ >> 3, n8 = tid_ & 7, row0 = gchunk * 64;
    const bool hasprev = ((row0 & (T - 1)) + t) > 0;
    const bf16* prow = (const bf16*)(F.ws + WS_PROJ) + (size_t)(row0 + t) * NIN; const bf16* pprev = prow - (hasprev ? NIN : 0);
    LAS unsigned char* L = F.lds;
    const u32x4 cxw = ldg16(prow + C_XW + n8 * 8), pxw = ldg16(pprev + C_XW + n8 * 8), cxa = ldg16(prow + C_XA + n8 * 8), pxa = ldg16(pprev + C_XA + n8 * 8);
    const u32x4 cg0 = ldg16(prow + C_XG + n8 * 16), pg0 = ldg16(pprev + C_XG + n8 * 16), cg1 = ldg16(prow + C_XG + n8 * 16 + 8), pg1 = ldg16(pprev + C_XG + n8 * 16 + 8);
    f32x4 vv1 = (f32x4){0.f, 0.f, 0.f, 0.f}; if (l == 1) vv1 = *(const f32x4*)((const float*)(F.ws + WS_VV1) + (size_t)(row0 + t) * 32 + n8 * 4);
    PIN_MEM();
    float x[8];
    shift8(cxw, pxw, hasprev, L, C_XW + n8 * 8, x);
#pragma unroll
    for (int k = 0; k < 8; ++k) { const float e = fast_exp(2.0f * x[k]); x[k] = 1.0f - 2.0f * __builtin_amdgcn_rcpf(e + 1.0f); }
    *(LAS u32x4*)(L + S1_XW + (t * 72 + n8 * 8) * 2) = pack8(x);
    shift8(cxa, pxa, hasprev, L, C_XA + n8 * 8, x);
    *(LAS u32x4*)(L + S1_XA + (t * 72 + n8 * 8) * 2) = pack8(x);
    shift8(cg0, pg0, hasprev, L, C_XG + n8 * 16, x);
#pragma unroll
    for (int k = 0; k < 8; ++k) x[k] = sigmoidf_(x[k]);
    *(LAS u32x4*)(L + S1_XG + (t * 136 + n8 * 16) * 2) = pack8(x);
    shift8(cg1, pg1, hasprev, L, C_XG + n8 * 16 + 8, x);
#pragma unroll
    for (int k = 0; k < 8; ++k) x[k] = sigmoidf_(x[k]);
    *(LAS u32x4*)(L + S1_XG + (t * 136 + n8 * 16 + 8) * 2) = pack8(x);
    if (l == 1) *(LAS u32x2*)(L + S1_XV + (t * 40 + n8 * 4) * 2) = pk4f(vv1);
    LDS_BAR();
}
struct S1Pre { u32x2 cr[2], pr[2], ck[2], pk[2], cv[2], pv[2], vf[2]; };
DI void s1_issue(Frame& F, const int l, const int gchunk, const int h, S1Pre& P) {
    int tid_ = ((int)threadIdx.x); asm volatile("" : "+v"(tid_));
    const int lane = tid_ & 63, wave = tid_ >> 6, t = 16 * (wave & 3) + (lane & 15), row0 = gchunk * 64;
    const bool hasprev = ((row0 & (T - 1)) + t) > 0;
    const bf16* prow = (const bf16*)(F.ws + WS_PROJ) + (size_t)(row0 + t) * NIN; const bf16* pprev = prow - (hasprev ? NIN : 0);
#pragma unroll
    for (int nn = 0; nn < 2; ++nn) { const int c = h * 64 + (2 * (wave >> 2) + nn) * 16 + 4 * (lane >> 4);
        P.cr[nn] = *(const u32x2*)(prow + C_R + c); P.pr[nn] = *(const u32x2*)(pprev + C_R + c); P.ck[nn] = *(const u32x2*)(prow + C_K + c); P.pk[nn] = *(const u32x2*)(pprev + C_K + c);
        P.cv[nn] = *(const u32x2*)(prow + C_V + c); P.pv[nn] = *(const u32x2*)(pprev + C_V + c);
        P.vf[nn] = (l == 1) ? *(const u32x2*)((const bf16*)(F.ws + WS_VF) + (size_t)(row0 + t) * RW + c) : P.cv[nn]; }
    PIN_MEM();
}

DI void s1_unit(Frame& F, const int l, const int gchunk, const int h, const S1Pre& pre, const int hn, S1Pre& nxt) {
    int tid_ = ((int)threadIdx.x); asm volatile("" : "+v"(tid_));
    const int tid = tid_, lane = tid & 63, wave = __builtin_amdgcn_readfirstlane(tid >> 6), fr = lane & 15, fq = lane >> 4;
    const int row0 = gchunk * 64, tseq0 = row0 & (T - 1), unit = gchunk * 8 + h;
    const int tt = wave & 3, nh = wave >> 2, t = 16 * tt + fr;
    const bool hasprev = (tseq0 + t) > 0;
    LAS unsigned char* L = F.lds;
    bf16x8 fw[2][2], fa[2][2], fg[2][4], fv[2];
    f32x4 cw0[2], ca0[2], ckk[2], cka[2], crk[2], cv0[2];
    {
        const bf16* W2T = (const bf16*)(F.ws + SM_W2T) + (size_t)(l * 512 + h * 64) * 64; const bf16* A2T = (const bf16*)(F.ws + SM_A2T) + (size_t)(l * 512 + h * 64) * 64;
        const bf16* G2T = (const bf16*)(F.ws + SM_G2T) + (size_t)(l * 512 + h * 64) * 128; const bf16* V2T = (const bf16*)(F.ws + SM_V2T) + (size_t)(h * 64) * 32;
#pragma unroll
        for (int nn = 0; nn < 2; ++nn) { const int nr = (nh * 2 + nn) * 16 + fr, hc = h * 64 + (nh * 2 + nn) * 16 + 4 * fq;
#pragma unroll
            for (int ks = 0; ks < 2; ++ks) { fw[nn][ks] = *(const bf16x8*)(W2T + nr * 64 + ks * 32 + fq * 8); fa[nn][ks] = *(const bf16x8*)(A2T + nr * 64 + ks * 32 + fq * 8); }
#pragma unroll
            for (int ks = 0; ks < 4; ++ks) fg[nn][ks] = *(const bf16x8*)(G2T + nr * 128 + ks * 32 + fq * 8);
            fv[nn] = (l == 1) ? *(const bf16x8*)(V2T + nr * 32 + fq * 8) : fw[nn][0];
            cw0[nn] = *(const f32x4*)(F.A->in[I_W0] + l * RW + hc); ca0[nn] = *(const f32x4*)(F.A->in[I_A0] + l * RW + hc); ckk[nn] = *(const f32x4*)(F.A->in[I_KK] + l * RW + hc);
            cka[nn] = *(const f32x4*)(F.A->in[I_KA] + l * RW + hc); crk[nn] = *(const f32x4*)(F.A->in[I_RK] + l * RW + hc); cv0[nn] = (l == 1) ? *(const f32x4*)(F.A->in[I_V0] + hc) : cw0[nn]; }
    }
    PIN_MEM();
    f32x4 lw[2], cs[2], av[2], kk[2], km[2], vm[2], r4[2], k4[2], v4[2];
    float nrm = 0.f, rk = 0.f;
#pragma unroll
    for (int nn = 0; nn < 2; ++nn) { const int c0 = h * 64 + (nh * 2 + nn) * 16 + 4 * fq;
        r4[nn] = shift4(pre.cr[nn], pre.pr[nn], hasprev, L, C_R + c0); k4[nn] = shift4(pre.ck[nn], pre.pk[nn], hasprev, L, C_K + c0); v4[nn] = shift4(pre.cv[nn], pre.pv[nn], hasprev, L, C_V + c0); }
#pragma unroll
    for (int nn = 0; nn < 2; ++nn) { const int nt = nh * 2 + nn; f32x4 aw = (f32x4){0.f, 0.f, 0.f, 0.f}, aa = aw, ag = aw, ap = aw;
#pragma unroll
        for (int ks = 0; ks < 2; ++ks) { const int ko = ks * 32 + fq * 8;
            aw = MFMA16(fw[nn][ks], LD_F8(L + S1_XW + (t * 72 + ko) * 2), aw);
            aa = MFMA16(fa[nn][ks], LD_F8(L + S1_XA + (t * 72 + ko) * 2), aa); }
#pragma unroll
        for (int ks = 0; ks < 4; ++ks) ag = MFMA16(fg[nn][ks], LD_F8(L + S1_XG + (t * 136 + ks * 32 + fq * 8) * 2), ag);
        if (l == 1) ap = MFMA16(fv[nn], LD_F8(L + S1_XV + (t * 40 + fq * 8) * 2), ap);
        *(u32x2*)((bf16*)(F.ws + WS_GB) + (size_t)(row0 + t) * RW + h * 64 + nt * 16 + 4 * fq) = pk4f(ag);
        const int c0 = h * 64 + nt * 16 + 4 * fq;
        const f32x4 vf4 = up4(pre.vf[nn]);
#pragma unroll
        for (int j = 0; j < 4; ++j) {
            const float x = -(cw0[nn][j] + aw[j]);
            const float sp = fmaxf(x, 0.f) + __logf(1.0f + __expf(-fabsf(x)));
            lw[nn][j] = -__expf(-sp - 0.5f);
            av[nn][j] = __builtin_amdgcn_rcpf(1.0f + __expf(-(ca0[nn][j] + aa[j])));
            kk[nn][j] = k4[nn][j] * ckk[nn][j]; nrm += kk[nn][j] * kk[nn][j];
            km[nn][j] = k4[nn][j] * (1.0f + (av[nn][j] - 1.0f) * cka[nn][j]);
            rk += r4[nn][j] * km[nn][j] * crk[nn][j];
            vm[nn][j] = (l == 1) ? v4[nn][j] + (vf4[j] - v4[nn][j]) * __builtin_amdgcn_rcpf(1.0f + __expf(-(cv0[nn][j] + ap[j]))) : v4[nn][j];
        }
        cs[nn] = lw[nn];
        *(u32x2*)((bf16*)(F.ws + (l == 0 ? WS_VF : WS_VMB)) + (size_t)(row0 + t) * RW + c0) = pk4f(vm[nn]);
    }
    *(LAS float*)(L + S1_NRM + (t * 8 + nh * 4 + fq) * 4) = nrm; *(LAS float*)(L + S1_RKX + (t * 8 + nh * 4 + fq) * 4) = rk;
#pragma unroll
    for (int nn = 0; nn < 2; ++nn)
#pragma unroll
        for (int j = 0; j < 4; ++j) cs[nn][j] = row_scan16(cs[nn][j]);
    if (fr == 15) {
#pragma unroll
        for (int nn = 0; nn < 2; ++nn) *(LAS f32x4*)(L + S1_WTOT + (tt * 64 + (nh * 2 + nn) * 16 + 4 * fq) * 4) = cs[nn]; }
    LDS_BAR();
    {
        const f32x4 na = *(const LAS f32x4*)(L + S1_NRM + t * 32), nb = *(const LAS f32x4*)(L + S1_NRM + t * 32 + 16);
        const float n2 = ((na[0] + na[1]) + (na[2] + na[3])) + ((nb[0] + nb[1]) + (nb[2] + nb[3]));
        const float inv = __builtin_amdgcn_rsqf(fmaxf(n2, 1e-24f));
        if (nh == 0 && fq == 0) { const f32x4 ra = *(const LAS f32x4*)(L + S1_RKX + t * 32), rb = *(const LAS f32x4*)(L + S1_RKX + t * 32 + 16); ((float*)(F.ws + WS_RKB))[(size_t)(row0 + t) * 8 + h] = ((ra[0] + ra[1]) + (ra[2] + ra[3])) + ((rb[0] + rb[1]) + (rb[2] + rb[3])); }
#pragma unroll
        for (int nn = 0; nn < 2; ++nn) { const int nc = (nh * 2 + nn) * 16 + 4 * fq;
            f32x4 off = (f32x4){0.f, 0.f, 0.f, 0.f}, tot = off;
#pragma unroll
            for (int w = 0; w < 4; ++w) { const f32x4 x = *(const LAS f32x4*)(L + S1_WTOT + (w * 64 + nc) * 4); tot = tot + x; if (w < tt) off = off + x; }
            f32x4 rt, kt, at, bt;
#pragma unroll
            for (int j = 0; j < 4; ++j) { const float Lc = cs[nn][j] + off[j];
                const float eL = __expf(Lc), eN = __expf(-Lc), eP = __expf(Lc - lw[nn][j]); const float kkn = kk[nn][j] * inv;
                rt[j] = r4[nn][j] * eL; kt[j] = km[nn][j] * eN; at[j] = -kkn * eP; bt[j] = kkn * av[nn][j] * eN; }
            if (tt == 0 && fr == 0) *(LAS f32x4*)(L + S1_LC + nc * 4) = tot;
            const int on = (t * 72 + nc) * 2;
            *(LAS u32x2*)(L + S1_RT + on) = pk4f(rt); *(LAS u32x2*)(L + S1_AT + on) = pk4f(at); *(LAS u32x2*)(L + S1_BT + on) = pk4f(bt); *(LAS u32x2*)(L + S1_KT + on) = pk4f(kt); *(LAS u32x2*)(L + S1_VN + on) = pk4f(vm[nn]); }
    }
    LDS_BAR();
    f32x4 rhs[4];
    {
        const int mi = wave >> 1, par = wave & 1;
        const int xo = (mi < 2) ? S1_AT : S1_RT, yo = (mi & 1) ? S1_KT : S1_BT, dst = S1_AAB + mi * 9216;
        int idx = 0;
#pragma unroll
        for (int ti = 0; ti < 4; ++ti)
#pragma unroll
            for (int si = 0; si < 4; ++si, ++idx) {
                if ((idx & 1) != par) continue;
                u32x2 w = {0u, 0u};
                if (si <= ti) {
                    f32x4 acc = (f32x4){0.f, 0.f, 0.f, 0.f};
#pragma unroll
                    for (int ks = 0; ks < 2; ++ks) acc = MFMA16(LD_F8(L + yo + ((si * 16 + fr) * 72 + ks * 32 + fq * 8) * 2), LD_F8(L + xo + ((ti * 16 + fr) * 72 + ks * 32 + fq * 8) * 2), acc);
                    if (si == ti) {
#pragma unroll
                        for (int j = 0; j < 4; ++j) { const int sl = 4 * fq + j; const bool keep = (mi < 2) ? (sl < fr) : (sl <= fr); acc[j] = keep ? acc[j] : 0.f; }
                    }
                    w = pk4f(acc);
                }
                *(LAS u32x2*)(L + dst + ((ti * 16 + fr) * 72 + si * 16 + 4 * fq) * 2) = w;
            }
    }
    if (wave < 4) {
        const f32x4 z4 = (f32x4){0.f, 0.f, 0.f, 0.f};
        f32x4 va = z4, ua = z4;
#pragma unroll
        for (int ks = 0; ks < 2; ++ks) { const bf16x8 fA = LD_F8(L + S1_AT + ((wave * 16 + fr) * 72 + ks * 32 + fq * 8) * 2), fB = LD_F8(L + S1_BT + ((wave * 16 + fr) * 72 + ks * 32 + fq * 8) * 2);
            va = MFMA16(fB, fA, va); ua = MFMA16(fA, fB, ua); }
#pragma unroll
        for (int j = 0; j < 4; ++j) { va[j] = (4 * fq + j < fr) ? va[j] : 0.f; ua[j] = (fr < 4 * fq + j) ? ua[j] : 0.f; }
        const u32x2 v0 = pk4f(va), u0 = pk4f(ua);
        f32x4 w1 = up4(v0);
#pragma unroll
        for (int j = 0; j < 4; ++j) w1[j] += (4 * fq + j == fr) ? 1.0f : 0.0f;
        const u32x2 w1p = pk4f(w1);
        const u32x2 u1 = pk4f(MFMA16(mk8h(v0), mk8h(u0), z4)), v1 = pk4f(MFMA16(mk8h(u0), mk8h(v0), z4));
        const f32x4 w2 = MFMA16(mk8h(u1), mk8h(w1p), w1); const u32x2 w2p = pk4f(w2);
        const u32x2 u2 = pk4f(MFMA16(mk8h(v1), mk8h(u1), z4)), v2 = pk4f(MFMA16(mk8h(u1), mk8h(v1), z4));
        const f32x4 w3 = MFMA16(mk8h(u2), mk8h(w2p), w2); const u32x2 w3p = pk4f(w3);
        const u32x2 u3 = pk4f(MFMA16(mk8h(v2), mk8h(u2), z4));
        const f32x4 w4 = MFMA16(mk8h(u3), mk8h(w3p), w3);
        *(LAS u32x2*)(L + S1_TII + ((wave * 16 + fr) * 24 + 4 * fq) * 2) = pk4f(w4);
#pragma unroll
        for (int i = 0; i < 4; ++i) rhs[i] = up4(tr_read(tr_addr(L + S1_AT, 16 * i + 4 * fq, wave * 16, lane)));
    }
    s1_issue(F, l, gchunk, hn, nxt);
    LDS_BAR();
    {
        if (wave >= 4) {
            bf16x8 vfr2[2];
#pragma unroll
            for (int ks = 0; ks < 2; ++ks) vfr2[ks] = tr_frag(L + S1_VN, (wave - 4) * 16, ks, lane);
#pragma unroll
            for (int i = 0; i < 4; ++i) { f32x4 acc = (f32x4){0.f, 0.f, 0.f, 0.f};
#pragma unroll
                for (int ks = 0; ks < 2; ++ks) acc = MFMA16(LD_F8(L + S1_AAK + ((i * 16 + fr) * 72 + ks * 32 + fq * 8) * 2), vfr2[ks], acc);
                rhs[i] = acc; }
        }
        const f32x4 z4 = (f32x4){0.f, 0.f, 0.f, 0.f};
        u32x2 sp[4];
#define TII_FRAG(i) mk8h(*(const LAS u32x2*)(L + S1_TII + (((i) * 16 + fr) * 24 + 4 * fq) * 2))
#define AAB_P(i, j0) (*(const LAS u32x2*)(L + S1_AAB + (((i) * 16 + fr) * 72 + (j0) * 16 + 4 * fq) * 2))
        const u32x2 z2 = {0u, 0u};
        sp[0] = pk4f(MFMA16(TII_FRAG(0), mk8h(pk4f(rhs[0])), z4));
        { const u32x2 a = AAB_P(1, 0); const f32x4 a1 = MFMA16(mk8(a.x, a.y, 0u, 0u), mk8h(sp[0]), rhs[1]); sp[1] = pk4f(MFMA16(TII_FRAG(1), mk8h(pk4f(a1)), z4)); }
        { const u32x2 a = AAB_P(2, 0), b = AAB_P(2, 1); const f32x4 a2 = MFMA16(mk8(a.x, a.y, b.x, b.y), mk8(sp[0].x, sp[0].y, sp[1].x, sp[1].y), rhs[2]); sp[2] = pk4f(MFMA16(TII_FRAG(2), mk8h(pk4f(a2)), z4)); }
        { const u32x2 a = AAB_P(3, 0), b = AAB_P(3, 1), c = AAB_P(3, 2); f32x4 a3 = MFMA16(mk8(a.x, a.y, b.x, b.y), mk8(sp[0].x, sp[0].y, sp[1].x, sp[1].y), rhs[3]);
          a3 = MFMA16(mk8(c.x, c.y, 0u, 0u), mk8h(sp[2]), a3); sp[3] = pk4f(MFMA16(TII_FRAG(3), mk8h(pk4f(a3)), z4)); }
        (void)z2;
#undef TII_FRAG
#undef AAB_P
        const int dsto = (wave < 4) ? (S1_MT + ((wave * 16 + fr) * 72) * 2) : (S1_XT + (((wave - 4) * 16 + fr) * 72) * 2);
#pragma unroll
        for (int i = 0; i < 4; ++i) *(LAS u32x2*)(L + dsto + (16 * i + 4 * fq) * 2) = sp[i];
    }
    LDS_BAR();
    {
        bf16* ZB = (bf16*)(F.ws + WS_ZB) + (size_t)unit * 4096; bf16* Y0B = (bf16*)(F.ws + WS_Y0B) + (size_t)unit * 4096;
        bf16* PTB = (bf16*)(F.ws + WS_PTB) + (size_t)unit * 4096; bf16* QB = (bf16*)(F.ws + WS_QB) + (size_t)unit * 4096;
        const int ta = wave >> 1;
        const int ra = ((ta * 16 + fr) * 72 + fq * 8) * 2;
        bf16x8 fmt[2], fxt[2], fvn[2], fbt[2], fkt[2];
#pragma unroll
        for (int ks = 0; ks < 2; ++ks) { fmt[ks] = LD_F8(L + S1_MT + ra + ks * 64); fxt[ks] = LD_F8(L + S1_XT + ra + ks * 64); fvn[ks] = tr_frag(L + S1_VN, ta * 16, ks, lane); fbt[ks] = tr_frag(L + S1_BT, ta * 16, ks, lane); fkt[ks] = tr_frag(L + S1_KT, ta * 16, ks, lane); }
        const f32x4 lc = *(const LAS f32x4*)(L + S1_LC + (ta * 16 + 4 * fq) * 4);
#pragma unroll
        for (int ii = 0; ii < 2; ++ii) { const int tb = (wave & 1) * 2 + ii;
            const int rb = ((tb * 16 + fr) * 72 + fq * 8) * 2;
            const int so = (tb * 16 + fr) * 64 + 16 * fq + 4 * ta;
            bf16x8 frb[2], frk[2], fbc[2], fxc[2], fvc[2];
#pragma unroll
            for (int ks = 0; ks < 2; ++ks) { frb[ks] = LD_F8(L + S1_ARB + rb + ks * 64); frk[ks] = LD_F8(L + S1_ARK + rb + ks * 64); fbc[ks] = tr_frag(L + S1_BT, tb * 16, ks, lane); fxc[ks] = LD_F8(L + S1_XT + rb + ks * 64); fvc[ks] = tr_frag(L + S1_VN, tb * 16, ks, lane); }
            {
                f32x4 acc = (f32x4){0.f, 0.f, 0.f, 0.f};
#pragma unroll
                for (int ks = 0; ks < 2; ++ks) acc = MFMA16(fmt[ks], frb[ks], acc);
                acc = acc + up4(*(const LAS u32x2*)(L + S1_RT + ((tb * 16 + fr) * 72 + ta * 16 + 4 * fq) * 2));
                *(u32x2*)(ZB + so) = pk4f(acc); }
            {
                f32x4 acc = (f32x4){0.f, 0.f, 0.f, 0.f};
#pragma unroll
                for (int ks = 0; ks < 2; ++ks) { acc = MFMA16(fxt[ks], frb[ks], acc); acc = MFMA16(fvn[ks], frk[ks], acc); }
                *(u32x2*)(Y0B + so) = pk4f(acc); }
            {
                f32x4 acc = (f32x4){0.f, 0.f, 0.f, 0.f};
#pragma unroll
                for (int ks = 0; ks < 2; ++ks) acc = MFMA16(fmt[ks], fbc[ks], acc);
                const float dn = __expf(*(const LAS float*)(L + S1_LC + (tb * 16 + fr) * 4));
#pragma unroll
                for (int j = 0; j < 4; ++j) acc[j] = (acc[j] + ((ta == tb && 4 * fq + j == fr) ? 1.0f : 0.0f)) * dn;
                *(u32x2*)(PTB + (tb * 16 + fr) * 64 + 32 * (ta >> 1) + 8 * fq + 4 * (ta & 1)) = pk4f(acc); }
            {
                f32x4 acc = (f32x4){0.f, 0.f, 0.f, 0.f};
#pragma unroll
                for (int ks = 0; ks < 2; ++ks) { acc = MFMA16(fbt[ks], fxc[ks], acc); acc = MFMA16(fkt[ks], fvc[ks], acc); }
#pragma unroll
                for (int j = 0; j < 4; ++j) acc[j] *= __expf(lc[j]);
                *(u32x2*)(QB + so) = pk4f(acc); }
        }
    }
}
struct S2Buf { bf16x8 pa[4][2]; u32x4 q0, q1; };
DI void s2_load(S2Buf& B, const bf16* PT, const bf16* Q, const int fr, const int fq, const int vs) {
#pragma unroll
    for (int io = 0; io < 4; ++io)
#pragma unroll
        for (int kb = 0; kb < 2; ++kb) B.pa[io][kb] = *(const bf16x8*)(PT + (16 * io + fr) * 64 + 32 * kb + 8 * fq);
    B.q0 = *(const u32x4*)(Q + (16 * vs + fr) * 64 + 16 * fq); B.q1 = *(const u32x4*)(Q + (16 * vs + fr) * 64 + 16 * fq + 8);
    PIN_MEM();
}
DI void s2_step(const S2Buf& B, f32x4 (&acc)[4], bf16* SBu, const int fr, const int fq, const int vs) {
    u32x4 bw[2];
#pragma unroll
    for (int kb = 0; kb < 2; ++kb) { bw[kb].x = pk2(acc[2 * kb][0], acc[2 * kb][1]); bw[kb].y = pk2(acc[2 * kb][2], acc[2 * kb][3]); bw[kb].z = pk2(acc[2 * kb + 1][0], acc[2 * kb + 1][1]); bw[kb].w = pk2(acc[2 * kb + 1][2], acc[2 * kb + 1][3]);
        *(u32x4*)(SBu + (16 * vs + fr) * 64 + 16 * fq + 8 * kb) = bw[kb]; }
    const unsigned qw[8] = {B.q0.x, B.q0.y, B.q0.z, B.q0.w, B.q1.x, B.q1.y, B.q1.z, B.q1.w};
#pragma unroll
    for (int io = 0; io < 4; ++io) { f32x4 c = (f32x4){bflo(qw[2 * io]), bfhi(qw[2 * io]), bflo(qw[2 * io + 1]), bfhi(qw[2 * io + 1])};
#pragma unroll
        for (int kb = 0; kb < 2; ++kb) c = MFMA16(B.pa[io][kb], __builtin_bit_cast(bf16x8, bw[kb]), c);
        acc[io] = c; }
    PIN_MEM();
}
DI void s2_phase(Frame& F, const int l) {
    if (F.wg >= 128 || F.wave != 0) {
        const int widx = (F.wg < 128) ? F.wg * 7 + (F.wave - 1) : 896 + (F.wg - 128) * 8 + F.wave;
        LAS float* scr = (LAS float*)(F.lds + F.wave * 16384);
        if (l == 0) convert_main<1>(F, widx, 1920, scr); else moe_weight_convert<0>(F, widx, 1920, scr);
        return;
    }
    const int seq = F.wg >> 2, vs = F.wg & 3, b = seq >> 3, h = seq & 7, fr = ((int)threadIdx.x & 63) & 15, fq = ((int)threadIdx.x & 63) >> 4;
    const bf16* PTB = (const bf16*)(F.ws + WS_PTB); const bf16* QB = (const bf16*)(F.ws + WS_QB); bf16* SB = (bf16*)(F.ws + WS_SB);
    f32x4 acc[4];
#pragma unroll
    for (int i = 0; i < 4; ++i) acc[i] = (f32x4){0.f, 0.f, 0.f, 0.f};
    const size_t u0 = ((size_t)b * 128 * 8 + h) * 4096;
    S2Buf B0, B1, B2, B3;
    s2_load(B0, PTB + u0, QB + u0, fr, fq, vs); s2_load(B1, PTB + u0 + 32768, QB + u0 + 32768, fr, fq, vs); s2_load(B2, PTB + u0 + 2 * 32768, QB + u0 + 2 * 32768, fr, fq, vs);
#pragma unroll 1
    for (int c = 0; c < 128; c += 4) {
        const size_t uc = u0 + (size_t)c * 32768;
        const size_t un = (c + 4 < 128) ? uc + 4 * 32768 : uc;
        s2_load(B3, PTB + uc + 3 * 32768, QB + uc + 3 * 32768, fr, fq, vs);
        s2_step(B0, acc, SB + uc, fr, fq, vs);
        s2_load(B0, PTB + un, QB + un, fr, fq, vs);
        s2_step(B1, acc, SB + uc + 32768, fr, fq, vs);
        s2_load(B1, PTB + un + 32768, QB + un + 32768, fr, fq, vs);
        s2_step(B2, acc, SB + uc + 2 * 32768, fr, fq, vs);
        s2_load(B2, PTB + un + 2 * 32768, QB + un + 2 * 32768, fr, fq, vs);
        s2_step(B3, acc, SB + uc + 3 * 32768, fr, fq, vs);
    }
}
DI void s3_phase(Frame& F, const int l) {
    const int fr = ((int)threadIdx.x & 63) & 15, fq = ((int)threadIdx.x & 63) >> 4;
    const bf16* VM = (const bf16*)(F.ws + (l == 0 ? WS_VF : WS_VMB)); const bf16* GB = (const bf16*)(F.ws + WS_GB); const float* RKB = (const float*)(F.ws + WS_RKB);
    bf16* mix = (bf16*)(F.ws + WS_MIX);
    for (int u = F.wg * NWAVES + F.wave; u < (M / 64) * NH; u += F.G * NWAVES) {
        const int gchunk = u >> 3, h = u & 7, row0 = gchunk * 64;
        const bf16* SBu = (const bf16*)(F.ws + WS_SB) + (size_t)u * 4096; const bf16* ZBu = (const bf16*)(F.ws + WS_ZB) + (size_t)u * 4096; const bf16* Y0u = (const bf16*)(F.ws + WS_Y0B) + (size_t)u * 4096;
        bf16x8 sa[4][2], zf[4][2]; u32x4 y0a[4], y0b[4]; float rkv[4];
#pragma unroll
        for (int vt = 0; vt < 4; ++vt)
#pragma unroll
            for (int kb = 0; kb < 2; ++kb) sa[vt][kb] = *(const bf16x8*)(SBu + (16 * vt + fr) * 64 + 16 * fq + 8 * kb);
#pragma unroll
        for (int tt = 0; tt < 4; ++tt) { const int t = 16 * tt + fr; zf[tt][0] = *(const bf16x8*)(ZBu + t * 64 + 16 * fq); zf[tt][1] = *(const bf16x8*)(ZBu + t * 64 + 16 * fq + 8);
            y0a[tt] = *(const u32x4*)(Y0u + t * 64 + 16 * fq); y0b[tt] = *(const u32x4*)(Y0u + t * 64 + 16 * fq + 8); rkv[tt] = RKB[(size_t)(row0 + t) * 8 + h]; }
        f32x4 gg[4], gb[4];
#pragma unroll
        for (int vt = 0; vt < 4; ++vt) { gg[vt] = *(const f32x4*)(F.A->in[I_GNG] + l * RW + h * 64 + 16 * vt + 4 * fq); gb[vt] = *(const f32x4*)(F.A->in[I_GNB] + l * RW + h * 64 + 16 * vt + 4 * fq); }
        PIN_MEM();
#pragma unroll
        for (int tt = 0; tt < 4; ++tt) {
            const int t = 16 * tt + fr;
            u32x2 vmr[4], ggr[4];
#pragma unroll
            for (int vt = 0; vt < 4; ++vt) { const size_t o = (size_t)(row0 + t) * RW + h * 64 + 16 * vt + 4 * fq; vmr[vt] = *(const u32x2*)(VM + o); ggr[vt] = *(const u32x2*)(GB + o); }
            const unsigned yw[8] = {y0a[tt].x, y0a[tt].y, y0a[tt].z, y0a[tt].w, y0b[tt].x, y0b[tt].y, y0b[tt].z, y0b[tt].w};
            f32x4 y[4]; float s = 0.f;
#pragma unroll
            for (int vt = 0; vt < 4; ++vt) { f32x4 c = (f32x4){bflo(yw[2 * vt]), bfhi(yw[2 * vt]), bflo(yw[2 * vt + 1]), bfhi(yw[2 * vt + 1])};
                c = MFMA16(sa[vt][0], zf[tt][0], c); c = MFMA16(sa[vt][1], zf[tt][1], c); y[vt] = c; s += (c[0] + c[1]) + (c[2] + c[3]); }
            s += __shfl_xor(s, 16); s += __shfl_xor(s, 32);
            const float mean = s * (1.f / 64.f); float q = 0.f;
#pragma unroll
            for (int vt = 0; vt < 4; ++vt) { y[vt] = y[vt] - mean; q += (y[vt][0] * y[vt][0] + y[vt][1] * y[vt][1]) + (y[vt][2] * y[vt][2] + y[vt][3] * y[vt][3]); }
            q += __shfl_xor(q, 16); q += __shfl_xor(q, 32);
            const float rstd = 1.0f / sqrtf(q * (1.f / 64.f) + GN_EPS);
            const float rk = rkv[tt];
#pragma unroll
            for (int vt = 0; vt < 4; ++vt) {
                const f32x4 vv = (f32x4){bflo(vmr[vt].x), bfhi(vmr[vt].x), bflo(vmr[vt].y), bfhi(vmr[vt].y)}, gv = (f32x4){bflo(ggr[vt].x), bfhi(ggr[vt].x), bflo(ggr[vt].y), bfhi(ggr[vt].y)};
                const f32x4 ov = (y[vt] * rstd * gg[vt] + gb[vt] + vv * rk) * gv;
                u32x2 w; w.x = pk2(ov[0], ov[1]); w.y = pk2(ov[2], ov[3]);
                *(u32x2*)(mix + (size_t)(row0 + t) * D + 512 + h * 64 + 16 * vt + 4 * fq) = w; }
        }
    }
}

DI void norm2_router_phase(Frame& F, const bf16* hsrc, const float* g, const float* router) {
    LAS float* RT = (LAS float*)F.lds;
    LAS int* E01 = (LAS int*)(F.lds + 131072);
    for (int i = ((int)threadIdx.x); i < 2048; i += NTHR) { const int col = i >> 1, half = i & 1; *(LAS f32x4*)(RT + ((((col >> 8) * 4 + (col & 3)) * 2 + half) * 64 + ((col & 255) >> 2)) * 4) = *(const f32x4*)(router + i * 4); }
    __syncthreads();
    unsigned char* hn = F.ws + WS_HN;
    int* tke = (int*)(F.ws + TB_TKE); float* tkg = (float*)(F.ws + TB_TKG);
    const int lane = (int)threadIdx.x & 63, mb = F.wg * 128 + F.wave * 16;
    f32x4 gg[4];
#pragma unroll
    for (int j = 0; j < 4; ++j) gg[j] = ((const f32x4*)g + lane)[64 * j];
    u32x2 cr[2][4], nr[2][4];
#pragma unroll
    for (int q = 0; q < 2; ++q)
#pragma unroll
        for (int j = 0; j < 4; ++j) cr[q][j] = ((const u32x2*)(hsrc + (size_t)(mb + q) * D) + lane)[64 * j];
#pragma unroll 1
    for (int i = 0; i < 16; i += 2) {
        const int in = (i + 2 < 16) ? i + 2 : i;
#pragma unroll
        for (int q = 0; q < 2; ++q)
#pragma unroll
            for (int j = 0; j < 4; ++j) nr[q][j] = ((const u32x2*)(hsrc + (size_t)(mb + in + q) * D) + lane)[64 * j];
        f32x4 y[2][4]; float ss[2] = {0.f, 0.f};
#pragma unroll
        for (int q = 0; q < 2; ++q)
#pragma unroll
            for (int j = 0; j < 4; ++j) { const u32x2 v = cr[q][j]; y[q][j] = (f32x4){bflo(v.x), bfhi(v.x), bflo(v.y), bfhi(v.y)}; ss[q] += (y[q][j].x * y[q][j].x + y[q][j].y * y[q][j].y) + (y[q][j].z * y[q][j].z + y[q][j].w * y[q][j].w); }
#pragma unroll
        for (int q = 0; q < 2; ++q) { const float rstd = 1.0f / sqrtf(wave_sum(ss[q]) * (1.f / D) + RMS_EPS);
#pragma unroll
            for (int j = 0; j < 4; ++j) y[q][j] = y[q][j] * rstd * gg[j];
            store_row_f8(hn + (size_t)(mb + i + q) * D, lane, y[q]); }
        float lg[2][8];
#pragma unroll
        for (int q = 0; q < 2; ++q)
#pragma unroll
            for (int e = 0; e < 8; ++e) lg[q][e] = 0.f;
#pragma unroll
        for (int j = 0; j < 4; ++j)
#pragma unroll
            for (int k = 0; k < 4; ++k) { const LAS f32x4* rp = (const LAS f32x4*)RT + (j * 4 + k) * 128 + lane; const f32x4 r0 = rp[0], r1 = rp[64];
#pragma unroll
                for (int q = 0; q < 2; ++q) { const float x = y[q][j][k];
                    lg[q][0] += x * r0[0]; lg[q][1] += x * r0[1]; lg[q][2] += x * r0[2]; lg[q][3] += x * r0[3]; lg[q][4] += x * r1[0]; lg[q][5] += x * r1[1]; lg[q][6] += x * r1[2]; lg[q][7] += x * r1[3]; } }
#pragma unroll
        for (int q = 0; q < 2; ++q)
#pragma unroll
            for (int e = 0; e < 8; ++e) lg[q][e] = wave_sum(lg[q][e]);
        if (lane == 0) {
#pragma unroll
            for (int q = 0; q < 2; ++q) { const int lt = F.wave * 16 + i + q, m = mb + i + q;
                int e0 = 0; float v0 = lg[q][0];
#pragma unroll
                for (int e = 1; e < 8; ++e) if (lg[q][e] > v0) { v0 = lg[q][e]; e0 = e; }
                int e1 = -1; float v1 = -3.0e38f;
#pragma unroll
                for (int e = 0; e < 8; ++e) if (e != e0 && lg[q][e] > v1) { v1 = lg[q][e]; e1 = e; }
                const float g0 = 1.0f / (1.0f + __expf(v1 - v0));
                tke[m] = e0; tke[M + m] = e1; tkg[m] = g0; tkg[M + m] = 1.0f - g0;
                E01[lt] = e0; E01[128 + lt] = e1; }
        }
#pragma unroll
        for (int q = 0; q < 2; ++q)
#pragma unroll
            for (int j = 0; j < 4; ++j) cr[q][j] = nr[q][j];
    }
    if (F.wg == 0) for (int i = ((int)threadIdx.x); i < D / 4; i += NTHR) ((unsigned*)(hn + (size_t)M * D))[i] = 0u;
    __syncthreads();
    if (((int)threadIdx.x) < 16) { const int s = ((int)threadIdx.x) >> 3, e = ((int)threadIdx.x) & 7; int c = 0; for (int i = 0; i < 128; ++i) c += (E01[s * 128 + i] == e) ? 1 : 0; ((int*)(F.ws + TB_CNT))[F.wg * 16 + ((int)threadIdx.x)] = c; }
}
DI void moe_dispatch_phase(Frame& F) {
    LAS int* C = (LAS int*)F.lds;
    LAS int* TOT = C + 4096; LAS int* MINE = TOT + 16; LAS int* START = MINE + 16; LAS int* PAD = START + 16; LAS int* EL = PAD + 16;
    const int* cnt = (const int*)(F.ws + TB_CNT);
    { const int k = ((int)threadIdx.x) & 15, part = ((int)threadIdx.x) >> 4; int tot = 0, mine = 0;
#pragma unroll
      for (int j = 0; j < 8; ++j) { const int w = part * 8 + j, c = cnt[w * 16 + k]; tot += c; mine += (w < F.wg) ? c : 0; }
      C[part * 16 + k] = tot; C[512 + part * 16 + k] = mine; }
    __syncthreads();
    if (((int)threadIdx.x) < 16) { int tot = 0, mine = 0; for (int p = 0; p < 32; ++p) { tot += C[p * 16 + ((int)threadIdx.x)]; mine += C[512 + p * 16 + ((int)threadIdx.x)]; } TOT[((int)threadIdx.x)] = tot; MINE[((int)threadIdx.x)] = mine; }
    __syncthreads();
    if (((int)threadIdx.x) == 0) { int acc = 0; for (int k = 0; k < 16; ++k) { START[k] = acc; const int p = (TOT[k] + 255) & ~255; PAD[k] = p; acc += p; } }
    const int* tke = (const int*)(F.ws + TB_TKE); const float* tkg = (const float*)(F.ws + TB_TKG);
    int* rowtok = (int*)(F.ws + TB_ROWTOK); float* rowgate = (float*)(F.ws + TB_ROWGATE);
    if (((int)threadIdx.x) < 256) EL[((int)threadIdx.x)] = tke[(((int)threadIdx.x) >> 7) * M + F.wg * 128 + (((int)threadIdx.x) & 127)];
    __syncthreads();
    if (((int)threadIdx.x) < 256) { const int s = ((int)threadIdx.x) >> 7, i = ((int)threadIdx.x) & 127, e = EL[((int)threadIdx.x)]; int rank = 0; for (int j = 0; j < i; ++j) rank += (EL[s * 128 + j] == e) ? 1 : 0;
        const int dest = START[s * 8 + e] + MINE[s * 8 + e] + rank, tok = F.wg * 128 + i;
        rowtok[dest] = tok; rowgate[dest] = tkg[s * M + tok]; }
    if (F.wg < 16) { const int k = F.wg; for (int r = START[k] + TOT[k] + ((int)threadIdx.x); r < START[k] + PAD[k]; r += NTHR) { rowtok[r] = -1; rowgate[r] = 0.f; } }
    if (F.wg == 0) {
        int* tile_e = (int*)(F.ws + TB_TILEE); int* ntiles = (int*)(F.ws + TB_NTILES);
        if (((int)threadIdx.x) < 2 * MOE_TILES) { const int r = ((int)threadIdx.x) * 256; int e = 0; for (int k = 0; k < 16; ++k) if (r >= START[k]) e = k & 7; tile_e[((int)threadIdx.x)] = e; }
        if (((int)threadIdx.x) == 0) { const int n0 = START[8] >> 8; ntiles[0] = n0; ntiles[1] = ((START[15] + PAD[15]) >> 8) - n0; }
    }
}

__device__ __attribute__((noinline)) void moe_dn_combine(const int wg, const int nM, const int G, float* part, unsigned* cnt, const bf16* hin, bf16* hout, const int* row_tok, const float* row_gate, const float sc) {
    pg8::OrderBase S; S.init(nM, D / 256, G, wg);
    const int main = (S.nwg / S.G) * S.G, left = S.nwg - main;
    if (wg >= pg8::DN_KSPLIT * left) return;
    const int j = wg / pg8::DN_KSPLIT, q = wg % pg8::DN_KSPLIT, tid = (int)threadIdx.x;
    pg8::Unit u; S.map((long)main + j, u);
    asm volatile("s_waitcnt vmcnt(0)" ::: "memory");
    __syncthreads();
    if (tid == 0) { __builtin_amdgcn_fence(__ATOMIC_RELEASE, "agent"); asm volatile("s_waitcnt vmcnt(0)" ::: "memory"); __hip_atomic_fetch_add(cnt + 64 * j, 1u, __ATOMIC_RELAXED, __HIP_MEMORY_SCOPE_AGENT);
        unsigned sp = 0; while (__hip_atomic_load(cnt + 64 * j, __ATOMIC_RELAXED, __HIP_MEMORY_SCOPE_AGENT) < (unsigned)pg8::DN_KSPLIT) { __builtin_amdgcn_s_sleep(2); if (++sp > (1u << 22)) break; }
        __builtin_amdgcn_fence(__ATOMIC_ACQUIRE, "agent"); asm volatile("s_waitcnt vmcnt(0)" ::: "memory"); }
    __syncthreads();
    constexpr int KS = pg8::DN_KSPLIT, RPW = (256 + KS - 1) / KS;
    const float* slab = part + (size_t)j * KS * 65536;
    const int cg = (tid & 31) * 8, r1 = (q * RPW + RPW < 256) ? q * RPW + RPW : 256;
    for (int r = q * RPW + (tid >> 5); r < r1; r += 16) {
        const int row = u.pm * 256 + r; const int tok = row_tok[row]; const float g = row_gate[row] * sc;
        if (tok >= 0) {
            f32x4 a[KS][2];
#pragma unroll
            for (int k = 0; k < KS; ++k) { a[k][0] = *(const f32x4*)(slab + (size_t)k * 65536 + r * 256 + cg); a[k][1] = *(const f32x4*)(slab + (size_t)k * 65536 + r * 256 + cg + 4); }
            float h[8]; unpack8(*(const u32x4*)(hin + (size_t)tok * D + u.pn * 256 + cg), h);
            f32x4 s0 = a[0][0], s1 = a[0][1];
#pragma unroll
            for (int k = 1; k < KS; ++k) { s0 += a[k][0]; s1 += a[k][1]; }
#pragma unroll
            for (int e = 0; e < 4; ++e) { h[e] += g * s0[e]; h[4 + e] += g * s1[e]; }
            *(u32x4*)(hout + (size_t)tok * D + u.pn * 256 + cg) = pack8(h);
        }
    }
}

constexpr int NPHASES = 21;
__global__ void __launch_bounds__(NTHR, 2) fwd(Args args) {
    extern __shared__ __attribute__((aligned(16))) unsigned char lds[];
    Frame F;
    F.lds = (LAS unsigned char*)lds;
    F.wave = __builtin_amdgcn_readfirstlane((int)threadIdx.x >> 6);
    F.G = gridDim.x; F.wg = blockIdx.x;
    F.A = &args; F.out = args.out; F.ws = args.ws;
    volatile LAS unsigned* MISC = (volatile LAS unsigned*)(F.lds + MISC_OFF);
    if (((int)threadIdx.x) < 64) MISC[((int)threadIdx.x)] = 0u;
    __syncthreads();
    const int lo = args.ph_lo, hi = args.ph_hi;
    XcdBarrier bar; bar.bar = (unsigned*)(F.ws + WS_CTL) + CW_BAR; bar.x = 0; bar.st = nullptr;
    if (hi - lo > 1) bar = xcd_barrier_post((unsigned*)(F.ws + WS_CTL) + CW_BAR, MISC + 8);
#ifndef ONLY_PHASE
#define ONLY_PHASE -1
#endif
#define IN(k) ((ONLY_PHASE < 0 || (k) == ONLY_PHASE) && lo <= (k) && (k) < hi)
#define SEAM(k) do { if (IN(k) && IN((k) + 1)) xcd_barrier(bar); } while (0)
    unsigned char* ws = F.ws;
    bf16* HN = (bf16*)(ws + WS_HN); bf16* MIX = (bf16*)(ws + WS_MIX); bf16* PROJ = (bf16*)(ws + WS_PROJ);
    bf16* HB = (bf16*)F.out;

    if (IN(0)) { p0_prologue(F); norm_rows_phase(F, F.A->in[I_X], F.A->in[I_N1G], HN); }
    SEAM(0);
#define LAYER_MIXER(l) do { \
        constexpr int pb = 1 + (l) * 9; \
        if (IN(pb + 0)) { pg8::DenseSched S; S.init(M / 256, NIN / 256, F.G, F.wg); S.A = (const char*)HN; S.Bt = (const char*)(ws + WS_WIN) + (size_t)(l) * NIN * D * 2; S.tstep = (size_t)256 * D * 2; \
            pg8::EpiBf16 E{PROJ, NIN}; pg8::gemm_phase<pg8::EpiBf16, pg8::DenseSched, true, true>(F.lds, D, S, E); } \
        SEAM(pb + 0); \
        if (IN(pb + 1)) { s1_stage_mu(F, (l)); for (int gc = F.wg; gc < M / 64; gc += F.G) { mixc_unit(F, (l), gc); s1_chunk_prep(F, (l), gc); S1Pre pa, pb2; s1_issue(F, (l), gc, 0, pa); for (int h = 0; h < NH; h += 2) { s1_unit(F, (l), gc, h, pa, h + 1, pb2); s1_unit(F, (l), gc, h + 1, pb2, (h + 2 < NH) ? h + 2 : h + 1, pa); } LDS_BAR(); } } \
        SEAM(pb + 1); \
        if (IN(pb + 2)) { s2_phase(F, (l)); } \
        SEAM(pb + 2); \
        if (IN(pb + 3)) { s3_phase(F, (l)); } \
        SEAM(pb + 3); \
        if (IN(pb + 4)) { pg8::DenseSched S; S.init(M / 256, D / 256, F.G, F.wg); S.A = (const char*)MIX; S.Bt = (const char*)(ws + WS_WOUT) + (size_t)(l) * D * D * 2; S.tstep = (size_t)256 * D * 2; \
            if ((l) == 0) { pg8::EpiResid<true> E{(const void*)F.A->in[I_X], HB, D}; pg8::gemm_phase<pg8::EpiResid<true>, pg8::DenseSched, true, true>(F.lds, D, S, E); } \
            else { pg8::EpiResid<false> E{(const void*)HB, HB, D}; pg8::gemm_phase<pg8::EpiResid<false>, pg8::DenseSched, true, true>(F.lds, D, S, E); } } \
        SEAM(pb + 4); } while (0)
    LAYER_MIXER(0);
    {
        if (IN(6)) norm_rows_phase_b<false>(F, HB, F.A->in[I_N2G], HN);
        SEAM(6);
        if (IN(7)) { pg8::DenseSched S; S.init(M / 256, 2 * FF / 256, F.G, F.wg); S.A = (const char*)HN; S.Bt = (const char*)(ws + WS_WGU); S.tstep = (size_t)256 * D * 2;
            pg8::EpiSwiglu E{(bf16*)(ws + WS_HID), FF}; pg8::gemm_phase<pg8::EpiSwiglu, pg8::DenseSched, true, true>(F.lds, D, S, E); }
        SEAM(7);
        if (IN(8)) { pg8::DenseSched S; S.init(M / 256, D / 256, F.G, F.wg); S.A = (const char*)(ws + WS_HID); S.Bt = (const char*)(ws + WS_WDN); S.tstep = (size_t)256 * FF * 2;
            pg8::EpiResid<false> E{(const void*)HB, HB, D}; pg8::gemm_phase<pg8::EpiResid<false>, pg8::DenseSched, true, true>(F.lds, FF, S, E); }
        SEAM(8);
        if (IN(9)) norm_rows_phase_b<false>(F, HB, F.A->in[I_N1G] + D, HN);
        SEAM(9);
    }
    LAYER_MIXER(1);
    if (IN(15)) { norm2_router_phase(F, HB, F.A->in[I_N2G] + D, F.A->in[I_ROUTER]); moe_weight_convert<1>(F, F.wg * NWAVES + F.wave, F.G * NWAVES, (LAS float*)(F.lds + 32768 + F.wave * 9216)); }
    SEAM(15);
    if (IN(16)) moe_dispatch_phase(F);
    SEAM(16);
    {
        const int* rowtok = (const int*)(ws + TB_ROWTOK); const float* rowgate = (const float*)(ws + TB_ROWGATE); const int* tile_e = (const int*)(ws + TB_TILEE);
        if (IN(17)) { const int nt = __builtin_amdgcn_readfirstlane(((const int*)(ws + TB_NTILES))[0] + ((const int*)(ws + TB_NTILES))[1]);
            pg8::MoeGuSched S; S.init(nt, 2 * FE / 256, F.G, F.wg); S.A = (const char*)HN; S.Bt = (const char*)(ws + WS_WMGU); S.row_tok = rowtok; S.tile_e = tile_e;
            pg8::EpiSwigluF8 E{ws + WS_MHID, FE}; pg8::gemm_phase<pg8::EpiSwigluF8, pg8::MoeGuSched, true, true, true>(F.lds, D / 2, S, E); }
        SEAM(17);
#pragma unroll
        for (int s = 0; s < 2; ++s) {
            if (IN(18 + s)) { const int nt0 = __builtin_amdgcn_readfirstlane(((const int*)(ws + TB_NTILES))[0]), nt = s ? __builtin_amdgcn_readfirstlane(((const int*)(ws + TB_NTILES))[1]) : nt0, t0 = s ? nt0 : 0;
                const int* rt = rowtok + t0 * 256; const float* rg = rowgate + t0 * 256; const int* te = tile_e + t0; const char* hid = (const char*)(ws + WS_MHID) + (size_t)t0 * 256 * FE;
                { pg8::MoeDnSched S; S.init(nt, D / 256, F.G, F.wg); S.A = hid; S.Bt = (const char*)(ws + WS_WMDN); S.tile_e = te; S.tstep = (size_t)256 * FE;
                  pg8::EpiMoeDown E{HB, (s == 0) ? HB : HN, rt, rg, F8_DN_INV}; pg8::gemm_phase<pg8::EpiMoeDown, pg8::MoeDnSched, true, true, true>(F.lds, FE / 2, S, E); }
                { pg8::MoeDnLeftSched S; S.init(nt, D / 256, F.G, F.wg); S.A = hid; S.Bt = (const char*)(ws + WS_WMDN); S.tile_e = te; S.tstep = (size_t)256 * FE;
                  float* part = (float*)(ws + WS_PART); unsigned* cnt = (unsigned*)(ws + WS_CTL) + CW_LEFT + s * 32 * 64;
                  pg8::EpiPartTile E{part + (size_t)F.wg * 65536};
                  pg8::gemm_phase<pg8::EpiPartTile, pg8::MoeDnLeftSched, true, true, true>(F.lds, FE / 2, S, E, pg8::DN_KT);
                  moe_dn_combine(F.wg, nt, F.G, part, cnt, HB, (s == 0) ? HB : HN, rt, rg, F8_DN_INV); } }
            SEAM(18 + s);
        }
    }
    if (IN(20)) norm_rows_phase_b<true>(F, HN, F.A->in[I_FINALG], F.out);
#undef IN
#undef SEAM
}

extern "C" void kernel_launch(void* const* d_in, const int* in_sizes, int n_in, void* d_out, int out_size, void* d_ws, size_t ws_size, hipStream_t stream) {
    static int ready = 0;
    if (ready == 0) {
        if (n_in != 33 || out_size != M * D || ws_size < WS_NEED) { fprintf(stderr, "kernel_launch: unexpected shapes (n_in %d, out %d, ws %zu, need %zu)\n", n_in, out_size, ws_size, (size_t)WS_NEED); ready = -1; return; }
        if (hipFuncSetAttribute((const void*)fwd, hipFuncAttributeMaxDynamicSharedMemorySize, LDS_BYTES) != hipSuccess) { fprintf(stderr, "kernel_launch: hipFuncSetAttribute failed\n"); ready = -1; return; }
        int per_cu = 0; (void)hipOccupancyMaxActiveBlocksPerMultiprocessor(&per_cu, (const void*)fwd, NTHR, LDS_BYTES); (void)hipGetLastError();
        if (per_cu < 1) fprintf(stderr, "kernel_launch: occupancy query reports %d\n", per_cu);
        ready = 1;
    }
    if (ready < 0) return;
    (void)hipMemsetAsync((char*)d_ws + WS_CTL, 0, CTL_ZERO_BYTES, stream);
    Args a{};
    for (int i = 0; i < 33; ++i) a.in[i] = (const float*)d_in[i];
    a.out = (float*)d_out; a.ws = (unsigned char*)d_ws;
#if N_LAUNCH_MODE == 1
    a.ph_lo = 0; a.ph_hi = NPHASES;
    hipLaunchKernelGGL(fwd, dim3(GRID), dim3(NTHR), LDS_BYTES, stream, a);
#else
    for (int p = 0; p < NPHASES; ++p) { a.ph_lo = p; a.ph_hi = p + 1; const int reps = ((PROBE_PHASES >> p) & 1u) ? 2 : 1;
        for (int r = 0; r < reps; ++r) hipLaunchKernelGGL(fwd, dim3(GRID), dim3(NTHR), LDS_BYTES, stream, a); }
#endif
    (void)in_sizes;
}
```

```cpp
#include <hip/hip_runtime.h>
#include <cstdio>
#include <cstdint>

#define DI __device__ __forceinline__
#define LAS __attribute__((address_space(3)))
typedef unsigned short bf16;
typedef short bf16x8 __attribute__((ext_vector_type(8)));
typedef float f32x4 __attribute__((ext_vector_type(4)));
typedef float f32x2 __attribute__((ext_vector_type(2)));
typedef unsigned u32x4 __attribute__((ext_vector_type(4)));
typedef unsigned u32x2 __attribute__((ext_vector_type(2)));
typedef __bf16 bf2_t __attribute__((ext_vector_type(2)));

#ifndef PROBE_PHASES
#define PROBE_PHASES 0x0u
#endif
#ifndef N_LAUNCH_MODE
#define N_LAUNCH_MODE 1
#endif

constexpr int BATCH = 4, T = 8192, D = 1024, M = BATCH * T;
constexpr int NIN = 2560, RW = 512, NH = 8;
constexpr int C_CONVA = 256, C_CONVB = 512, C_R = 768, C_K = 1280, C_V = 1792, C_XW = 2304, C_XA = 2368, C_XG = 2432;
constexpr int NRC = 1792;
constexpr int FF = 2816, FE = 3584, NE = 8;
constexpr int MOE_ROWS = M + NE * 256;
constexpr int MOE_TILES = MOE_ROWS / 256;
constexpr float RMS_EPS = 1e-6f, LN_EPS = 1e-5f, GN_EPS = 64e-5f;
constexpr int NWAVES = 8, NTHR = 512, GRID = 256;

DI unsigned pk2(float lo, float hi) { f32x2 v = {lo, hi}; return __builtin_bit_cast(unsigned, __builtin_convertvector(v, bf2_t)); }
DI float bflo(unsigned u) { return __uint_as_float(u << 16); }
DI float bfhi(unsigned u) { return __uint_as_float(u & 0xffff0000u); }
DI float fast_exp(float x) { return __builtin_amdgcn_exp2f(x * 1.44269504088896f); }
DI float sigmoidf_(float x) { return __builtin_amdgcn_rcpf(1.0f + fast_exp(-x)); }
DI float siluf_(float x) { return x * sigmoidf_(x); }
template <int D> DI float row_shr(float x) { return __builtin_bit_cast(float, __builtin_amdgcn_update_dpp(0, __builtin_bit_cast(int, x), 0x110 + D, 0xf, 0xf, false)); }
DI float row_scan16(float x) { x += row_shr<1>(x); x += row_shr<2>(x); x += row_shr<4>(x); x += row_shr<8>(x); return x; }
DI float wave_sum(float v) {
    v = row_scan16(v);
    const int iv = __builtin_bit_cast(int, v);
    const float a = __builtin_bit_cast(float, __builtin_amdgcn_readlane(iv, 15)), b = __builtin_bit_cast(float, __builtin_amdgcn_readlane(iv, 31));
    const float c = __builtin_bit_cast(float, __builtin_amdgcn_readlane(iv, 47)), d = __builtin_bit_cast(float, __builtin_amdgcn_readlane(iv, 63));
    return (a + b) + (c + d);
}
DI void unpack8(const u32x4 w, float (&f)[8]) { f[0] = bflo(w.x); f[1] = bfhi(w.x); f[2] = bflo(w.y); f[3] = bfhi(w.y); f[4] = bflo(w.z); f[5] = bfhi(w.z); f[6] = bflo(w.w); f[7] = bfhi(w.w); }
DI u32x4 pack8(const float (&f)[8]) { u32x4 w; w.x = pk2(f[0], f[1]); w.y = pk2(f[2], f[3]); w.z = pk2(f[4], f[5]); w.w = pk2(f[6], f[7]); return w; }
#define MFMA16(a, b, c) __builtin_amdgcn_mfma_f32_16x16x32_bf16((a), (b), (c), 0, 0, 0)
typedef int i32x8 __attribute__((ext_vector_type(8)));
typedef int i32x4 __attribute__((ext_vector_type(4)));
constexpr float F8S_X = 4.f, F8S_WGU = 64.f, F8S_H = 8.f, F8S_WDN = 128.f;
constexpr float F8_GU_INV = 1.f / (F8S_X * F8S_WGU), F8_DN_INV = 1.f / (F8S_H * F8S_WDN);
DI float f8clamp(float x) { return __builtin_amdgcn_fmed3f(x, -448.f, 448.f); }
DI unsigned pk4_f8(float a, float b, float c, float d) { int p = __builtin_amdgcn_cvt_pk_fp8_f32(f8clamp(a), f8clamp(b), 0, false); p = __builtin_amdgcn_cvt_pk_fp8_f32(f8clamp(c), f8clamp(d), p, true); return (unsigned)p; }
DI i32x8 cat8(const bf16x8 a, const bf16x8 b) { return __builtin_shufflevector(__builtin_bit_cast(i32x4, a), __builtin_bit_cast(i32x4, b), 0, 1, 2, 3, 4, 5, 6, 7); }

namespace pg8 {
constexpr int BM = 256, BK = 64, HALF = 128, HTB = HALF * BK * 2, STAGE_BYTES = 8 * HTB, NXCD = 8, WGM = 8;
DI int lds_byte(int r, int c) { const int st = (r >> 4) * 2 + (c >> 5), rr = r & 15, cc = c & 31, ob = rr * 64 + cc * 2; return st * 1024 + (ob ^ (((ob >> 9) & 1) << 5)); }
DI void stage_rc(int b, int& R, int& C) { const int st = b / 1024, sb = b % 1024, swz = sb ^ (((sb >> 9) & 1) << 5); R = (st >> 1) * 16 + swz / 64; C = (st & 1) * 32 + (swz % 64) / 2; }
DI int perm32(int rho) { const int n = rho >> 4, i = rho & 15; return 8 * (i >> 2) + 4 * n + (i & 3); }
struct Unit { int pm, pn; };
struct OrderBase {
    int nM, nN, nwg, G, c;
    DI void init(int nM_, int nN_, int G_, int c_) { nM = nM_; nN = nN_; nwg = nM * nN; G = G_; c = c_; }
    DI void map(const long L, Unit& u) const {
        int wgid = (int)L; { const int q = nwg / NXCD, r = nwg % NXCD, xcd = wgid % NXCD, off = wgid / NXCD; wgid = (xcd < r ? xcd * (q + 1) : r * (q + 1) + (xcd - r) * q) + off; }
        const int nig = WGM * nN, gid = wgid / nig, fm = gid * WGM, gsz = (nM - fm) < WGM ? (nM - fm) : WGM;
        u.pm = fm + ((wgid % nig) % gsz); u.pn = (wgid % nig) / gsz;
    }
    DI bool next(int i, Unit& u) const { const long L = (long)i * G + c; if (L >= nwg) return false; map(L, u); return true; }
};
struct DenseSched : OrderBase {
    static constexpr bool GATHER = false;
    const char* A; const char* Bt; size_t tstep;
    DI const char* a_base(const Unit& u) const { return A + (size_t)u.pm * tstep; }
    DI const char* b_base(const Unit& u) const { return Bt + (size_t)u.pn * tstep; }
    DI void a_offs(const Unit&, const int (&)[2], const int (&)[2], unsigned (&)[2][2]) const {}
};
struct MoeGuSched : OrderBase {
    static constexpr bool GATHER = true;
    const char* A; const char* Bt; const int* row_tok; const int* tile_e;
    DI const char* a_base(const Unit&) const { return A; }
    DI const char* b_base(const Unit& u) const { const int e = __builtin_amdgcn_readfirstlane(tile_e[u.pm]); return Bt + ((size_t)e * (2 * FE) + (size_t)u.pn * 256) * (size_t)D; }
    DI void a_offs(const Unit& u, const int (&R)[2], const int (&C)[2], unsigned (&o)[2][2]) const {
#pragma unroll
        for (int h = 0; h < 2; ++h)
#pragma unroll
            for (int i = 0; i < 2; ++i) { int tok = row_tok[u.pm * 256 + h * 128 + R[i]]; tok = tok < 0 ? M : tok; o[h][i] = (unsigned)tok * (unsigned)D + (unsigned)(C[i] * 2); }
    }
};
struct MoeDnSched : OrderBase {
    static constexpr bool GATHER = false;
    const char* A; const char* Bt; const int* tile_e; size_t tstep;
    DI bool next(int i, Unit& u) const { if (i >= nwg / G) return false; map((long)i * G + c, u); return true; }
    DI const char* a_base(const Unit& u) const { return A + (size_t)u.pm * tstep; }
    DI const char* b_base(const Unit& u) const { const int e = __builtin_amdgcn_readfirstlane(tile_e[u.pm]); return Bt + ((size_t)e * D + (size_t)u.pn * 256) * (size_t)FE; }
    DI void a_offs(const Unit&, const int (&)[2], const int (&)[2], unsigned (&)[2][2]) const {}
};
constexpr int DN_KSPLIT = 7, DN_KT = FE / 128 / DN_KSPLIT;
struct MoeDnLeftSched : OrderBase {
    static constexpr bool GATHER = false;
    const char* A; const char* Bt; const int* tile_e; size_t tstep;
    DI bool next(int i, Unit& u) const { const int main = (nwg / G) * G, left = nwg - main; if (i > 0 || c >= DN_KSPLIT * left) return false; map((long)main + (c / DN_KSPLIT), u); return true; }
    DI const char* a_base(const Unit& u) const { return A + (size_t)u.pm * tstep + (size_t)(c % DN_KSPLIT) * (DN_KT * 128); }
    DI const char* b_base(const Unit& u) const { const int e = __builtin_amdgcn_readfirstlane(tile_e[u.pm]); return Bt + ((size_t)e * D + (size_t)u.pn * 256) * (size_t)FE + (size_t)(c % DN_KSPLIT) * (DN_KT * 128); }
    DI void a_offs(const Unit&, const int (&)[2], const int (&)[2], unsigned (&)[2][2]) const {}
};

struct EpiBf16 {
    static constexpr bool PERM = true;
    bf16* O; int ldc;
    DI void operator()(const f32x4 (&acc)[2][2][4][2], const Unit& u, int wr, int wc, int fr, int fq) const {
        const int row0 = u.pm * BM + wr * 64 + fr, col0 = u.pn * BM + wc * 32 + 8 * fq;
#pragma unroll
        for (int ai = 0; ai < 2; ++ai)
#pragma unroll
            for (int m = 0; m < 4; ++m) { bf16* rowp = O + (size_t)(row0 + ai * HALF + m * 16) * ldc + col0;
#pragma unroll
                for (int bj = 0; bj < 2; ++bj) { const f32x4 v0 = acc[ai][bj][m][0], v1 = acc[ai][bj][m][1];
                    u32x4 w; w.x = pk2(v0[0], v0[1]); w.y = pk2(v0[2], v0[3]); w.z = pk2(v1[0], v1[1]); w.w = pk2(v1[2], v1[3]);
                    *(u32x4*)(rowp + bj * HALF) = w; } }
    }
};
struct EpiSwiglu {
    static constexpr bool PERM = true;
    bf16* O; int ldc;
    DI void operator()(const f32x4 (&acc)[2][2][4][2], const Unit& u, int wr, int wc, int fr, int fq) const {
        const int row0 = u.pm * BM + wr * 64 + fr, col0 = u.pn * HALF + wc * 32 + 8 * fq;
#pragma unroll
        for (int ai = 0; ai < 2; ++ai)
#pragma unroll
            for (int m = 0; m < 4; ++m) { bf16* rowp = O + (size_t)(row0 + ai * HALF + m * 16) * ldc + col0;
                float h[8];
#pragma unroll
                for (int n = 0; n < 2; ++n)
#pragma unroll
                    for (int j = 0; j < 4; ++j) { const float g = acc[ai][0][m][n][j], up = acc[ai][1][m][n][j]; h[n * 4 + j] = siluf_(g) * up; }
                *(u32x4*)rowp = pack8(h); }
    }
};
struct EpiSwigluF8 {
    static constexpr bool PERM = true;
    unsigned char* O; int ldc;
    DI void operator()(const f32x4 (&acc)[2][2][4][2], const Unit& u, int wr, int wc, int fr, int fq) const {
        const int row0 = u.pm * BM + wr * 64 + fr, col0 = u.pn * HALF + wc * 32 + 8 * fq;
#pragma unroll
        for (int ai = 0; ai < 2; ++ai)
#pragma unroll
            for (int m = 0; m < 4; ++m) { unsigned char* rowp = O + (size_t)(row0 + ai * HALF + m * 16) * ldc + col0;
                float h[8];
#pragma unroll
                for (int n = 0; n < 2; ++n)
#pragma unroll
                    for (int j = 0; j < 4; ++j) { const float ag = acc[ai][0][m][n][j], au = acc[ai][1][m][n][j];
                        constexpr float KK = 1.f / (F8S_H * F8_GU_INV * F8_GU_INV), LK = 13.f; static_assert(KK == 8192.f, "log2 of K");
                        h[n * 4 + j] = (ag * au) * __builtin_amdgcn_rcpf(KK + __builtin_amdgcn_exp2f(__builtin_fmaf(ag, -1.44269504088896f * F8_GU_INV, LK))); }
                u32x2 w; w.x = pk4_f8(h[0], h[1], h[2], h[3]); w.y = pk4_f8(h[4], h[5], h[6], h[7]);
                *(u32x2*)rowp = w; }
    }
};
template <bool BASE_F32> struct EpiResid {
    static constexpr bool PERM = true;
    const void* base; bf16* out; int ldc;
    DI void operator()(const f32x4 (&acc)[2][2][4][2], const Unit& u, int wr, int wc, int fr, int fq) const {
        const int row0 = u.pm * BM + wr * 64 + fr, col0 = u.pn * BM + wc * 32 + 8 * fq;
        u32x4 bball[BASE_F32 ? 1 : 2][4][2];
        if constexpr (!BASE_F32) {
#pragma unroll
            for (int ai = 0; ai < 2; ++ai)
#pragma unroll
                for (int m = 0; m < 4; ++m)
#pragma unroll
                    for (int bj = 0; bj < 2; ++bj) bball[ai][m][bj] = *(const u32x4*)((const bf16*)base + (size_t)(row0 + ai * HALF + m * 16) * ldc + col0 + bj * HALF);
            asm volatile("" ::: "memory");
        }
#pragma unroll
        for (int ai = 0; ai < 2; ++ai) {
            f32x4 bf[BASE_F32 ? 4 : 1][2][2]; u32x4 bb[4][2];
#pragma unroll
            for (int m = 0; m < 4; ++m) { const size_t off = (size_t)(row0 + ai * HALF + m * 16) * ldc + col0;
#pragma unroll
                for (int bj = 0; bj < 2; ++bj) { if (BASE_F32) { bf[BASE_F32 ? m : 0][bj][0] = *(const f32x4*)((const float*)base + off + bj * HALF); bf[BASE_F32 ? m : 0][bj][1] = *(const f32x4*)((const float*)base + off + bj * HALF + 4); }
                                                 else bb[m][bj] = bball[BASE_F32 ? 0 : ai][m][bj]; } }
            asm volatile("" ::: "memory");
#pragma unroll
            for (int m = 0; m < 4; ++m) { const size_t off = (size_t)(row0 + ai * HALF + m * 16) * ldc + col0;
#pragma unroll
                for (int bj = 0; bj < 2; ++bj) { float h[8];
                    if (BASE_F32) {
#pragma unroll
                        for (int j = 0; j < 4; ++j) { h[j] = bf[BASE_F32 ? m : 0][bj][0][j]; h[4 + j] = bf[BASE_F32 ? m : 0][bj][1][j]; } }
                    else unpack8(bb[m][bj], h);
#pragma unroll
                    for (int j = 0; j < 4; ++j) { h[j] += acc[ai][bj][m][0][j]; h[4 + j] += acc[ai][bj][m][1][j]; }
                    *(u32x4*)(out + off + bj * HALF) = pack8(h); } }
            asm volatile("" ::: "memory");
        }
    }
};
struct EpiMoeDown {
    static constexpr bool PERM = true;
    const bf16* hin; bf16* hout; const int* row_tok; const float* row_gate; float sc;
    DI void operator()(const f32x4 (&acc)[2][2][4][2], const Unit& u, int wr, int wc, int fr, int fq) const {
        const int row0 = u.pm * BM + wr * 64 + fr, col0 = u.pn * BM + wc * 32 + 8 * fq;
        int tok[2][4]; float g[2][4];
#pragma unroll
        for (int ai = 0; ai < 2; ++ai)
#pragma unroll
            for (int m = 0; m < 4; ++m) { const int r = row0 + ai * HALF + m * 16; tok[ai][m] = row_tok[r]; g[ai][m] = row_gate[r] * sc; }
        u32x4 bball[2][4][2];
#pragma unroll
        for (int ai = 0; ai < 2; ++ai)
#pragma unroll
            for (int m = 0; m < 4; ++m) { const int tk = tok[ai][m]; const bf16* hp = hin + (size_t)(tk < 0 ? 0 : tk) * D + col0;
#pragma unroll
                for (int bj = 0; bj < 2; ++bj) bball[ai][m][bj] = *(const u32x4*)(hp + bj * HALF); }
        asm volatile("" ::: "memory");
#pragma unroll
        for (int ai = 0; ai < 2; ++ai) {
            u32x4 bb[4][2];
#pragma unroll
            for (int m = 0; m < 4; ++m)
#pragma unroll
                for (int bj = 0; bj < 2; ++bj) bb[m][bj] = bball[ai][m][bj];
#pragma unroll
            for (int m = 0; m < 4; ++m) { const int tk = tok[ai][m]; if (tk >= 0) { bf16* hp = hout + (size_t)tk * D + col0; const float gg = g[ai][m];
#pragma unroll
                for (int bj = 0; bj < 2; ++bj) { float h[8]; unpack8(bb[m][bj], h);
#pragma unroll
                    for (int j = 0; j < 4; ++j) { h[j] += acc[ai][bj][m][0][j] * gg; h[4 + j] += acc[ai][bj][m][1][j] * gg; }
                    *(u32x4*)(hp + bj * HALF) = pack8(h); } } }
            asm volatile("" ::: "memory");
        }
    }
};

struct EpiPartTile {
    static constexpr bool PERM = true;
    float* slab;
    DI void operator()(const f32x4 (&acc)[2][2][4][2], const Unit&, int wr, int wc, int fr, int fq) const {
        float* base = slab + (size_t)(wr * 64 + fr) * 256 + wc * 32 + 8 * fq;
#pragma unroll
        for (int ai = 0; ai < 2; ++ai)
#pragma unroll
            for (int m = 0; m < 4; ++m)
#pragma unroll
                for (int bj = 0; bj < 2; ++bj) { float* p = base + (size_t)(ai * HALF + m * 16) * 256 + bj * HALF; *(f32x4*)p = acc[ai][bj][m][0]; *(f32x4*)(p + 4) = acc[ai][bj][m][1]; }
    }
};

template <class Epi, class Sched, bool ALIGN_EPI, bool SP2, bool F8 = false>
DI void gemm_phase(LAS unsigned char* lds, const int K, const Sched& S, const Epi& E, const int ktiles = 0) {
    const int tid = threadIdx.x, wid = __builtin_amdgcn_readfirstlane(tid >> 6), lane = tid & 63, wr = wid >> 2, wc = wid & 3, fr = lane & 15, fq = lane >> 4;
    const int nt = ktiles ? ktiles : K / BK;
    unsigned voffA[2], voffB[2]; int RA[2], CA[2];
#pragma unroll
    for (int i = 0; i < 2; ++i) { int R, C; stage_rc(tid * 16 + i * 8192, R, C); const int Rb = Epi::PERM ? ((R & ~31) + perm32(R & 31)) : R;
        RA[i] = R; CA[i] = C; voffA[i] = (unsigned)(R * K + C) * 2u; voffB[i] = (unsigned)(Rb * K + C) * 2u; }
    unsigned gc[2][2] = {{0u, 0u}, {0u, 0u}}, gn[2][2] = {{0u, 0u}, {0u, 0u}};
    const size_t kstep = (size_t)(BK * 2);
    const size_t hstep = (size_t)HALF * K * 2;
    const unsigned ldsw = (unsigned)wid * 1024u;
    const int aoff = lds_byte(wr * 64 + fr, fq * 8), boff = lds_byte(wc * 32 + fr, fq * 8);
#define PG8_SA(b, h) (((b) * 2 + (h)) * HTB)
#define PG8_SB(b, h) ((4 + (b) * 2 + (h)) * HTB)
#define PG8_STAGE(bufoff, gbase, voff) do { _Pragma("unroll") for (int _i = 0; _i < 2; ++_i) \
        __builtin_amdgcn_global_load_lds((const unsigned*)((const char*)(gbase) + (voff)[_i]), (LAS unsigned*)(lds + (bufoff) + ldsw + _i * 8192), 16, 0, 0); } while (0)
#define PG8_STAGE_A(bufoff, kbase, h, go) do { if constexpr (Sched::GATHER) { PG8_STAGE(bufoff, kbase, (go)[h]); } else { PG8_STAGE(bufoff, (kbase) + (h) * hstep, voffA); } } while (0)
#define PG8_LDA(dst, b, h) do { _Pragma("unroll") for (int m = 0; m < 4; ++m) { if constexpr (F8) dst##8[m] = __builtin_shufflevector(*(const LAS i32x4*)(lds + PG8_SA(b, h) + aoff + m * 2048), *(const LAS i32x4*)(lds + PG8_SA(b, h) + aoff + m * 2048 + 1024), 0, 1, 2, 3, 4, 5, 6, 7); \
        else { _Pragma("unroll") for (int k = 0; k < 2; ++k) dst[m][k] = *(const LAS bf16x8*)(lds + PG8_SA(b, h) + aoff + m * 2048 + k * 1024); } } } while (0)
#define PG8_LDB(dst, b, h) do { _Pragma("unroll") for (int n = 0; n < 2; ++n) { if constexpr (F8) dst##8[n] = __builtin_shufflevector(*(const LAS i32x4*)(lds + PG8_SB(b, h) + boff + n * 2048), *(const LAS i32x4*)(lds + PG8_SB(b, h) + boff + n * 2048 + 1024), 0, 1, 2, 3, 4, 5, 6, 7); \
        else { _Pragma("unroll") for (int k = 0; k < 2; ++k) dst[n][k] = *(const LAS bf16x8*)(lds + PG8_SB(b, h) + boff + n * 2048 + k * 1024); } } } while (0)
#define PG8_MMA(ai, bj, At, Bt) do { __builtin_amdgcn_s_setprio(1); _Pragma("unroll") for (int m = 0; m < 4; ++m) _Pragma("unroll") for (int n = 0; n < 2; ++n) { \
        if constexpr (F8) asm volatile("v_mfma_f32_16x16x128_f8f6f4 %0, %1, %2, %0" : "+v"(acc[ai][bj][m][n]) : "v"(Bt##8[n]), "v"(At##8[m])); \
        else { _Pragma("unroll") for (int k = 0; k < 2; ++k) acc[ai][bj][m][n] = __builtin_amdgcn_mfma_f32_16x16x32_bf16(Bt[n][k], At[m][k], acc[ai][bj][m][n], 0, 0, 0); } } __builtin_amdgcn_s_setprio(0); } while (0)
#define PG8_WAIT_V(n) asm volatile("s_waitcnt vmcnt(" #n ")" ::: "memory")
#define PG8_WAIT_L(n) asm volatile("s_waitcnt lgkmcnt(" #n ")" ::: "memory")
#define PG8_BAR __builtin_amdgcn_s_barrier()
#define PG8_SCHED __builtin_amdgcn_sched_barrier(0)
    Unit cur, nxt; int ui = 0;
    if (!S.next(0, cur)) return;
    f32x4 acc[2][2][4][2];
#pragma unroll
    for (int a = 0; a < 2; ++a)
#pragma unroll
        for (int b = 0; b < 2; ++b)
#pragma unroll
            for (int m = 0; m < 4; ++m)
#pragma unroll
                for (int n = 0; n < 2; ++n) acc[a][b][m][n] = (f32x4){0.f, 0.f, 0.f, 0.f};
    bf16x8 At[4][2], B0[2][2], B1[2][2];
    i32x8 At8[4], B08[2], B18[2];
    const char* cA = S.a_base(cur); const char* cB = S.b_base(cur);
    if constexpr (Sched::GATHER) { S.a_offs(cur, RA, CA, gc); asm volatile("" : "+v"(gc[0][0]), "+v"(gc[0][1]), "+v"(gc[1][0]), "+v"(gc[1][1])); }
    if constexpr (SP2) {
        PG8_STAGE(PG8_SB(0, 0), cB, voffB); PG8_STAGE(PG8_SB(0, 1), cB + hstep, voffB); PG8_STAGE_A(PG8_SA(0, 0), cA, 0, gc); PG8_STAGE_A(PG8_SA(0, 1), cA, 1, gc);
        if (wr == 1) PG8_BAR;
        PG8_WAIT_V(2); PG8_BAR;
        PG8_STAGE(PG8_SB(1, 0), cB + kstep, voffB); PG8_STAGE_A(PG8_SA(1, 0), cA + kstep, 0, gc); PG8_STAGE(PG8_SB(1, 1), cB + hstep + kstep, voffB);
        PG8_WAIT_V(6); PG8_BAR;
    } else {
        PG8_STAGE(PG8_SB(0, 0), cB, voffB); PG8_STAGE_A(PG8_SA(0, 0), cA, 0, gc); PG8_STAGE(PG8_SB(0, 1), cB + hstep, voffB); PG8_STAGE_A(PG8_SA(0, 1), cA, 1, gc);
        if (wr == 1) PG8_BAR;
        PG8_WAIT_V(4); PG8_BAR;
        PG8_STAGE(PG8_SB(1, 0), cB + kstep, voffB); PG8_STAGE_A(PG8_SA(1, 0), cA + kstep, 0, gc); PG8_STAGE(PG8_SB(1, 1), cB + hstep + kstep, voffB);
        PG8_WAIT_V(6); PG8_BAR;
    }
    for (;;) {
        const bool has_next = S.next(ui + 1, nxt);
        const char* nA = has_next ? S.a_base(nxt) : cA; const char* nB = has_next ? S.b_base(nxt) : cB;
        if constexpr (Sched::GATHER) {
            if (has_next) { S.a_offs(nxt, RA, CA, gn); asm volatile("" : "+v"(gn[0][0]), "+v"(gn[0][1]), "+v"(gn[1][0]), "+v"(gn[1][1])); }
            else { gn[0][0] = gc[0][0]; gn[0][1] = gc[0][1]; gn[1][0] = gc[1][0]; gn[1][1] = gc[1][1]; }
        }
#pragma unroll 1
        for (int t = 0; t < nt; t += 2) {
            const bool last = (t == nt - 2);
            const char* a1 = cA + (size_t)(t + 1) * kstep;
            const char* a2 = last ? nA : cA + (size_t)(t + 2) * kstep; const char* b2 = last ? nB : cB + (size_t)(t + 2) * kstep;
            const char* a3 = a2 + kstep; const char* b3 = b2 + kstep;
            unsigned g2[2][2];
            if constexpr (Sched::GATHER) {
#pragma unroll
                for (int h = 0; h < 2; ++h)
#pragma unroll
                    for (int i = 0; i < 2; ++i) g2[h][i] = last ? gn[h][i] : gc[h][i];
            }
            if constexpr (SP2) {
            PG8_LDB(B0, 0, 0); PG8_LDB(B1, 0, 1); PG8_SCHED; PG8_LDA(At, 0, 0); PG8_STAGE_A(PG8_SA(1, 1), a1, 1, gc);
            PG8_WAIT_V(8); PG8_WAIT_L(0); PG8_BAR; PG8_MMA(0, 0, At, B0); PG8_MMA(0, 1, At, B1); PG8_BAR; PG8_SCHED;
            PG8_LDA(At, 0, 1); PG8_STAGE(PG8_SB(0, 0), b2, voffB); PG8_STAGE(PG8_SB(0, 1), b2 + hstep, voffB); PG8_STAGE_A(PG8_SA(0, 0), a2, 0, g2);
            PG8_WAIT_V(8); PG8_WAIT_L(0); PG8_BAR; PG8_MMA(1, 0, At, B0); PG8_MMA(1, 1, At, B1); PG8_BAR; PG8_SCHED;
            PG8_LDB(B0, 1, 0); PG8_LDB(B1, 1, 1); PG8_SCHED; PG8_LDA(At, 1, 0); PG8_STAGE_A(PG8_SA(0, 1), a2, 1, g2);
            PG8_WAIT_V(8); PG8_WAIT_L(0); PG8_BAR; PG8_MMA(0, 0, At, B0); PG8_MMA(0, 1, At, B1); PG8_BAR; PG8_SCHED;
            PG8_LDA(At, 1, 1); PG8_STAGE(PG8_SB(1, 0), b3, voffB); PG8_STAGE(PG8_SB(1, 1), b3 + hstep, voffB); PG8_STAGE_A(PG8_SA(1, 0), a3, 0, g2);
            PG8_WAIT_V(8); PG8_WAIT_L(0); PG8_BAR; PG8_MMA(1, 0, At, B0); PG8_MMA(1, 1, At, B1); PG8_BAR; PG8_SCHED;
            } else {
            PG8_LDB(B0, 0, 0); PG8_SCHED; PG8_LDA(At, 0, 0); PG8_STAGE_A(PG8_SA(1, 1), a1, 1, gc);
            PG8_WAIT_L(8); PG8_BAR; PG8_WAIT_L(0); PG8_MMA(0, 0, At, B0); PG8_BAR; PG8_SCHED;
            PG8_LDB(B1, 0, 1); PG8_STAGE(PG8_SB(0, 0), b2, voffB);
            PG8_BAR; PG8_WAIT_L(0); PG8_MMA(0, 1, At, B1); PG8_BAR;
            PG8_LDA(At, 0, 1); PG8_STAGE_A(PG8_SA(0, 0), a2, 0, g2);
            PG8_BAR; PG8_WAIT_L(0); PG8_MMA(1, 0, At, B0); PG8_BAR; PG8_SCHED;
            PG8_STAGE(PG8_SB(0, 1), b2 + hstep, voffB);
            PG8_WAIT_V(6); PG8_BAR; PG8_MMA(1, 1, At, B1); PG8_BAR;
            PG8_LDB(B0, 1, 0); PG8_SCHED; PG8_LDA(At, 1, 0); PG8_STAGE_A(PG8_SA(0, 1), a2, 1, g2);
            PG8_WAIT_L(8); PG8_BAR; PG8_WAIT_L(0); PG8_MMA(0, 0, At, B0); PG8_BAR; PG8_SCHED;
            PG8_LDB(B1, 1, 1); PG8_STAGE(PG8_SB(1, 0), b3, voffB);
            PG8_BAR; PG8_WAIT_L(0); PG8_MMA(0, 1, At, B1); PG8_BAR;
            PG8_LDA(At, 1, 1); PG8_STAGE_A(PG8_SA(1, 0), a3, 0, g2);
            PG8_BAR; PG8_WAIT_L(0); PG8_MMA(1, 0, At, B0); PG8_BAR; PG8_SCHED;
            PG8_STAGE(PG8_SB(1, 1), b3 + hstep, voffB);
            PG8_WAIT_V(6); PG8_BAR; PG8_MMA(1, 1, At, B1); PG8_BAR;
            }
        }
        if constexpr (ALIGN_EPI) { if (wr == 0) PG8_BAR; }
        if constexpr (F8) asm volatile("s_nop 15\n\ts_nop 15" ::: "memory");
        E(acc, cur, wr, wc, fr, fq);
        if (!has_next) break;
#pragma unroll
        for (int a = 0; a < 2; ++a)
#pragma unroll
            for (int b = 0; b < 2; ++b)
#pragma unroll
                for (int m = 0; m < 4; ++m)
#pragma unroll
                    for (int n = 0; n < 2; ++n) acc[a][b][m][n] = (f32x4){0.f, 0.f, 0.f, 0.f};
        cur = nxt; cA = nA; cB = nB; ++ui;
        if constexpr (Sched::GATHER) { gc[0][0] = gn[0][0]; gc[0][1] = gn[0][1]; gc[1][0] = gn[1][0]; gc[1][1] = gn[1][1]; }
        if constexpr (ALIGN_EPI) { if (wr == 1) PG8_BAR; }
    }
    PG8_WAIT_V(0);
    if constexpr (!ALIGN_EPI) { if (wr == 0) PG8_BAR; }
    PG8_BAR;
#undef PG8_SA
#undef PG8_SB
#undef PG8_STAGE
#undef PG8_STAGE_A
#undef PG8_LDA
#undef PG8_LDB
#undef PG8_MMA
#undef PG8_WAIT_V
#undef PG8_WAIT_L
#undef PG8_BAR
#undef PG8_SCHED
}
}

constexpr size_t MiB = 1u << 20;
constexpr size_t WS_CTL = 0, CTL_ZERO_BYTES = 64 * 1024;
constexpr size_t WS_SMALL = 1 * MiB;
constexpr size_t SM_POOLT = WS_SMALL;
constexpr size_t SM_W2T = SM_POOLT + 2 * 4 * 64 * 64 * 2;
constexpr size_t SM_A2T = SM_W2T + 2 * 512 * 64 * 2;
constexpr size_t SM_G2T = SM_A2T + 2 * 512 * 64 * 2;
constexpr size_t SM_V1T = SM_G2T + 2 * 512 * 128 * 2;
constexpr size_t SM_V2T = SM_V1T + 32 * 512 * 2;
constexpr size_t SM_END = SM_V2T + 512 * 32 * 2;
constexpr size_t TB_TKE = 2 * MiB;
constexpr size_t TB_TKG = TB_TKE + 2 * M * 4;
constexpr size_t TB_CNT = TB_TKG + 2 * M * 4;
constexpr size_t TB_ROWTOK = TB_CNT + 256 * 16 * 4;
constexpr size_t TB_ROWGATE = TB_ROWTOK + 2 * MOE_ROWS * 4;
constexpr size_t TB_TILEE = TB_ROWGATE + 2 * MOE_ROWS * 4;
constexpr size_t TB_NTILES = TB_TILEE + 2 * MOE_TILES * 4;
constexpr size_t TB_END = TB_NTILES + 64;
static_assert(SM_END <= TB_TKE && TB_END <= 4 * MiB, "small region");
constexpr size_t WS_WIN = 4 * MiB;
constexpr size_t WS_WOUT = WS_WIN + (size_t)2 * NIN * D * 2;
constexpr size_t WS_WGU = WS_WOUT + (size_t)2 * D * D * 2;
constexpr size_t WS_WDN = WS_WGU + (size_t)2 * FF * D * 2;
constexpr size_t WS_WEND = WS_WDN + (size_t)D * FF * 2;
static_assert(WS_WEND <= 36 * MiB, "main weights");
constexpr size_t WS_HN = 36 * MiB;
constexpr size_t WS_MIX = 101 * MiB;
constexpr size_t WS_VF = 165 * MiB;
constexpr size_t WS_VV1 = 197 * MiB;
constexpr size_t WS_PROJ = 204 * MiB;
constexpr size_t WS_ZB = 364 * MiB, WS_Y0B = 396 * MiB, WS_PTB = 428 * MiB, WS_QB = 460 * MiB;
constexpr size_t WS_SB = 492 * MiB;
constexpr size_t WS_RKB = 524 * MiB;
constexpr size_t WS_GB = 36 * MiB;
constexpr size_t WS_VMB = 68 * MiB;
constexpr size_t WS_HID = 204 * MiB;
constexpr size_t WS_WMGU = 165 * MiB;
constexpr size_t WS_WMDN = 101 * MiB;
constexpr size_t WS_MHID = 277 * MiB;
constexpr size_t WS_PART = 221 * MiB;
constexpr size_t WS_NEED = 526 * MiB;
static_assert(WS_WMGU + (size_t)NE * 2 * FE * D <= WS_PART && WS_PART + (size_t)32 * 7 * 65536 * 4 <= WS_MHID && WS_WMDN + (size_t)NE * D * FE <= 165 * MiB && WS_MHID + (size_t)2 * MOE_ROWS * FE <= 526 * MiB && WS_RKB + (size_t)M * 8 * 4 <= 526 * MiB, "moe map");
static_assert(WS_HN + (size_t)(M + 1) * D * 2 <= WS_MIX && WS_PROJ + (size_t)M * NIN * 2 <= 364 * MiB && WS_HID + (size_t)M * FF * 2 <= 526 * MiB, "map");
constexpr int CW_LEFT = 8192;
constexpr int CW_BAR = 1024;

constexpr int LDS_BYTES = 163840 - 1024;
constexpr int MISC_OFF = LDS_BYTES - 256;

#define XB_TMO      128
#define XB_XCNT(j)  (256  + 64 * (j))
#define XB_XSUB(j)  (1280 + 64 * (j))
#define XB_XGEN(j)  (2304 + 64 * (j))
#define XB_TOP      3328
#define XB_TOPGEN   3392
#define XCD_BAR_WORDS 3456
#define XB_SPIN_CAP (1u << 22)
DI unsigned xb_ld(unsigned* p)              { return __hip_atomic_load(p, __ATOMIC_RELAXED, __HIP_MEMORY_SCOPE_AGENT); }
DI unsigned xb_add(unsigned* p, unsigned v) { return __hip_atomic_fetch_add(p, v, __ATOMIC_RELAXED, __HIP_MEMORY_SCOPE_AGENT); }
DI unsigned xb_xcc_id() { return (unsigned)__builtin_amdgcn_s_getreg((3 << 11) | 20) & 0xFu; }
#define XB_SPIN(cond, bar) do { unsigned _sp = 0; while (cond) { __builtin_amdgcn_s_sleep(1); \
    if ((++_sp & 255u) == 0u) { if (xb_ld(&(bar)[XB_TMO])) break; if (_sp > XB_SPIN_CAP) { atomicAdd(&(bar)[XB_TMO], 1u); break; } } } } while (0)
struct XcdBarrier { unsigned* bar; unsigned x; volatile LAS unsigned* st; };
DI XcdBarrier xcd_barrier_post(unsigned* bar, volatile LAS unsigned* st) {
    XcdBarrier b; b.bar = bar; b.x = xb_xcc_id(); b.st = st;
    if (threadIdx.x == 0) (void)xb_add(&bar[XB_XCNT(b.x)], 1u);
    return b;
}
DI void xcd_barrier_complete(unsigned* bar, unsigned x, unsigned& nloc, unsigned& nx) {
    const unsigned G = gridDim.x * gridDim.y * gridDim.z;
    unsigned sum, cnt, mine, sp = 0u;
    for (;;) {
        sum = 0u; cnt = 0u; mine = 0u;
#pragma unroll
        for (unsigned j = 0; j < 16; ++j) { const unsigned c = xb_ld(&bar[XB_XCNT(j)]); sum += c; cnt += (c > 0u) ? 1u : 0u; mine = (j == x) ? c : mine; }
        if (sum == G) break;
        __builtin_amdgcn_s_sleep(1);
        if ((++sp & 255u) == 0u) { if (xb_ld(&bar[XB_TMO])) break; if (sp > XB_SPIN_CAP) { atomicAdd(&bar[XB_TMO], 1u); break; } }
    }
    nloc = mine > 0u ? mine : 1u; nx = cnt > 0u ? cnt : 1u;
}
DI void xcd_barrier(const XcdBarrier& b) {
    asm volatile("s_waitcnt vmcnt(0)" ::: "memory");
    __syncthreads();
    if (threadIdx.x == 0) {
        unsigned* bar = b.bar;
        __builtin_amdgcn_s_waitcnt(0);
        unsigned nloc = b.st[0], nx = b.st[1];
        if (nloc == 0u) { xcd_barrier_complete(bar, b.x, nloc, nx); b.st[0] = nloc; b.st[1] = nx; }
        const unsigned old = xb_add(&bar[XB_XSUB(b.x)], 1u);
        const unsigned gen = old / nloc;
        if (old + 1u == (gen + 1u) * nloc) {
            __builtin_amdgcn_fence(__ATOMIC_RELEASE, "agent");
            asm volatile("s_waitcnt vmcnt(0)" ::: "memory");
            const unsigned og = xb_add(&bar[XB_TOP], 1u);
            const unsigned tg = og / nx;
            if (og + 1u == (tg + 1u) * nx) xb_add(&bar[XB_TOPGEN], 1u);
            else XB_SPIN(xb_ld(&bar[XB_TOPGEN]) == tg, bar);
            __builtin_amdgcn_fence(__ATOMIC_ACQUIRE, "agent");
            xb_add(&bar[XB_XGEN(b.x)], 1u);
            asm volatile("s_waitcnt vmcnt(0)" ::: "memory");
        } else {
            XB_SPIN(xb_ld(&bar[XB_XGEN(b.x)]) == gen, bar);
            __builtin_amdgcn_fence(__ATOMIC_ACQUIRE, "agent");
            asm volatile("s_waitcnt vmcnt(0)" ::: "memory");
        }
    }
    __syncthreads();
}

struct Args { const float* in[33]; float* out; unsigned char* ws; int ph_lo, ph_hi; };
struct Frame {
    LAS unsigned char* lds;
    int wave, wg, G;
    const struct Args* A; float* out; unsigned char* ws;
};
enum In { I_X = 0, I_N1G, I_WIN, I_POOLW, I_POOLS, I_CONVW, I_CONVB, I_CLNG, I_CLNB, I_MU, I_W0, I_W2, I_A0, I_A2, I_G2, I_KK, I_KA, I_RK, I_GNG, I_GNB, I_V0, I_V1, I_V2, I_WOUT, I_N2G,
          I_FG, I_FU, I_FD, I_ROUTER, I_MG, I_MU2, I_MD, I_FINALG };

#define LDS_WAIT() asm volatile("s_waitcnt lgkmcnt(0)" ::: "memory")
#define LDS_BAR() do { asm volatile("s_waitcnt lgkmcnt(0)" ::: "memory"); __builtin_amdgcn_s_barrier(); asm volatile("" ::: "memory"); } while (0)
#define PIN_MEM() asm volatile("" ::: "memory")
DI u32x4 ldg16(const bf16* p) { return *(const u32x4*)p; }
struct CvItem { const float* W; bf16* WT; int K, N, k0, n0, drow0; };
DI void cv_load(const CvItem& c, const int lane, f32x4 (&r)[16]) {
#pragma unroll
    for (int i = 0; i < 16; ++i) r[i] = __builtin_nontemporal_load((const f32x4*)(c.W + (size_t)(c.k0 + 4 * i + (lane >> 4)) * c.N + c.n0 + 4 * (lane & 15)));
}
DI bf16x8 cv_trfrag(const LAS unsigned char* img, const int c0, const int kb, const int lane);
template <int F8SC> DI void cv_store(const CvItem& c, const int lane, const f32x4 (&r)[16], LAS unsigned char* img) {
#pragma unroll
    for (int i = 0; i < 16; ++i) { u32x2 w; w.x = pk2(r[i][0], r[i][1]); w.y = pk2(r[i][2], r[i][3]); *(LAS u32x2*)(img + ((4 * i + (lane >> 4)) * 72 + 4 * (lane & 15)) * 2) = w; }
    LDS_WAIT(); asm volatile("" ::: "memory");
#pragma unroll
    for (int nb = 0; nb < 4; ++nb)
#pragma unroll
        for (int kh = 0; kh < 2; ++kh) { const bf16x8 v = cv_trfrag(img, 16 * nb, kh, lane);
            if constexpr (F8SC == 0) *(bf16x8*)(c.WT + (size_t)(c.drow0 + 16 * nb + (lane & 15)) * c.K + c.k0 + 32 * kh + 8 * (lane >> 4)) = v;
            else { float f[8]; unpack8(__builtin_bit_cast(u32x4, v), f); constexpr float sc = (float)F8SC; u32x2 w; w.x = pk4_f8(f[0] * sc, f[1] * sc, f[2] * sc, f[3] * sc); w.y = pk4_f8(f[4] * sc, f[5] * sc, f[6] * sc, f[7] * sc);
                *(u32x2*)((unsigned char*)c.WT + (size_t)(c.drow0 + 16 * nb + (lane & 15)) * c.K + c.k0 + 32 * kh + 8 * (lane >> 4)) = w; } }
    LDS_WAIT(); asm volatile("" ::: "memory");
}
DI CvItem cv_plain(const float* W, int K, int N, bf16* WT, int item) { const int nblk = N / 64, kb = item / nblk, nb = item % nblk; return CvItem{W, WT, K, N, 64 * kb, 64 * nb, 64 * nb}; }
DI CvItem cv_gu(const float* W, int K, int Fh, bf16* WT, int up, int item) { const int nblk = Fh / 64, kb = item / nblk, nb = item % nblk, n0 = 64 * nb; return CvItem{W, WT, K, Fh, 64 * kb, n0, 256 * (n0 / 128) + up * 128 + (n0 % 128)}; }
template <int F8SC, class Desc> DI void cv_run(const Desc& desc, const int nitems, const int first, const int stride, const int lane, LAS float* scr_) {
    if (first >= nitems) return;
    LAS unsigned char* img = (LAS unsigned char*)scr_;
    f32x4 ra[16], rb[16];
    CvItem ca = desc(first), cb = ca;
    cv_load(ca, lane, ra);
    for (int it = first; it < nitems; it += 2 * stride) {
        const bool hb = (it + stride) < nitems;
        if (hb) { cb = desc(it + stride); cv_load(cb, lane, rb); }
        PIN_MEM();
        cv_store<F8SC>(ca, lane, ra, img);
        const bool ha = (it + 2 * stride) < nitems;
        if (ha) { ca = desc(it + 2 * stride); cv_load(ca, lane, ra); }
        PIN_MEM();
        if (hb) cv_store<F8SC>(cb, lane, rb, img);
    }
}

DI void store_row_bf16(bf16* orow, int lane, const f32x4 (&y)[4]) {
    u32x2* o8 = (u32x2*)orow + lane;
#pragma unroll
    for (int j = 0; j < 4; ++j) { u32x2 w; w.x = pk2(y[j].x, y[j].y); w.y = pk2(y[j].z, y[j].w); o8[64 * j] = w; }
}
DI void store_row_f8(unsigned char* orow, int lane, const f32x4 (&y)[4]) {
    unsigned* o4 = (unsigned*)orow + lane;
#pragma unroll
    for (int j = 0; j < 4; ++j) o4[64 * j] = pk4_f8(y[j].x * F8S_X, y[j].y * F8S_X, y[j].z * F8S_X, y[j].w * F8S_X);
}
DI void norm_rows_phase(Frame& F, const float* src, const float* g, bf16* dst) {
    const int lane = (int)threadIdx.x & 63, gw = F.wg * NWAVES + F.wave, NGW = F.G * NWAVES;
    f32x4 cr[2][4], nr[2][4];
#pragma unroll
    for (int q = 0; q < 2; ++q) { const int mq = (gw + q * NGW < M) ? gw + q * NGW : gw;
#pragma unroll
        for (int j = 0; j < 4; ++j) cr[q][j] = ((const f32x4*)(src + (size_t)mq * D) + lane)[64 * j]; }
#pragma unroll 1
    for (int m = gw; m < M; m += 2 * NGW) {
#pragma unroll
        for (int q = 0; q < 2; ++q) { const int mq = (m + (2 + q) * NGW < M) ? m + (2 + q) * NGW : m;
#pragma unroll
            for (int j = 0; j < 4; ++j) nr[q][j] = ((const f32x4*)(src + (size_t)mq * D) + lane)[64 * j]; }
        float ss[2] = {0.f, 0.f};
#pragma unroll
        for (int q = 0; q < 2; ++q)
#pragma unroll
            for (int j = 0; j < 4; ++j) ss[q] += (cr[q][j].x * cr[q][j].x + cr[q][j].y * cr[q][j].y) + (cr[q][j].z * cr[q][j].z + cr[q][j].w * cr[q][j].w);
#pragma unroll
        for (int q = 0; q < 2; ++q) { const float rstd = 1.0f / sqrtf(wave_sum(ss[q]) * (1.f / D) + RMS_EPS); const int mq = m + q * NGW; f32x4 y[4];
#pragma unroll
            for (int j = 0; j < 4; ++j) y[j] = cr[q][j] * rstd * ((const f32x4*)g + lane)[64 * j];
            if (mq < M) store_row_bf16(dst + (size_t)mq * D, lane, y); }
#pragma unroll
        for (int q = 0; q < 2; ++q)
#pragma unroll
            for (int j = 0; j < 4; ++j) cr[q][j] = nr[q][j];
    }
}
template <bool OUT_F32> DI void norm_rows_phase_b(Frame& F, const bf16* src, const float* g, void* dst) {
    const int lane = (int)threadIdx.x & 63, gw = F.wg * NWAVES + F.wave, NGW = F.G * NWAVES;
    f32x4 gg[4];
#pragma unroll
    for (int j = 0; j < 4; ++j) gg[j] = ((const f32x4*)g + lane)[64 * j];
    u32x2 cr[2][4], nr[2][4];
#pragma unroll
    for (int q = 0; q < 2; ++q) { const int mq = (gw + q * NGW < M) ? gw + q * NGW : gw;
#pragma unroll
        for (int j = 0; j < 4; ++j) cr[q][j] = ((const u32x2*)(src + (size_t)mq * D) + lane)[64 * j]; }
#pragma unroll 1
    for (int m = gw; m < M; m += 2 * NGW) {
#pragma unroll
        for (int q = 0; q < 2; ++q) { const int mq = (m + (2 + q) * NGW < M) ? m + (2 + q) * NGW : m;
#pragma unroll
            for (int j = 0; j < 4; ++j) nr[q][j] = ((const u32x2*)(src + (size_t)mq * D) + lane)[64 * j]; }
        f32x4 y[2][4]; float ss[2] = {0.f, 0.f};
#pragma unroll
        for (int q = 0; q < 2; ++q)
#pragma unroll
            for (int j = 0; j < 4; ++j) { const u32x2 v = cr[q][j]; y[q][j] = (f32x4){bflo(v.x), bfhi(v.x), bflo(v.y), bfhi(v.y)}; ss[q] += (y[q][j].x * y[q][j].x + y[q][j].y * y[q][j].y) + (y[q][j].z * y[q][j].z + y[q][j].w * y[q][j].w); }
#pragma unroll
        for (int q = 0; q < 2; ++q) { const float rstd = 1.0f / sqrtf(wave_sum(ss[q]) * (1.f / D) + RMS_EPS); const int mq = m + q * NGW;
#pragma unroll
            for (int j = 0; j < 4; ++j) y[q][j] = y[q][j] * rstd * gg[j];
            if (mq < M) { if constexpr (OUT_F32) { f32x4* o = (f32x4*)((float*)dst + (size_t)mq * D) + lane;
#pragma unroll
                    for (int j = 0; j < 4; ++j) o[64 * j] = y[q][j]; }
                else store_row_bf16((bf16*)dst + (size_t)mq * D, lane, y[q]); } }
#pragma unroll
        for (int q = 0; q < 2; ++q)
#pragma unroll
            for (int j = 0; j < 4; ++j) cr[q][j] = nr[q][j];
    }
}
template <int JOB> DI void convert_main(Frame& F, const int first, const int stride, LAS float* scr) {
    unsigned char* ws = F.ws; const Args* A = F.A;
    constexpr int I_IN = (D / 64) * (NIN / 64), I_OUT = (D / 64) * (D / 64), I_GU = (D / 64) * (FF / 64), I_DN = (FF / 64) * (D / 64);
    if (JOB == 0) {
        auto desc = [=](int it) -> CvItem { return cv_plain(A->in[I_WIN], D, NIN, (bf16*)(ws + WS_WIN), it); };
        cv_run<0>(desc, I_IN, first, stride, ((int)threadIdx.x & 63), scr);
    } else {
        constexpr int NITEMS = I_IN + 2 * I_OUT + 2 * I_GU + I_DN;
        auto desc = [=](int it) -> CvItem {
            int r = it;
            if (r < I_IN) return cv_plain(A->in[I_WIN] + (size_t)D * NIN, D, NIN, (bf16*)(ws + WS_WIN) + (size_t)NIN * D, r); r -= I_IN;
            if (r < 2 * I_OUT) { const int l = r / I_OUT; return cv_plain(A->in[I_WOUT] + (size_t)l * D * D, D, D, (bf16*)(ws + WS_WOUT) + (size_t)l * D * D, r % I_OUT); } r -= 2 * I_OUT;
            if (r < I_GU) return cv_gu(A->in[I_FG], D, FF, (bf16*)(ws + WS_WGU), 0, r); r -= I_GU;
            if (r < I_GU) return cv_gu(A->in[I_FU], D, FF, (bf16*)(ws + WS_WGU), 1, r); r -= I_GU;
            return cv_plain(A->in[I_FD], FF, D, (bf16*)(ws + WS_WDN), r);
        };
        cv_run<0>(desc, NITEMS, first, stride, ((int)threadIdx.x & 63), scr);
    }
}
DI void p0_prologue(Frame& F) {
    LAS float* scr = (LAS float*)(F.lds + F.wave * 16384);
    const int gw = F.wg * NWAVES + F.wave, NGW = F.G * NWAVES;
    unsigned char* ws = F.ws;
    convert_main<0>(F, gw, NGW, scr);
    const int gt = F.wg * NTHR + ((int)threadIdx.x), NGT = F.G * NTHR;
    for (int i = gt; i < 2 * 4 * 64 * 64; i += NGT) { const int c = i & 63, n = (i >> 6) & 63, lg = i >> 12; ((bf16*)(ws + SM_POOLT))[i] = (bf16)(pk2(F.A->in[I_POOLW][(size_t)lg * 4096 + c * 64 + n], 0.f) & 0xffffu); }
    for (int i = gt; i < 2 * 512 * 64; i += NGT) { const int j = i & 63, n = (i >> 6) & 511, l = i >> 15;
        ((bf16*)(ws + SM_W2T))[i] = (bf16)(pk2(F.A->in[I_W2][(size_t)l * 64 * 512 + j * 512 + n], 0.f) & 0xffffu);
        ((bf16*)(ws + SM_A2T))[i] = (bf16)(pk2(F.A->in[I_A2][(size_t)l * 64 * 512 + j * 512 + n], 0.f) & 0xffffu); }
    for (int i = gt; i < 2 * 512 * 128; i += NGT) { const int j = i & 127, n = (i >> 7) & 511, l = i >> 16; ((bf16*)(ws + SM_G2T))[i] = (bf16)(pk2(F.A->in[I_G2][(size_t)l * 128 * 512 + j * 512 + n], 0.f) & 0xffffu); }
    for (int i = gt; i < 32 * 512; i += NGT) { const int c = i & 511, r = i >> 9; ((bf16*)(ws + SM_V1T))[i] = (bf16)(pk2(F.A->in[I_V1][(size_t)c * 32 + r], 0.f) & 0xffffu); }
    for (int i = gt; i < 512 * 32; i += NGT) { const int r = i & 31, n = i >> 5; ((bf16*)(ws + SM_V2T))[i] = (bf16)(pk2(F.A->in[I_V2][(size_t)r * 512 + n], 0.f) & 0xffffu); }
}
template <int JOB> DI void moe_weight_convert(Frame& F, const int first, const int stride, LAS float* scr) {
    constexpr int I_G = (D / 64) * (FE / 64), I_D = (FE / 64) * (D / 64);
    const Args* A = F.A; unsigned char* ws = F.ws;
    if (JOB == 0) {
        auto desc = [=](int it) -> CvItem {
            const int e = it / (2 * I_G); int r = it % (2 * I_G);
            bf16* gu = (bf16*)(ws + WS_WMGU + (size_t)e * 2 * FE * D);
            if (r < I_G) return cv_gu(A->in[I_MG] + (size_t)e * D * FE, D, FE, gu, 0, r);
            return cv_gu(A->in[I_MU2] + (size_t)e * D * FE, D, FE, gu, 1, r - I_G);
        };
        cv_run<(int)F8S_WGU>(desc, NE * 2 * I_G, first, stride, ((int)threadIdx.x & 63), scr);
    } else {
        auto desc = [=](int it) -> CvItem { const int e = it / I_D, r = it % I_D; return cv_plain(A->in[I_MD] + (size_t)e * FE * D, FE, D, (bf16*)(ws + WS_WMDN + (size_t)e * D * FE), r); };
        cv_run<(int)F8S_WDN>(desc, NE * I_D, first, stride, ((int)threadIdx.x & 63), scr);
    }
}

DI void mixc_unit(Frame& F, const int l, const int tile) {
    int tid_ = ((int)threadIdx.x); asm volatile("" : "+v"(tid_));
    const int tid = tid_, lane = tid & 63, wave = __builtin_amdgcn_readfirstlane(tid >> 6);
    const int row0 = tile * 64, tseq = row0 & (T - 1);
    const bf16* proj = (const bf16*)(F.ws + WS_PROJ);
    bf16* mix = (bf16*)(F.ws + WS_MIX);
    u32x4 pv[5]; bool pok[5];
#pragma unroll
    for (int k = 0; k < 5; ++k) { const int idx = tid + k * NTHR, r = idx >> 5, cc = idx & 31; pok[k] = (idx < 79 * 32) && (tseq - 15 + r >= 0); pv[k] = ldg16(proj + (size_t)(pok[k] ? row0 - 15 + r : row0) * NIN + cc * 8); }
    u32x4 ca[6], cb[6]; bool cok[6];
#pragma unroll
    for (int k = 0; k < 6; ++k) { const int idx = tid + k * NTHR, r = idx >> 5, cc = idx & 31; cok[k] = (idx < 94 * 32) && (tseq - 30 + r >= 0); const bf16* p = proj + (size_t)(cok[k] ? row0 - 30 + r : row0) * NIN + cc * 8;
        ca[k] = ldg16(p + C_CONVA); cb[k] = ldg16(p + C_CONVB); }
    const int cch = tid & 255, half = tid >> 8; const float* cw = F.A->in[I_CONVW] + (size_t)l * 31 * 256 + cch; float w[31];
#pragma unroll
    for (int j = 0; j < 31; ++j) w[j] = cw[j * 256];
    const float bias = F.A->in[I_CONVB][l * 256 + cch];
    bf16x8 pfr[4][2]; f32x4 psc[4];
    { const bf16* PT = (const bf16*)(F.ws + SM_POOLT) + (size_t)(l * 4 + (wave >> 1)) * 4096; const float* sc = F.A->in[I_POOLS] + l * 256 + (wave >> 1) * 64;
#pragma unroll
      for (int nt = 0; nt < 4; ++nt) { psc[nt] = *(const f32x4*)(sc + nt * 16 + 4 * (lane >> 4));
#pragma unroll
          for (int ks = 0; ks < 2; ++ks) pfr[nt][ks] = *(const bf16x8*)(PT + (nt * 16 + (lane & 15)) * 64 + ks * 32 + (lane >> 4) * 8); } }
    PIN_MEM();
    LAS bf16* PU = (LAS bf16*)F.lds; LAS bf16* DM = (LAS bf16*)(F.lds + 79 * 264 * 2 + 16);
#pragma unroll
    for (int k = 0; k < 5; ++k) { const int idx = tid + k * NTHR, r = idx >> 5, cc = idx & 31; if (idx < 79 * 32) *(LAS u32x4*)(PU + r * 264 + cc * 8) = pok[k] ? pv[k] : (u32x4){0u, 0u, 0u, 0u}; }
    LDS_BAR();
    {
        const int g = wave >> 1, win = 2 << g, cc = g * 8 + (lane & 7);
#pragma unroll
        for (int it = 0; it < 4; ++it) { const int t = (wave & 1) * 32 + it * 8 + (lane >> 3); const int pos = tseq + t; const int cnt = (pos + 1 < win) ? pos + 1 : win;
            float s[8], u[8];
#pragma unroll
            for (int k = 0; k < 8; ++k) s[k] = 0.f;
            unpack8(*(const LAS u32x4*)(PU + (15 + t) * 264 + cc * 8), u);
            for (int j = 0; j < win; ++j) { float x[8]; unpack8(*(const LAS u32x4*)(PU + (15 + t - j) * 264 + cc * 8), x);
#pragma unroll
                for (int k = 0; k < 8; ++k) s[k] += x[k]; }
            const float inv = 1.0f / (float)cnt;
#pragma unroll
            for (int k = 0; k < 8; ++k) s[k] = s[k] * inv - u[k];
            *(LAS u32x4*)(DM + t * 264 + cc * 8) = pack8(s); }
    }
    LDS_BAR();
    {
        const int g = wave >> 1;
#pragma unroll
        for (int tt2 = 0; tt2 < 2; ++tt2) { const int tt = (wave & 1) * 2 + tt2;
            bf16x8 bfr[2];
#pragma unroll
            for (int ks = 0; ks < 2; ++ks) bfr[ks] = *(const LAS bf16x8*)(DM + (tt * 16 + (lane & 15)) * 264 + g * 64 + ks * 32 + (lane >> 4) * 8);
#pragma unroll
            for (int nt = 0; nt < 4; ++nt) { f32x4 acc = (f32x4){0.f, 0.f, 0.f, 0.f};
#pragma unroll
                for (int ks = 0; ks < 2; ++ks) acc = MFMA16(pfr[nt][ks], bfr[ks], acc);
                const int t = tt * 16 + (lane & 15), col = g * 64 + nt * 16 + 4 * (lane >> 4); const f32x4 s4 = psc[nt];
                u32x2 wv; wv.x = pk2(acc[0] * s4[0], acc[1] * s4[1]); wv.y = pk2(acc[2] * s4[2], acc[3] * s4[3]);
                *(u32x2*)(mix + (size_t)(row0 + t) * D + col) = wv; } }
    }
    LDS_BAR();
    LAS float* U = (LAS float*)F.lds;
#pragma unroll
    for (int k = 0; k < 6; ++k) { const int idx = tid + k * NTHR, r = idx >> 5, cc = idx & 31; float u[8], a[8], b[8]; unpack8(ca[k], a); unpack8(cb[k], b);
#pragma unroll
        for (int e = 0; e < 8; ++e) u[e] = cok[k] ? a[e] * sigmoidf_(b[e]) : 0.f;
        if (idx < 94 * 32) { *(LAS f32x4*)(U + r * 256 + cc * 8) = (f32x4){u[0], u[1], u[2], u[3]}; *(LAS f32x4*)(U + r * 256 + cc * 8 + 4) = (f32x4){u[4], u[5], u[6], u[7]}; } }
    u32x4 vc[8], vp[8];
    if (l == 1) {
#pragma unroll
        for (int k = 0; k < 8; ++k) { const int idx = tid + k * NTHR, t = idx >> 6, cc = idx & 63; const bf16* p = proj + (size_t)(row0 + t) * NIN + C_V + cc * 8; vc[k] = ldg16(p); vp[k] = ldg16(p - ((tseq + t > 0) ? NIN : 0)); }
        PIN_MEM();
    }
    LDS_BAR();
    {
        float y[32];
#pragma unroll
        for (int i = 0; i < 32; ++i) y[i] = bias;
#pragma unroll
        for (int r = 0; r < 62; ++r) { const float val = U[(half * 32 + r) * 256 + cch];
#pragma unroll
            for (int i = 0; i < 32; ++i) { const int j = r - i; if (j >= 0 && j <= 30) y[i] += w[j] * val; } }
        LDS_BAR();
#pragma unroll
        for (int i = 0; i < 32; ++i) U[(half * 32 + i) * 256 + cch] = y[i];
    }
    LDS_BAR();
    {
        const f32x4 lg = *(const f32x4*)(F.A->in[I_CLNG] + l * 256 + lane * 4), lb = *(const f32x4*)(F.A->in[I_CLNB] + l * 256 + lane * 4);
#pragma unroll 2
        for (int i = 0; i < 8; ++i) { const int t = wave * 8 + i; const f32x4 v = *(const LAS f32x4*)(U + t * 256 + lane * 4);
            const float mu = wave_sum((v.x + v.y) + (v.z + v.w)) * (1.f / 256.f); const f32x4 d = v - mu;
            const float var = wave_sum((d.x * d.x + d.y * d.y) + (d.z * d.z + d.w * d.w)) * (1.f / 256.f); const float rstd = 1.0f / sqrtf(var + LN_EPS);
            f32x4 o = d * rstd * lg + lb; u32x2 wv; wv.x = pk2(siluf_(o.x), siluf_(o.y)); wv.y = pk2(siluf_(o.z), siluf_(o.w));
            *(u32x2*)(mix + (size_t)(row0 + t) * D + 256 + lane * 4) = wv; }
    }
    if (l == 1) {
        LDS_BAR();
        LAS bf16* VS = (LAS bf16*)F.lds;
        const float* mu = F.A->in[I_MU] + l * NRC + (C_V - C_R);
#pragma unroll
        for (int k = 0; k < 8; ++k) { const int idx = tid + k * NTHR, t = idx >> 6, cc = idx & 63; float c8[8], p8[8]; unpack8(vc[k], c8); unpack8(vp[k], p8); const bool hp = (tseq + t) > 0;
            const f32x4 m0 = *(const f32x4*)(mu + cc * 8), m1 = *(const f32x4*)(mu + cc * 8 + 4);
#pragma unroll
            for (int e = 0; e < 8; ++e) c8[e] = c8[e] + (e < 4 ? m0[e & 3] : m1[e & 3]) * ((hp ? p8[e] : 0.f) - c8[e]);
            *(LAS u32x4*)(VS + t * 520 + cc * 8) = pack8(c8); }
        LDS_BAR();
        const int tt = wave & 3, rt = wave >> 2; const bf16* V1T = (const bf16*)(F.ws + SM_V1T); f32x4 acc = (f32x4){0.f, 0.f, 0.f, 0.f};
#pragma unroll 4
        for (int ks = 0; ks < 16; ++ks) { const bf16x8 a = *(const bf16x8*)(V1T + (rt * 16 + (lane & 15)) * 512 + ks * 32 + (lane >> 4) * 8);
            const bf16x8 b = *(const LAS bf16x8*)(VS + (tt * 16 + (lane & 15)) * 520 + ks * 32 + (lane >> 4) * 8); acc = MFMA16(a, b, acc); }
        *(f32x4*)((float*)(F.ws + WS_VV1) + (size_t)(row0 + tt * 16 + (lane & 15)) * 32 + rt * 16 + 4 * (lane >> 4)) = acc;
    }
    asm volatile("s_waitcnt vmcnt(0)" ::: "memory");
    LDS_BAR();
}

constexpr int S1_XW = 0, S1_XA = 9216, S1_XG = 18432, S1_XV = 35840;
constexpr int S1_AAB = 40960, S1_AAK = S1_AAB + 9216, S1_ARB = S1_AAK + 9216, S1_ARK = S1_ARB + 9216, S1_MT = S1_ARK + 9216, S1_XT = S1_MT + 9216, S1_TII = S1_XT + 9216;
constexpr int S1_RT = S1_TII + 3072, S1_AT = S1_RT + 9216, S1_BT = S1_AT + 9216, S1_KT = S1_BT + 9216, S1_VN = S1_KT + 9216;
constexpr int S1_WTOT = S1_VN + 9216, S1_NRM = S1_WTOT + 1024, S1_RKX = S1_NRM + 2048, S1_LC = S1_RKX + 2048, S1_MU = S1_LC + 256, S1_END = S1_MU + NRC * 4;
static_assert(S1_XV + 5120 <= S1_AAB && S1_END <= MISC_OFF, "S1 lds map");
#define LD_F8(ptr) (*(const LAS bf16x8*)(ptr))
typedef short s16x4 __attribute__((ext_vector_type(4)));
DI bf16x8 mk8(unsigned a, unsigned b, unsigned c, unsigned d) { u32x4 w = {a, b, c, d}; return __builtin_bit_cast(bf16x8, w); }
DI u32x2 pk4f(const f32x4 v) { u32x2 p; p.x = pk2(v[0], v[1]); p.y = pk2(v[2], v[3]); return p; }
DI f32x4 up4(const u32x2 v) { return (f32x4){bflo(v.x), bfhi(v.x), bflo(v.y), bfhi(v.y)}; }
DI bf16x8 mk8h(const u32x2 p) { return mk8(p.x, p.y, 0u, 0u); }
DI u32x2 tr_read(const LAS unsigned char* p) { return __builtin_bit_cast(u32x2, __builtin_amdgcn_ds_read_tr16_b64_v4i16((LAS s16x4*)p)); }
DI const LAS unsigned char* tr_addr(const LAS unsigned char* img, const int r0, const int c0, const int lane) { return img + ((r0 + ((lane & 15) >> 2)) * 72 + c0 + 4 * (lane & 3)) * 2; }
DI bf16x8 tr_frag(const LAS unsigned char* img, const int c0, const int kb, const int lane) {
    const int r0 = 32 * kb + 8 * (lane >> 4);
    const u32x2 lo = tr_read(tr_addr(img, r0, c0, lane)), hi = tr_read(tr_addr(img, r0 + 4, c0, lane));
    return mk8(lo.x, lo.y, hi.x, hi.y);
}
DI bf16x8 cv_trfrag(const LAS unsigned char* img, const int c0, const int kb, const int lane) { return tr_frag(img, c0, kb, lane); }
DI void shift8(const u32x4 cur, const u32x4 prev, const bool hasprev, const LAS unsigned char* L, const int col, float (&o)[8]) {
    float c8[8], p8[8]; unpack8(cur, c8); unpack8(prev, p8);
    const f32x4 m0 = *(const LAS f32x4*)(L + S1_MU + (col - C_R) * 4), m1 = *(const LAS f32x4*)(L + S1_MU + (col - C_R + 4) * 4);
#pragma unroll
    for (int k = 0; k < 8; ++k) o[k] = c8[k] + (k < 4 ? m0[k & 3] : m1[k & 3]) * ((hasprev ? p8[k] : 0.f) - c8[k]);
}
DI f32x4 shift4(const u32x2 cur, const u32x2 prev, const bool hasprev, const LAS unsigned char* L, const int col) {
    const f32x4 c = up4(cur), p = hasprev ? up4(prev) : (f32x4){0.f, 0.f, 0.f, 0.f}, m = *(const LAS f32x4*)(L + S1_MU + (col - C_R) * 4);
    return c + m * (p - c);
}
DI void s1_stage_mu(Frame& F, const int l) {
    for (int i = ((int)threadIdx.x); i < NRC / 4; i += NTHR) *(LAS f32x4*)(F.lds + S1_MU + i * 16) = *(const f32x4*)(F.A->in[I_MU] + l * NRC + i * 4);
    LDS_BAR();
}
DI void s1_chunk_prep(Frame& F, const int l, const int gchunk) {
    int tid_ = ((int)threadIdx.x); asm volatile("" : "+v"(tid_));
    const int t = tid_ >> 3, n8 = tid_ & 7, row0 = gchunk * 64;
    const bool hasprev = ((row0 & (T - 1)) + t) > 0;
    const bf16* prow = (const bf16*)(F.ws + WS_PROJ) + (size_t)(row0 + t) * NIN; const bf16* pprev = prow - (hasprev ? NIN : 0);
    LAS unsigned char* L = F.lds;
    const u32x4 cxw = ldg16(prow + C_XW + n8 * 8), pxw = ldg16(pprev + C_XW + n8 * 8), cxa = ldg16(prow + C_XA + n8 * 8), pxa = ldg16(pprev + C_XA + n8 * 8);
    const u32x4 cg0 = ldg16(prow + C_XG + n8 * 16), pg0 = ldg16(pprev + C_XG + n8 * 16), cg1 = ldg16(prow + C_XG + n8 * 16 + 8), pg1 = ldg16(pprev + C_XG + n8 * 16 + 8);
    f32x4 vv1 = (f32x4){0.f, 0.f, 0.f, 0.f}; if (l == 1) vv1 = *(const f32x4*)((const float*)(F.ws + WS_VV1) + (size_t)(row0 + t) * 32 + n8 * 4);
    PIN_MEM();
    float x[8];
    shift8(cxw, pxw, hasprev, L, C_XW + n8 * 8, x);
#pragma unroll
    for (int k = 0; k < 8; ++k) { const float e = fast_exp(2.0f * x[k]); x[k] = 1.0f - 2.0f * __builtin_amdgcn_rcpf(e + 1.0f); }
    *(LAS u32x4*)(L + S1_XW + (t * 72 + n8 * 8) * 2) = pack8(x);
    shift8(cxa, pxa, hasprev, L, C_XA + n8 * 8, x);
    *(LAS u32x4*)(L + S1_XA + (t * 72 + n8 * 8) * 2) = pack8(x);
    shift8(cg0, pg0, hasprev, L, C_XG + n8 * 16, x);
#pragma unroll
    for (int k = 0; k < 8; ++k) x[k] = sigmoidf_(x[k]);
    *(LAS u32x4*)(L + S1_XG + (t * 136 + n8 * 16) * 2) = pack8(x);
    shift8(cg1, pg1, hasprev, L, C_XG + n8 * 16 + 8, x);
#pragma unroll
    for (int k = 0; k < 8; ++k) x[k] = sigmoidf_(x[k]);
    *(LAS u32x4*)(L + S1_XG + (t * 136 + n8 * 16 + 8) * 2) = pack8(x);
    if (l == 1) *(LAS u32x2*)(L + S1_XV + (t * 40 + n8 * 4) * 2) = pk4f(vv1);
    LDS_BAR();
}
struct S1Pre { u32x2 cr[2], pr[2], ck[2], pk[2], cv[2], pv[2], vf[2]; };
DI void s1_issue(Frame& F, const int l, const int gchunk, const int h, S1Pre& P) {
    int tid_ = ((int)threadIdx.x); asm volatile("" : "+v"(tid_));
    const int lane = tid_ & 63, wave = tid_ >> 6, t = 16 * (wave & 3) + (lane & 15), row0 = gchunk * 64;
    const bool hasprev = ((row0 & (T - 1)) + t) > 0;
    const bf16* prow = (const bf16*)(F.ws + WS_PROJ) + (size_t)(row0 + t) * NIN; const bf16* pprev = prow - (hasprev ? NIN : 0);
#pragma unroll
    for (int nn = 0; nn < 2; ++nn) { const int c = h * 64 + (2 * (wave >> 2) + nn) * 16 + 4 * (lane >> 4);
        P.cr[nn] = *(const u32x2*)(prow + C_R + c); P.pr[nn] = *(const u32x2*)(pprev + C_R + c); P.ck[nn] = *(const u32x2*)(prow + C_K + c); P.pk[nn] = *(const u32x2*)(pprev + C_K + c);
        P.cv[nn] = *(const u32x2*)(prow + C_V + c); P.pv[nn] = *(const u32x2*)(pprev + C_V + c);
        P.vf[nn] = (l == 1) ? *(const u32x2*)((const bf16*)(F.ws + WS_VF) + (size_t)(row0 + t) * RW + c) : P.cv[nn]; }
    PIN_MEM();
}

DI void s1_unit(Frame& F, const int l, const int gchunk, const int h, const S1Pre& pre, const int hn, S1Pre& nxt) {
    int tid_ = ((int)threadIdx.x); asm volatile("" : "+v"(tid_));
    const int tid = tid_, lane = tid & 63, wave = __builtin_amdgcn_readfirstlane(tid >> 6), fr = lane & 15, fq = lane >> 4;
    const int row0 = gchunk * 64, tseq0 = row0 & (T - 1), unit = gchunk * 8 + h;
    const int tt = wave & 3, nh = wave >> 2, t = 16 * tt + fr;
    const bool hasprev = (tseq0 + t) > 0;
    LAS unsigned char* L = F.lds;
    bf16x8 fw[2][2], fa[2][2], fg[2][4], fv[2];
    f32x4 cw0[2], ca0[2], ckk[2], cka[2], crk[2], cv0[2];
    {
        const bf16* W2T = (const bf16*)(F.ws + SM_W2T) + (size_t)(l * 512 + h * 64) * 64; const bf16* A2T = (const bf16*)(F.ws + SM_A2T) + (size_t)(l * 512 + h * 64) * 64;
        const bf16* G2T = (const bf16*)(F.ws + SM_G2T) + (size_t)(l * 512 + h * 64) * 128; const bf16* V2T = (const bf16*)(F.ws + SM_V2T) + (size_t)(h * 64) * 32;
#pragma unroll
        for (int nn = 0; nn < 2; ++nn) { const int nr = (nh * 2 + nn) * 16 + fr, hc = h * 64 + (nh * 2 + nn) * 16 + 4 * fq;
#pragma unroll
            for (int ks = 0; ks < 2; ++ks) { fw[nn][ks] = *(const bf16x8*)(W2T + nr * 64 + ks * 32 + fq * 8); fa[nn][ks] = *(const bf16x8*)(A2T + nr * 64 + ks * 32 + fq * 8); }
#pragma unroll
            for (int ks = 0; ks < 4; ++ks) fg[nn][ks] = *(const bf16x8*)(G2T + nr * 128 + ks * 32 + fq * 8);
            fv[nn] = (l == 1) ? *(const bf16x8*)(V2T + nr * 32 + fq * 8) : fw[nn][0];
            cw0[nn] = *(const f32x4*)(F.A->in[I_W0] + l * RW + hc); ca0[nn] = *(const f32x4*)(F.A->in[I_A0] + l * RW + hc); ckk[nn] = *(const f32x4*)(F.A->in[I_KK] + l * RW + hc);
            cka[nn] = *(const f32x4*)(F.A->in[I_KA] + l * RW + hc); crk[nn] = *(const f32x4*)(F.A->in[I_RK] + l * RW + hc); cv0[nn] = (l == 1) ? *(const f32x4*)(F.A->in[I_V0] + hc) : cw0[nn]; }
    }
    PIN_MEM();
    f32x4 lw[2], cs[2], av[2], kk[2], km[2], vm[2], r4[2], k4[2], v4[2];
    float nrm = 0.f, rk = 0.f;
#pragma unroll
    for (int nn = 0; nn < 2; ++nn) { const int c0 = h * 64 + (nh * 2 + nn) * 16 + 4 * fq;
        r4[nn] = shift4(pre.cr[nn], pre.pr[nn], hasprev, L, C_R + c0); k4[nn] = shift4(pre.ck[nn], pre.pk[nn], hasprev, L, C_K + c0); v4[nn] = shift4(pre.cv[nn], pre.pv[nn], hasprev, L, C_V + c0); }
#pragma unroll
    for (int nn = 0; nn < 2; ++nn) { const int nt = nh * 2 + nn; f32x4 aw = (f32x4){0.f, 0.f, 0.f, 0.f}, aa = aw, ag = aw, ap = aw;
#pragma unroll
        for (int ks = 0; ks < 2; ++ks) { const int ko = ks * 32 + fq * 8;
            aw = MFMA16(fw[nn][ks], LD_F8(L + S1_XW + (t * 72 + ko) * 2), aw);
            aa = MFMA16(fa[nn][ks], LD_F8(L + S1_XA + (t * 72 + ko) * 2), aa); }
#pragma unroll
        for (int ks = 0; ks < 4; ++ks) ag = MFMA16(fg[nn][ks], LD_F8(L + S1_XG + (t * 136 + ks * 32 + fq * 8) * 2), ag);
        if (l == 1) ap = MFMA16(fv[nn], LD_F8(L + S1_XV + (t * 40 + fq * 8) * 2), ap);
        *(u32x2*)((bf16*)(F.ws + WS_GB) + (size_t)(row0 + t) * RW + h * 64 + nt * 16 + 4 * fq) = pk4f(ag);
        const int c0 = h * 64 + nt * 16 + 4 * fq;
        const f32x4 vf4 = up4(pre.vf[nn]);
#pragma unroll
        for (int j = 0; j < 4; ++j) {
            const float x = -(cw0[nn][j] + aw[j]);
            const float sp = fmaxf(x, 0.f) + __logf(1.0f + __expf(-fabsf(x)));
            lw[nn][j] = -__expf(-sp - 0.5f);
            av[nn][j] = __builtin_amdgcn_rcpf(1.0f + __expf(-(ca0[nn][j] + aa[j])));
            kk[nn][j] = k4[nn][j] * ckk[nn][j]; nrm += kk[nn][j] * kk[nn][j];
            km[nn][j] = k4[nn][j] * (1.0f + (av[nn][j] - 1.0f) * cka[nn][j]);
            rk += r4[nn][j] * km[nn][j] * crk[nn][j];
            vm[nn][j] = (l == 1) ? v4[nn][j] + (vf4[j] - v4[nn][j]) * __builtin_amdgcn_rcpf(1.0f + __expf(-(cv0[nn][j] + ap[j]))) : v4[nn][j];
        }
        cs[nn] = lw[nn];
        *(u32x2*)((bf16*)(F.ws + (l == 0 ? WS_VF : WS_VMB)) + (size_t)(row0 + t) * RW + c0) = pk4f(vm[nn]);
    }
    *(LAS float*)(L + S1_NRM + (t * 8 + nh * 4 + fq) * 4) = nrm; *(LAS float*)(L + S1_RKX + (t * 8 + nh * 4 + fq) * 4) = rk;
#pragma unroll
    for (int nn = 0; nn < 2; ++nn)
#pragma unroll
        for (int j = 0; j < 4; ++j) cs[nn][j] = row_scan16(cs[nn][j]);
    if (fr == 15) {
#pragma unroll
        for (int nn = 0; nn < 2; ++nn) *(LAS f32x4*)(L + S1_WTOT + (tt * 64 + (nh * 2 + nn) * 16 + 4 * fq) * 4) = cs[nn]; }
    LDS_BAR();
    {
        const f32x4 na = *(const LAS f32x4*)(L + S1_NRM + t * 32), nb = *(const LAS f32x4*)(L + S1_NRM + t * 32 + 16);
        const float n2 = ((na[0] + na[1]) + (na[2] + na[3])) + ((nb[0] + nb[1]) + (nb[2] + nb[3]));
        const float inv = __builtin_amdgcn_rsqf(fmaxf(n2, 1e-24f));
        if (nh == 0 && fq == 0) { const f32x4 ra = *(const LAS f32x4*)(L + S1_RKX + t * 32), rb = *(const LAS f32x4*)(L + S1_RKX + t * 32 + 16); ((float*)(F.ws + WS_RKB))[(size_t)(row0 + t) * 8 + h] = ((ra[0] + ra[1]) + (ra[2] + ra[3])) + ((rb[0] + rb[1]) + (rb[2] + rb[3])); }
#pragma unroll
        for (int nn = 0; nn < 2; ++nn) { const int nc = (nh * 2 + nn) * 16 + 4 * fq;
            f32x4 off = (f32x4){0.f, 0.f, 0.f, 0.f}, tot = off;
#pragma unroll
            for (int w = 0; w < 4; ++w) { const f32x4 x = *(const LAS f32x4*)(L + S1_WTOT + (w * 64 + nc) * 4); tot = tot + x; if (w < tt) off = off + x; }
            f32x4 rt, kt, at, bt;
#pragma unroll
            for (int j = 0; j < 4; ++j) { const float Lc = cs[nn][j] + off[j];
                const float eL = __expf(Lc), eN = __expf(-Lc), eP = __expf(Lc - lw[nn][j]); const float kkn = kk[nn][j] * inv;
                rt[j] = r4[nn][j] * eL; kt[j] = km[nn][j] * eN; at[j] = -kkn * eP; bt[j] = kkn * av[nn][j] * eN; }
            if (tt == 0 && fr == 0) *(LAS f32x4*)(L + S1_LC + nc * 4) = tot;
            const int on = (t * 72 + nc) * 2;
            *(LAS u32x2*)(L + S1_RT + on) = pk4f(rt); *(LAS u32x2*)(L + S1_AT + on) = pk4f(at); *(LAS u32x2*)(L + S1_BT + on) = pk4f(bt); *(LAS u32x2*)(L + S1_KT + on) = pk4f(kt); *(LAS u32x2*)(L + S1_VN + on) = pk4f(vm[nn]); }
    }
    LDS_BAR();
    f32x4 rhs[4];
    {
        const int mi = wave >> 1, par = wave & 1;
        const int xo = (mi < 2) ? S1_AT : S1_RT, yo = (mi & 1) ? S1_KT : S1_BT, dst = S1_AAB + mi * 9216;
        int idx = 0;
#pragma unroll
        for (int ti = 0; ti < 4; ++ti)
#pragma unroll
            for (int si = 0; si < 4; ++si, ++idx) {
                if ((idx & 1) != par) continue;
                u32x2 w = {0u, 0u};
                if (si <= ti) {
                    f32x4 acc = (f32x4){0.f, 0.f, 0.f, 0.f};
#pragma unroll
                    for (int ks = 0; ks < 2; ++ks) acc = MFMA16(LD_F8(L + yo + ((si * 16 + fr) * 72 + ks * 32 + fq * 8) * 2), LD_F8(L + xo + ((ti * 16 + fr) * 72 + ks * 32 + fq * 8) * 2), acc);
                    if (si == ti) {
#pragma unroll
                        for (int j = 0; j < 4; ++j) { const int sl = 4 * fq + j; const bool keep = (mi < 2) ? (sl < fr) : (sl <= fr); acc[j] = keep ? acc[j] : 0.f; }
                    }
                    w = pk4f(acc);
                }
                *(LAS u32x2*)(L + dst + ((ti * 16 + fr) * 72 + si * 16 + 4 * fq) * 2) = w;
            }
    }
    if (wave < 4) {
        const f32x4 z4 = (f32x4){0.f, 0.f, 0.f, 0.f};
        f32x4 va = z4, ua = z4;
#pragma unroll
        for (int ks = 0; ks < 2; ++ks) { const bf16x8 fA = LD_F8(L + S1_AT + ((wave * 16 + fr) * 72 + ks * 32 + fq * 8) * 2), fB = LD_F8(L + S1_BT + ((wave * 16 + fr) * 72 + ks * 32 + fq * 8) * 2);
            va = MFMA16(fB, fA, va); ua = MFMA16(fA, fB, ua); }
#pragma unroll
        for (int j = 0; j < 4; ++j) { va[j] = (4 * fq + j < fr) ? va[j] : 0.f; ua[j] = (fr < 4 * fq + j) ? ua[j] : 0.f; }
        const u32x2 v0 = pk4f(va), u0 = pk4f(ua);
        f32x4 w1 = up4(v0);
#pragma unroll
        for (int j = 0; j < 4; ++j) w1[j] += (4 * fq + j == fr) ? 1.0f : 0.0f;
        const u32x2 w1p = pk4f(w1);
        const u32x2 u1 = pk4f(MFMA16(mk8h(v0), mk8h(u0), z4)), v1 = pk4f(MFMA16(mk8h(u0), mk8h(v0), z4));
        const f32x4 w2 = MFMA16(mk8h(u1), mk8h(w1p), w1); const u32x2 w2p = pk4f(w2);
        const u32x2 u2 = pk4f(MFMA16(mk8h(v1), mk8h(u1), z4)), v2 = pk4f(MFMA16(mk8h(u1), mk8h(v1), z4));
        const f32x4 w3 = MFMA16(mk8h(u2), mk8h(w2p), w2); const u32x2 w3p = pk4f(w3);
        const u32x2 u3 = pk4f(MFMA16(mk8h(v2), mk8h(u2), z4));
        const f32x4 w4 = MFMA16(mk8h(u3), mk8h(w3p), w3);
        *(LAS u32x2*)(L + S1_TII + ((wave * 16 + fr) * 24 + 4 * fq) * 2) = pk4f(w4);
#pragma unroll
        for (int i = 0; i < 4; ++i) rhs[i] = up4(tr_read(tr_addr(L + S1_AT, 16 * i + 4 * fq, wave * 16, lane)));
    }
    s1_issue(F, l, gchunk, hn, nxt);
    LDS_BAR();
    {
        if (wave >= 4) {
            bf16x8 vfr2[2];
#pragma unroll
            for (int ks = 0; ks < 2; ++ks) vfr2[ks] = tr_frag(L + S1_VN, (wave - 4) * 16, ks, lane);
#pragma unroll
            for (int i = 0; i < 4; ++i) { f32x4 acc = (f32x4){0.f, 0.f, 0.f, 0.f};
#pragma unroll
                for (int ks = 0; ks < 2; ++ks) acc = MFMA16(LD_F8(L + S1_AAK + ((i * 16 + fr) * 72 + ks * 32 + fq * 8) * 2), vfr2[ks], acc);
                rhs[i] = acc; }
        }
        const f32x4 z4 = (f32x4){0.f, 0.f, 0.f, 0.f};
        u32x2 sp[4];
#define TII_FRAG(i) mk8h(*(const LAS u32x2*)(L + S1_TII + (((i) * 16 + fr) * 24 + 4 * fq) * 2))
#define AAB_P(i, j0) (*(const LAS u32x2*)(L + S1_AAB + (((i) * 16 + fr) * 72 + (j0) * 16 + 4 * fq) * 2))
        const u32x2 z2 = {0u, 0u};
        sp[0] = pk4f(MFMA16(TII_FRAG(0), mk8h(pk4f(rhs[0])), z4));
        { const u32x2 a = AAB_P(1, 0); const f32x4 a1 = MFMA16(mk8(a.x, a.y, 0u, 0u), mk8h(sp[0]), rhs[1]); sp[1] = pk4f(MFMA16(TII_FRAG(1), mk8h(pk4f(a1)), z4)); }
        { const u32x2 a = AAB_P(2, 0), b = AAB_P(2, 1); const f32x4 a2 = MFMA16(mk8(a.x, a.y, b.x, b.y), mk8(sp[0].x, sp[0].y, sp[1].x, sp[1].y), rhs[2]); sp[2] = pk4f(MFMA16(TII_FRAG(2), mk8h(pk4f(a2)), z4)); }
        { const u32x2 a = AAB_P(3, 0), b = AAB_P(3, 1), c = AAB_P(3, 2); f32x4 a3 = MFMA16(mk8(a.x, a.y, b.x, b.y), mk8(sp[0].x, sp[0].y, sp[1].x, sp[1].y), rhs[3]);
          a3 = MFMA16(mk8(c.x, c.y, 0u, 0u), mk8h(sp[2]), a3); sp[3] = pk4f(MFMA16(TII_FRAG(3), mk8h(pk4f(a3)), z4)); }
        (void)z2;
#undef TII_FRAG
#undef AAB_P
        const int dsto = (wave < 4) ? (S1_MT + ((wave * 16 + fr) * 72) * 2) : (S1_XT + (((wave - 4) * 16 + fr) * 72) * 2);
#pragma unroll
        for (int i = 0; i < 4; ++i) *(LAS u32x2*)(L + dsto + (16 * i + 4 * fq) * 2) = sp[i];
    }
    LDS_BAR();
    {
        bf16* ZB = (bf16*)(F.ws + WS_ZB) + (size_t)unit * 4096; bf16* Y0B = (bf16*)(F.ws + WS_Y0B) + (size_t)unit * 4096;
        bf16* PTB = (bf16*)(F.ws + WS_PTB) + (size_t)unit * 4096; bf16* QB = (bf16*)(F.ws + WS_QB) + (size_t)unit * 4096;
        const int ta = wave >> 1;
        const int ra = ((ta * 16 + fr) * 72 + fq * 8) * 2;
        bf16x8 fmt[2], fxt[2], fvn[2], fbt[2], fkt[2];
#pragma unroll
        for (int ks = 0; ks < 2; ++ks) { fmt[ks] = LD_F8(L + S1_MT + ra + ks * 64); fxt[ks] = LD_F8(L + S1_XT + ra + ks * 64); fvn[ks] = tr_frag(L + S1_VN, ta * 16, ks, lane); fbt[ks] = tr_frag(L + S1_BT, ta * 16, ks, lane); fkt[ks] = tr_frag(L + S1_KT, ta * 16, ks, lane); }
        const f32x4 lc = *(const LAS f32x4*)(L + S1_LC + (ta * 16 + 4 * fq) * 4);
#pragma unroll
        for (int ii = 0; ii < 2; ++ii) { const int tb = (wave & 1) * 2 + ii;
            const int rb = ((tb * 16 + fr) * 72 + fq * 8) * 2;
            const int so = (tb * 16 + fr) * 64 + 16 * fq + 4 * ta;
            bf16x8 frb[2], frk[2], fbc[2], fxc[2], fvc[2];
#pragma unroll
            for (int ks = 0; ks < 2; ++ks) { frb[ks] = LD_F8(L + S1_ARB + rb + ks * 64); frk[ks] = LD_F8(L + S1_ARK + rb + ks * 64); fbc[ks] = tr_frag(L + S1_BT, tb * 16, ks, lane); fxc[ks] = LD_F8(L + S1_XT + rb + ks * 64); fvc[ks] = tr_frag(L + S1_VN, tb * 16, ks, lane); }
            {
                f32x4 acc = (f32x4){0.f, 0.f, 0.f, 0.f};
#pragma unroll
                for (int ks = 0; ks < 2; ++ks) acc = MFMA16(fmt[ks], frb[ks], acc);
                acc = acc + up4(*(const LAS u32x2*)(L + S1_RT + ((tb * 16 + fr) * 72 + ta * 16 + 4 * fq) * 2));
                *(u32x2*)(ZB + so) = pk4f(acc); }
            {
                f32x4 acc = (f32x4){0.f, 0.f, 0.f, 0.f};
#pragma unroll
                for (int ks = 0; ks < 2; ++ks) { acc = MFMA16(fxt[ks], frb[ks], acc); acc = MFMA16(fvn[ks], frk[ks], acc); }
                *(u32x2*)(Y0B + so) = pk4f(acc); }
            {
                f32x4 acc = (f32x4){0.f, 0.f, 0.f, 0.f};
#pragma unroll
                for (int ks = 0; ks < 2; ++ks) acc = MFMA16(fmt[ks], fbc[ks], acc);
                const float dn = __expf(*(const LAS float*)(L + S1_LC + (tb * 16 + fr) * 4));
#pragma unroll
                for (int j = 0; j < 4; ++j) acc[j] = (acc[j] + ((ta == tb && 4 * fq + j == fr) ? 1.0f : 0.0f)) * dn;
                *(u32x2*)(PTB + (tb * 16 + fr) * 64 + 32 * (ta >> 1) + 8 * fq + 4 * (ta & 1)) = pk4f(acc); }
            {
                f32x4 acc = (f32x4){0.f, 0.f, 0.f, 0.f};
#pragma unroll
                for (int ks = 0; ks < 2; ++ks) { acc = MFMA16(fbt[ks], fxc[ks], acc); acc = MFMA16(fkt[ks], fvc[ks], acc); }
#pragma unroll
                for (int j = 0; j < 4; ++j) acc[j] *= __expf(lc[j]);
                *(u32x2*)(QB + so) = pk4f(acc); }
        }
    }
}
struct S2Buf { bf16x8 pa[4][2]; u32x4 q0, q1; };
DI void s2_load(S2Buf& B, const bf16* PT, const bf16* Q, const int fr, const int fq, const int vs) {
#pragma unroll
    for (int io = 0; io < 4; ++io)
#pragma unroll
        for (int kb = 0; kb < 2; ++kb) B.pa[io][kb] = *(const bf16x8*)(PT + (16 * io + fr) * 64 + 32 * kb + 8 * fq);
    B.q0 = *(const u32x4*)(Q + (16 * vs + fr) * 64 + 16 * fq); B.q1 = *(const u32x4*)(Q + (16 * vs + fr) * 64 + 16 * fq + 8);
    PIN_MEM();
}
DI void s2_step(const S2Buf& B, f32x4 (&acc)[4], bf16* SBu, const int fr, const int fq, const int vs) {
    u32x4 bw[2];
#pragma unroll
    for (int kb = 0; kb < 2; ++kb) { bw[kb].x = pk2(acc[2 * kb][0], acc[2 * kb][1]); bw[kb].y = pk2(acc[2 * kb][2], acc[2 * kb][3]); bw[kb].z = pk2(acc[2 * kb + 1][0], acc[2 * kb + 1][1]); bw[kb].w = pk2(acc[2 * kb + 1][2], acc[2 * kb + 1][3]);
        *(u32x4*)(SBu + (16 * vs + fr) * 64 + 16 * fq + 8 * kb) = bw[kb]; }
    const unsigned qw[8] = {B.q0.x, B.q0.y, B.q0.z, B.q0.w, B.q1.x, B.q1.y, B.q1.z, B.q1.w};
#pragma unroll
    for (int io = 0; io < 4; ++io) { f32x4 c = (f32x4){bflo(qw[2 * io]), bfhi(qw[2 * io]), bflo(qw[2 * io + 1]), bfhi(qw[2 * io + 1])};
#pragma unroll
        for (int kb = 0; kb < 2; ++kb) c = MFMA16(B.pa[io][kb], __builtin_bit_cast(bf16x8, bw[kb]), c);
        acc[io] = c; }
    PIN_MEM();
}
DI void s2_phase(Frame& F, const int l) {
    if (F.wg >= 128 || F.wave != 0) {
        const int widx = (F.wg < 128) ? F.wg * 7 + (F.wave - 1) : 896 + (F.wg - 128) * 8 + F.wave;
        LAS float* scr = (LAS float*)(F.lds + F.wave * 16384);
        if (l == 0) convert_main<1>(F, widx, 1920, scr); else moe_weight_convert<0>(F, widx, 1920, scr);
        return;
    }
    const int seq = F.wg >> 2, vs = F.wg & 3, b = seq >> 3, h = seq & 7, fr = ((int)threadIdx.x & 63) & 15, fq = ((int)threadIdx.x & 63) >> 4;
    const bf16* PTB = (const bf16*)(F.ws + WS_PTB); const bf16* QB = (const bf16*)(F.ws + WS_QB); bf16* SB = (bf16*)(F.ws + WS_SB);
    f32x4 acc[4];
#pragma unroll
    for (int i = 0; i < 4; ++i) acc[i] = (f32x4){0.f, 0.f, 0.f, 0.f};
    const size_t u0 = ((size_t)b * 128 * 8 + h) * 4096;
    S2Buf B0, B1, B2, B3;
    s2_load(B0, PTB + u0, QB + u0, fr, fq, vs); s2_load(B1, PTB + u0 + 32768, QB + u0 + 32768, fr, fq, vs); s2_load(B2, PTB + u0 + 2 * 32768, QB + u0 + 2 * 32768, fr, fq, vs);
#pragma unroll 1
    for (int c = 0; c < 128; c += 4) {
        const size_t uc = u0 + (size_t)c * 32768;
        const size_t un = (c + 4 < 128) ? uc + 4 * 32768 : uc;
        s2_load(B3, PTB + uc + 3 * 32768, QB + uc + 3 * 32768, fr, fq, vs);
        s2_step(B0, acc, SB + uc, fr, fq, vs);
        s2_load(B0, PTB + un, QB + un, fr, fq, vs);
        s2_step(B1, acc, SB + uc + 32768, fr, fq, vs);
        s2_load(B1, PTB + un + 32768, QB + un + 32768, fr, fq, vs);
        s2_step(B2, acc, SB + uc + 2 * 32768, fr, fq, vs);
        s2_load(B2, PTB + un + 2 * 32768, QB + un + 2 * 32768, fr, fq, vs);
        s2_step(B3, acc, SB + uc + 3 * 32768, fr, fq, vs);
    }
}
DI void s3_phase(Frame& F, const int l) {
    const int fr = ((int)threadIdx.x & 63) & 15, fq = ((int)threadIdx.x & 63) >> 4;
    const bf16* VM = (const bf16*)(F.ws + (l == 0 ? WS_VF : WS_VMB)); const bf16* GB = (const bf16*)(F.ws + WS_GB); const float* RKB = (const float*)(F.ws + WS_RKB);
    bf16* mix = (bf16*)(F.ws + WS_MIX);
    for (int u = F.wg * NWAVES + F.wave; u < (M / 64) * NH; u += F.G * NWAVES) {
        const int gchunk = u >> 3, h = u & 7, row0 = gchunk * 64;
        const bf16* SBu = (const bf16*)(F.ws + WS_SB) + (size_t)u * 4096; const bf16* ZBu = (const bf16*)(F.ws + WS_ZB) + (size_t)u * 4096; const bf16* Y0u = (const bf16*)(F.ws + WS_Y0B) + (size_t)u * 4096;
        bf16x8 sa[4][2], zf[4][2]; u32x4 y0a[4], y0b[4]; float rkv[4];
#pragma unroll
        for (int vt = 0; vt < 4; ++vt)
#pragma unroll
            for (int kb = 0; kb < 2; ++kb) sa[vt][kb] = *(const bf16x8*)(SBu + (16 * vt + fr) * 64 + 16 * fq + 8 * kb);
#pragma unroll
        for (int tt = 0; tt < 4; ++tt) { const int t = 16 * tt + fr; zf[tt][0] = *(const bf16x8*)(ZBu + t * 64 + 16 * fq); zf[tt][1] = *(const bf16x8*)(ZBu + t * 64 + 16 * fq + 8);
            y0a[tt] = *(const u32x4*)(Y0u + t * 64 + 16 * fq); y0b[tt] = *(const u32x4*)(Y0u + t * 64 + 16 * fq + 8); rkv[tt] = RKB[(size_t)(row0 + t) * 8 + h]; }
        f32x4 gg[4], gb[4];
#pragma unroll
        for (int vt = 0; vt < 4; ++vt) { gg[vt] = *(const f32x4*)(F.A->in[I_GNG] + l * RW + h * 64 + 16 * vt + 4 * fq); gb[vt] = *(const f32x4*)(F.A->in[I_GNB] + l * RW + h * 64 + 16 * vt + 4 * fq); }
        PIN_MEM();
#pragma unroll
        for (int tt = 0; tt < 4; ++tt) {
            const int t = 16 * tt + fr;
            u32x2 vmr[4], ggr[4];
#pragma unroll
            for (int vt = 0; vt < 4; ++vt) { const size_t o = (size_t)(row0 + t) * RW + h * 64 + 16 * vt + 4 * fq; vmr[vt] = *(const u32x2*)(VM + o); ggr[vt] = *(const u32x2*)(GB + o); }
            const unsigned yw[8] = {y0a[tt].x, y0a[tt].y, y0a[tt].z, y0a[tt].w, y0b[tt].x, y0b[tt].y, y0b[tt].z, y0b[tt].w};
            f32x4 y[4]; float s = 0.f;
#pragma unroll
            for (int vt = 0; vt < 4; ++vt) { f32x4 c = (f32x4){bflo(yw[2 * vt]), bfhi(yw[2 * vt]), bflo(yw[2 * vt + 1]), bfhi(yw[2 * vt + 1])};
                c = MFMA16(sa[vt][0], zf[tt][0], c); c = MFMA16(sa[vt][1], zf[tt][1], c); y[vt] = c; s += (c[0] + c[1]) + (c[2] + c[3]); }
            s += __shfl_xor(s, 16); s += __shfl_xor(s, 32);
            const float mean = s * (1.f / 64.f); float q = 0.f;
#pragma unroll
            for (int vt = 0; vt < 4; ++vt) { y[vt] = y[vt] - mean; q += (y[vt][0] * y[vt][0] + y[vt][1] * y[vt][1]) + (y[vt][2] * y[vt][2] + y[vt][3] * y[vt][3]); }
            q += __shfl_xor(q, 16); q += __shfl_xor(q, 32);
            const float rstd = 1.0f / sqrtf(q * (1.f / 64.f) + GN_EPS);
            const float rk = rkv[tt];
#pragma unroll
            for (int vt = 0; vt < 4; ++vt) {
                const f32x4 vv = (f32x4){bflo(vmr[vt].x), bfhi(vmr[vt].x), bflo(vmr[vt].y), bfhi(vmr[vt].y)}, gv = (f32x4){bflo(ggr[vt].x), bfhi(ggr[vt].x), bflo(ggr[vt].y), bfhi(ggr[vt].y)};
                const f32x4 ov = (y[vt] * rstd * gg[vt] + gb[vt] + vv * rk) * gv;
                u32x2 w; w.x = pk2(ov[0], ov[1]); w.y = pk2(ov[2], ov[3]);
                *(u32x2*)(mix + (size_t)(row0 + t) * D + 512 + h * 64 + 16 * vt + 4 * fq) = w; }
        }
    }
}

DI void norm2_router_phase(Frame& F, const bf16* hsrc, const float* g, const float* router) {
    LAS float* RT = (LAS float*)F.lds;
    LAS int* E01 = (LAS int*)(F.lds + 131072);
    for (int i = ((int)threadIdx.x); i < 2048; i += NTHR) { const int col = i >> 1, half = i & 1; *(LAS f32x4*)(RT + ((((col >> 8) * 4 + (col & 3)) * 2 + half) * 64 + ((col & 255) >> 2)) * 4) = *(const f32x4*)(router + i * 4); }
    __syncthreads();
    unsigned char* hn = F.ws + WS_HN;
    int* tke = (int*)(F.ws + TB_TKE); float* tkg = (float*)(F.ws + TB_TKG);
    const int lane = (int)threadIdx.x & 63, mb = F.wg * 128 + F.wave * 16;
    f32x4 gg[4];
#pragma unroll
    for (int j = 0; j < 4; ++j) gg[j] = ((const f32x4*)g + lane)[64 * j];
    u32x2 cr[2][4], nr[2][4];
#pragma unroll
    for (int q = 0; q < 2; ++q)
#pragma unroll
        for (int j = 0; j < 4; ++j) cr[q][j] = ((const u32x2*)(hsrc + (size_t)(mb + q) * D) + lane)[64 * j];
#pragma unroll 1
    for (int i = 0; i < 16; i += 2) {
        const int in = (i + 2 < 16) ? i + 2 : i;
#pragma unroll
        for (int q = 0; q < 2; ++q)
#pragma unroll
            for (int j = 0; j < 4; ++j) nr[q][j] = ((const u32x2*)(hsrc + (size_t)(mb + in + q) * D) + lane)[64 * j];
        f32x4 y[2][4]; float ss[2] = {0.f, 0.f};
#pragma unroll
        for (int q = 0; q < 2; ++q)
#pragma unroll
            for (int j = 0; j < 4; ++j) { const u32x2 v = cr[q][j]; y[q][j] = (f32x4){bflo(v.x), bfhi(v.x), bflo(v.y), bfhi(v.y)}; ss[q] += (y[q][j].x * y[q][j].x + y[q][j].y * y[q][j].y) + (y[q][j].z * y[q][j].z + y[q][j].w * y[q][j].w); }
#pragma unroll
        for (int q = 0; q < 2; ++q) { const float rstd = 1.0f / sqrtf(wave_sum(ss[q]) * (1.f / D) + RMS_EPS);
#pragma unroll
            for (int j = 0; j < 4; ++j) y[q][j] = y[q][j] * rstd * gg[j];
            store_row_f8(hn + (size_t)(mb + i + q) * D, lane, y[q]); }
        float lg[2][8];
#pragma unroll
        for (int q = 0; q < 2; ++q)
#pragma unroll
            for (int e = 0; e < 8; ++e) lg[q][e] = 0.f;
#pragma unroll
        for (int j = 0; j < 4; ++j)
#pragma unroll
            for (int k = 0; k < 4; ++k) { const LAS f32x4* rp = (const LAS f32x4*)RT + (j * 4 + k) * 128 + lane; const f32x4 r0 = rp[0], r1 = rp[64];
#pragma unroll
                for (int q = 0; q < 2; ++q) { const float x = y[q][j][k];
                    lg[q][0] += x * r0[0]; lg[q][1] += x * r0[1]; lg[q][2] += x * r0[2]; lg[q][3] += x * r0[3]; lg[q][4] += x * r1[0]; lg[q][5] += x * r1[1]; lg[q][6] += x * r1[2]; lg[q][7] += x * r1[3]; } }
#pragma unroll
        for (int q = 0; q < 2; ++q)
#pragma unroll
            for (int e = 0; e < 8; ++e) lg[q][e] = wave_sum(lg[q][e]);
        if (lane == 0) {
#pragma unroll
            for (int q = 0; q < 2; ++q) { const int lt = F.wave * 16 + i + q, m = mb + i + q;
                int e0 = 0; float v0 = lg[q][0];
#pragma unroll
                for (int e = 1; e < 8; ++e) if (lg[q][e] > v0) { v0 = lg[q][e]; e0 = e; }
                int e1 = -1; float v1 = -3.0e38f;
#pragma unroll
                for (int e = 0; e < 8; ++e) if (e != e0 && lg[q][e] > v1) { v1 = lg[q][e]; e1 = e; }
                const float g0 = 1.0f / (1.0f + __expf(v1 - v0));
                tke[m] = e0; tke[M + m] = e1; tkg[m] = g0; tkg[M + m] = 1.0f - g0;
                E01[lt] = e0; E01[128 + lt] = e1; }
        }
#pragma unroll
        for (int q = 0; q < 2; ++q)
#pragma unroll
            for (int j = 0; j < 4; ++j) cr[q][j] = nr[q][j];
    }
    if (F.wg == 0) for (int i = ((int)threadIdx.x); i < D / 4; i += NTHR) ((unsigned*)(hn + (size_t)M * D))[i] = 0u;
    __syncthreads();
    if (((int)threadIdx.x) < 16) { const int s = ((int)threadIdx.x) >> 3, e = ((int)threadIdx.x) & 7; int c = 0; for (int i = 0; i < 128; ++i) c += (E01[s * 128 + i] == e) ? 1 : 0; ((int*)(F.ws + TB_CNT))[F.wg * 16 + ((int)threadIdx.x)] = c; }
}
DI void moe_dispatch_phase(Frame& F) {
    LAS int* C = (LAS int*)F.lds;
    LAS int* TOT = C + 4096; LAS int* MINE = TOT + 16; LAS int* START = MINE + 16; LAS int* PAD = START + 16; LAS int* EL = PAD + 16;
    const int* cnt = (const int*)(F.ws + TB_CNT);
    { const int k = ((int)threadIdx.x) & 15, part = ((int)threadIdx.x) >> 4; int tot = 0, mine = 0;
#pragma unroll
      for (int j = 0; j < 8; ++j) { const int w = part * 8 + j, c = cnt[w * 16 + k]; tot += c; mine += (w < F.wg) ? c : 0; }
      C[part * 16 + k] = tot; C[512 + part * 16 + k] = mine; }
    __syncthreads();
    if (((int)threadIdx.x) < 16) { int tot = 0, mine = 0; for (int p = 0; p < 32; ++p) { tot += C[p * 16 + ((int)threadIdx.x)]; mine += C[512 + p * 16 + ((int)threadIdx.x)]; } TOT[((int)threadIdx.x)] = tot; MINE[((int)threadIdx.x)] = mine; }
    __syncthreads();
    if (((int)threadIdx.x) == 0) { int acc = 0; for (int k = 0; k < 16; ++k) { START[k] = acc; const int p = (TOT[k] + 255) & ~255; PAD[k] = p; acc += p; } }
    const int* tke = (const int*)(F.ws + TB_TKE); const float* tkg = (const float*)(F.ws + TB_TKG);
    int* rowtok = (int*)(F.ws + TB_ROWTOK); float* rowgate = (float*)(F.ws + TB_ROWGATE);
    if (((int)threadIdx.x) < 256) EL[((int)threadIdx.x)] = tke[(((int)threadIdx.x) >> 7) * M + F.wg * 128 + (((int)threadIdx.x) & 127)];
    __syncthreads();
    if (((int)threadIdx.x) < 256) { const int s = ((int)threadIdx.x) >> 7, i = ((int)threadIdx.x) & 127, e = EL[((int)threadIdx.x)]; int rank = 0; for (int j = 0; j < i; ++j) rank += (EL[s * 128 + j] == e) ? 1 : 0;
        const int dest = START[s * 8 + e] + MINE[s * 8 + e] + rank, tok = F.wg * 128 + i;
        rowtok[dest] = tok; rowgate[dest] = tkg[s * M + tok]; }
    if (F.wg < 16) { const int k = F.wg; for (int r = START[k] + TOT[k] + ((int)threadIdx.x); r < START[k] + PAD[k]; r += NTHR) { rowtok[r] = -1; rowgate[r] = 0.f; } }
    if (F.wg == 0) {
        int* tile_e = (int*)(F.ws + TB_TILEE); int* ntiles = (int*)(F.ws + TB_NTILES);
        if (((int)threadIdx.x) < 2 * MOE_TILES) { const int r = ((int)threadIdx.x) * 256; int e = 0; for (int k = 0; k < 16; ++k) if (r >= START[k]) e = k & 7; tile_e[((int)threadIdx.x)] = e; }
        if (((int)threadIdx.x) == 0) { const int n0 = START[8] >> 8; ntiles[0] = n0; ntiles[1] = ((START[15] + PAD[15]) >> 8) - n0; }
    }
}

__device__ __attribute__((noinline)) void moe_dn_combine(const int wg, const int nM, const int G, float* part, unsigned* cnt, const bf16* hin, bf16* hout, const int* row_tok, const float* row_gate, const float sc) {
    pg8::OrderBase S; S.init(nM, D / 256, G, wg);
    const int main = (S.nwg / S.G) * S.G, left = S.nwg - main;
    if (wg >= pg8::DN_KSPLIT * left) return;
    const int j = wg / pg8::DN_KSPLIT, q = wg % pg8::DN_KSPLIT, tid = (int)threadIdx.x;
    pg8::Unit u; S.map((long)main + j, u);
    asm volatile("s_waitcnt vmcnt(0)" ::: "memory");
    __syncthreads();
    if (tid == 0) { __builtin_amdgcn_fence(__ATOMIC_RELEASE, "agent"); asm volatile("s_waitcnt vmcnt(0)" ::: "memory"); __hip_atomic_fetch_add(cnt + 64 * j, 1u, __ATOMIC_RELAXED, __HIP_MEMORY_SCOPE_AGENT);
        unsigned sp = 0; while (__hip_atomic_load(cnt + 64 * j, __ATOMIC_RELAXED, __HIP_MEMORY_SCOPE_AGENT) < (unsigned)pg8::DN_KSPLIT) { __builtin_amdgcn_s_sleep(2); if (++sp > (1u << 22)) break; }
        __builtin_amdgcn_fence(__ATOMIC_ACQUIRE, "agent"); asm volatile("s_waitcnt vmcnt(0)" ::: "memory"); }
    __syncthreads();
    constexpr int KS = pg8::DN_KSPLIT, RPW = (256 + KS - 1) / KS;
    const float* slab = part + (size_t)j * KS * 65536;
    const int cg = (tid & 31) * 8, r1 = (q * RPW + RPW < 256) ? q * RPW + RPW : 256;
    for (int r = q * RPW + (tid >> 5); r < r1; r += 16) {
        const int row = u.pm * 256 + r; const int tok = row_tok[row]; const float g = row_gate[row] * sc;
        if (tok >= 0) {
            f32x4 a[KS][2];
#pragma unroll
            for (int k = 0; k < KS; ++k) { a[k][0] = *(const f32x4*)(slab + (size_t)k * 65536 + r * 256 + cg); a[k][1] = *(const f32x4*)(slab + (size_t)k * 65536 + r * 256 + cg + 4); }
            float h[8]; unpack8(*(const u32x4*)(hin + (size_t)tok * D + u.pn * 256 + cg), h);
            f32x4 s0 = a[0][0], s1 = a[0][1];
#pragma unroll
            for (int k = 1; k < KS; ++k) { s0 += a[k][0]; s1 += a[k][1]; }
#pragma unroll
            for (int e = 0; e < 4; ++e) { h[e] += g * s0[e]; h[4 + e] += g * s1[e]; }
            *(u32x4*)(hout + (size_t)tok * D + u.pn * 256 + cg) = pack8(h);
        }
    }
}

constexpr int NPHASES = 21;
__global__ void __launch_bounds__(NTHR, 2) fwd(Args args) {
    extern __shared__ __attribute__((aligned(16))) unsigned char lds[];
    Frame F;
    F.lds = (LAS unsigned char*)lds;
    F.wave = __builtin_amdgcn_readfirstlane((int)threadIdx.x >> 6);
    F.G = gridDim.x; F.wg = blockIdx.x;
    F.A = &args; F.out = args.out; F.ws = args.ws;
    volatile LAS unsigned* MISC = (volatile LAS unsigned*)(F.lds + MISC_OFF);
    if (((int)threadIdx.x) < 64) MISC[((int)threadIdx.x)] = 0u;
    __syncthreads();
    const int lo = args.ph_lo, hi = args.ph_hi;
    XcdBarrier bar; bar.bar = (unsigned*)(F.ws + WS_CTL) + CW_BAR; bar.x = 0; bar.st = nullptr;
    if (hi - lo > 1) bar = xcd_barrier_post((unsigned*)(F.ws + WS_CTL) + CW_BAR, MISC + 8);
#ifndef ONLY_PHASE
#define ONLY_PHASE -1
#endif
#define IN(k) ((ONLY_PHASE < 0 || (k) == ONLY_PHASE) && lo <= (k) && (k) < hi)
#define SEAM(k) do { if (IN(k) && IN((k) + 1)) xcd_barrier(bar); } while (0)
    unsigned char* ws = F.ws;
    bf16* HN = (bf16*)(ws + WS_HN); bf16* MIX = (bf16*)(ws + WS_MIX); bf16* PROJ = (bf16*)(ws + WS_PROJ);
    bf16* HB = (bf16*)F.out;

    if (IN(0)) { p0_prologue(F); norm_rows_phase(F, F.A->in[I_X], F.A->in[I_N1G], HN); }
    SEAM(0);
#define LAYER_MIXER(l) do { \
        constexpr int pb = 1 + (l) * 9; \
        if (IN(pb + 0)) { pg8::DenseSched S; S.init(M / 256, NIN / 256, F.G, F.wg); S.A = (const char*)HN; S.Bt = (const char*)(ws + WS_WIN) + (size_t)(l) * NIN * D * 2; S.tstep = (size_t)256 * D * 2; \
            pg8::EpiBf16 E{PROJ, NIN}; pg8::gemm_phase<pg8::EpiBf16, pg8::DenseSched, true, true>(F.lds, D, S, E); } \
        SEAM(pb + 0); \
        if (IN(pb + 1)) { s1_stage_mu(F, (l)); for (int gc = F.wg; gc < M / 64; gc += F.G) { mixc_unit(F, (l), gc); s1_chunk_prep(F, (l), gc); S1Pre pa, pb2; s1_issue(F, (l), gc, 0, pa); for (int h = 0; h < NH; h += 2) { s1_unit(F, (l), gc, h, pa, h + 1, pb2); s1_unit(F, (l), gc, h + 1, pb2, (h + 2 < NH) ? h + 2 : h + 1, pa); } LDS_BAR(); } } \
        SEAM(pb + 1); \
        if (IN(pb + 2)) { s2_phase(F, (l)); } \
        SEAM(pb + 2); \
        if (IN(pb + 3)) { s3_phase(F, (l)); } \
        SEAM(pb + 3); \
        if (IN(pb + 4)) { pg8::DenseSched S; S.init(M / 256, D / 256, F.G, F.wg); S.A = (const char*)MIX; S.Bt = (const char*)(ws + WS_WOUT) + (size_t)(l) * D * D * 2; S.tstep = (size_t)256 * D * 2; \
            if ((l) == 0) { pg8::EpiResid<true> E{(const void*)F.A->in[I_X], HB, D}; pg8::gemm_phase<pg8::EpiResid<true>, pg8::DenseSched, true, true>(F.lds, D, S, E); } \
            else { pg8::EpiResid<false> E{(const void*)HB, HB, D}; pg8::gemm_phase<pg8::EpiResid<false>, pg8::DenseSched, true, true>(F.lds, D, S, E); } } \
        SEAM(pb + 4); } while (0)
    LAYER_MIXER(0);
    {
        if (IN(6)) norm_rows_phase_b<false>(F, HB, F.A->in[I_N2G], HN);
        SEAM(6);
        if (IN(7)) { pg8::DenseSched S; S.init(M / 256, 2 * FF / 256, F.G, F.wg); S.A = (const char*)HN; S.Bt = (const char*)(ws + WS_WGU); S.tstep = (size_t)256 * D * 2;
            pg8::EpiSwiglu E{(bf16*)(ws + WS_HID), FF}; pg8::gemm_phase<pg8::EpiSwiglu, pg8::DenseSched, true, true>(F.lds, D, S, E); }
        SEAM(7);
        if (IN(8)) { pg8::DenseSched S; S.init(M / 256, D / 256, F.G, F.wg); S.A = (const char*)(ws + WS_HID); S.Bt = (const char*)(ws + WS_WDN); S.tstep = (size_t)256 * FF * 2;
            pg8::EpiResid<false> E{(const void*)HB, HB, D}; pg8::gemm_phase<pg8::EpiResid<false>, pg8::DenseSched, true, true>(F.lds, FF, S, E); }
        SEAM(8);
        if (IN(9)) norm_rows_phase_b<false>(F, HB, F.A->in[I_N1G] + D, HN);
        SEAM(9);
    }
    LAYER_MIXER(1);
    if (IN(15)) { norm2_router_phase(F, HB, F.A->in[I_N2G] + D, F.A->in[I_ROUTER]); moe_weight_convert<1>(F, F.wg * NWAVES + F.wave, F.G * NWAVES, (LAS float*)(F.lds + 32768 + F.wave * 9216)); }
    SEAM(15);
    if (IN(16)) moe_dispatch_phase(F);
    SEAM(16);
    {
        const int* rowtok = (const int*)(ws + TB_ROWTOK); const float* rowgate = (const float*)(ws + TB_ROWGATE); const int* tile_e = (const int*)(ws + TB_TILEE);
        if (IN(17)) { const int nt = __builtin_amdgcn_readfirstlane(((const int*)(ws + TB_NTILES))[0] + ((const int*)(ws + TB_NTILES))[1]);
            pg8::MoeGuSched S; S.init(nt, 2 * FE / 256, F.G, F.wg); S.A = (const char*)HN; S.Bt = (const char*)(ws + WS_WMGU); S.row_tok = rowtok; S.tile_e = tile_e;
            pg8::EpiSwigluF8 E{ws + WS_MHID, FE}; pg8::gemm_phase<pg8::EpiSwigluF8, pg8::MoeGuSched, true, true, true>(F.lds, D / 2, S, E); }
        SEAM(17);
#pragma unroll
        for (int s = 0; s < 2; ++s) {
            if (IN(18 + s)) { const int nt0 = __builtin_amdgcn_readfirstlane(((const int*)(ws + TB_NTILES))[0]), nt = s ? __builtin_amdgcn_readfirstlane(((const int*)(ws + TB_NTILES))[1]) : nt0, t0 = s ? nt0 : 0;
                const int* rt = rowtok + t0 * 256; const float* rg = rowgate + t0 * 256; const int* te = tile_e + t0; const char* hid = (const char*)(ws + WS_MHID) + (size_t)t0 * 256 * FE;
                { pg8::MoeDnSched S; S.init(nt, D / 256, F.G, F.wg); S.A = hid; S.Bt = (const char*)(ws + WS_WMDN); S.tile_e = te; S.tstep = (size_t)256 * FE;
                  pg8::EpiMoeDown E{HB, (s == 0) ? HB : HN, rt, rg, F8_DN_INV}; pg8::gemm_phase<pg8::EpiMoeDown, pg8::MoeDnSched, true, true, true>(F.lds, FE / 2, S, E); }
                { pg8::MoeDnLeftSched S; S.init(nt, D / 256, F.G, F.wg); S.A = hid; S.Bt = (const char*)(ws + WS_WMDN); S.tile_e = te; S.tstep = (size_t)256 * FE;
                  float* part = (float*)(ws + WS_PART); unsigned* cnt = (unsigned*)(ws + WS_CTL) + CW_LEFT + s * 32 * 64;
                  pg8::EpiPartTile E{part + (size_t)F.wg * 65536};
                  pg8::gemm_phase<pg8::EpiPartTile, pg8::MoeDnLeftSched, true, true, true>(F.lds, FE / 2, S, E, pg8::DN_KT);
                  moe_dn_combine(F.wg, nt, F.G, part, cnt, HB, (s == 0) ? HB : HN, rt, rg, F8_DN_INV); } }
            SEAM(18 + s);
        }
    }
    if (IN(20)) norm_rows_phase_b<true>(F, HN, F.A->in[I_FINALG], F.out);
#undef IN
#undef SEAM
}

extern "C" void kernel_launch(void* const* d_in, const int* in_sizes, int n_in, void* d_out, int out_size, void* d_ws, size_t ws_size, hipStream_t stream) {
    static int ready = 0;
    if (ready == 0) {
        if (n_in != 33 || out_size != M * D || ws_size < WS_NEED) { fprintf(stderr, "kernel_launch: unexpected shapes (n_in %d, out %d, ws %zu, need %zu)\n", n_in, out_size, ws_size, (size_t)WS_NEED); ready = -1; return; }
        if (hipFuncSetAttribute((const void*)fwd, hipFuncAttributeMaxDynamicSharedMemorySize, LDS_BYTES) != hipSuccess) { fprintf(stderr, "kernel_launch: hipFuncSetAttribute failed\n"); ready = -1; return; }
        int per_cu = 0; (void)hipOccupancyMaxActiveBlocksPerMultiprocessor(&per_cu, (const void*)fwd, NTHR, LDS_BYTES); (void)hipGetLastError();
        if (per_cu < 1) fprintf(stderr, "kernel_launch: occupancy query reports %d\n", per_cu);
        ready = 1;
    }
    if (ready < 0) return;
    (void)hipMemsetAsync((char*)d_ws + WS_CTL, 0, CTL_ZERO_BYTES, stream);
    Args a{};
    for (int i = 0; i < 33; ++i) a.in[i] = (const float*)d_in[i];
    a.out = (float*)d_out; a.ws = (unsigned char*)d_ws;
#if N_LAUNCH_MODE == 1
    a.ph_lo = 0; a.ph_hi = NPHASES;
    hipLaunchKernelGGL(fwd, dim3(GRID), dim3(NTHR), LDS_BYTES, stream, a);
#else
    for (int p = 0; p < NPHASES; ++p) { a.ph_lo = p; a.ph_hi = p + 1; const int reps = ((PROBE_PHASES >> p) & 1u) ? 2 : 1;
        for (int r = 0; r < reps; ++r) hipLaunchKernelGGL(fwd, dim3(GRID), dim3(NTHR), LDS_BYTES, stream, a); }
#endif
    (void)in_sizes;
}
```

```cpp
#include <hip/hip_runtime.h>
#include <cstdio>
#include <cstdint>

#define DI __device__ __forceinline__
#define LAS __attribute__((address_space(3)))
typedef unsigned short bf16;
typedef short bf16x8 __attribute__((ext_vector_type(8)));
typedef float f32x4 __attribute__((ext_vector_type(4)));
typedef float f32x2 __attribute__((ext_vector_type(2)));
typedef unsigned u32x4 __attribute__((ext_vector_type(4)));
typedef unsigned u32x2 __attribute__((ext_vector_type(2)));
typedef __bf16 bf2_t __attribute__((ext_vector_type(2)));

#ifndef PROBE_PHASES
#define PROBE_PHASES 0x0u
#endif
#ifndef N_LAUNCH_MODE
#define N_LAUNCH_MODE 1
#endif

constexpr int BATCH = 4, T = 8192, D = 1024, M = BATCH * T;
constexpr int NIN = 2560, RW = 512, NH = 8;
constexpr int C_CONVA = 256, C_CONVB = 512, C_R = 768, C_K = 1280, C_V = 1792, C_XW = 2304, C_XA = 2368, C_XG = 2432;
constexpr int NRC = 1792;
constexpr int FF = 2816, FE = 3584, NE = 8;
constexpr int MOE_ROWS = M + NE * 256;
constexpr int MOE_TILES = MOE_ROWS / 256;
constexpr float RMS_EPS = 1e-6f, LN_EPS = 1e-5f, GN_EPS = 64e-5f;
constexpr int NWAVES = 8, NTHR = 512, GRID = 256;

DI unsigned pk2(float lo, float hi) { f32x2 v = {lo, hi}; return __builtin_bit_cast(unsigned, __builtin_convertvector(v, bf2_t)); }
DI float bflo(unsigned u) { return __uint_as_float(u << 16); }
DI float bfhi(unsigned u) { return __uint_as_float(u & 0xffff0000u); }
DI float fast_exp(float x) { return __builtin_amdgcn_exp2f(x * 1.44269504088896f); }
DI float sigmoidf_(float x) { return __builtin_amdgcn_rcpf(1.0f + fast_exp(-x)); }
DI float siluf_(float x) { return x * sigmoidf_(x); }
template <int D> DI float row_shr(float x) { return __builtin_bit_cast(float, __builtin_amdgcn_update_dpp(0, __builtin_bit_cast(int, x), 0x110 + D, 0xf, 0xf, false)); }
DI float row_scan16(float x) { x += row_shr<1>(x); x += row_shr<2>(x); x += row_shr<4>(x); x += row_shr<8>(x); return x; }
DI float wave_sum(float v) {
    v = row_scan16(v);
    const int iv = __builtin_bit_cast(int, v);
    const float a = __builtin_bit_cast(float, __builtin_amdgcn_readlane(iv, 15)), b = __builtin_bit_cast(float, __builtin_amdgcn_readlane(iv, 31));
    const float c = __builtin_bit_cast(float, __builtin_amdgcn_readlane(iv, 47)), d = __builtin_bit_cast(float, __builtin_amdgcn_readlane(iv, 63));
    return (a + b) + (c + d);
}
DI void unpack8(const u32x4 w, float (&f)[8]) { f[0] = bflo(w.x); f[1] = bfhi(w.x); f[2] = bflo(w.y); f[3] = bfhi(w.y); f[4] = bflo(w.z); f[5] = bfhi(w.z); f[6] = bflo(w.w); f[7] = bfhi(w.w); }
DI u32x4 pack8(const float (&f)[8]) { u32x4 w; w.x = pk2(f[0], f[1]); w.y = pk2(f[2], f[3]); w.z = pk2(f[4], f[5]); w.w = pk2(f[6], f[7]); return w; }
#define MFMA16(a, b, c) __builtin_amdgcn_mfma_f32_16x16x32_bf16((a), (b), (c), 0, 0, 0)
typedef int i32x8 __attribute__((ext_vector_type(8)));
typedef int i32x4 __attribute__((ext_vector_type(4)));
constexpr float F8S_X = 4.f, F8S_WGU = 64.f, F8S_H = 8.f, F8S_WDN = 128.f;
constexpr float F8_GU_INV = 1.f / (F8S_X * F8S_WGU), F8_DN_INV = 1.f / (F8S_H * F8S_WDN);
DI float f8clamp(float x) { return __builtin_amdgcn_fmed3f(x, -448.f, 448.f); }
DI unsigned pk4_f8(float a, float b, float c, float d) { int p = __builtin_amdgcn_cvt_pk_fp8_f32(f8clamp(a), f8clamp(b), 0, false); p = __builtin_amdgcn_cvt_pk_fp8_f32(f8clamp(c), f8clamp(d), p, true); return (unsigned)p; }
DI i32x8 cat8(const bf16x8 a, const bf16x8 b) { return __builtin_shufflevector(__builtin_bit_cast(i32x4, a), __builtin_bit_cast(i32x4, b), 0, 1, 2, 3, 4, 5, 6, 7); }

namespace pg8 {
constexpr int BM = 256, BK = 64, HALF = 128, HTB = HALF * BK * 2, STAGE_BYTES = 8 * HTB, NXCD = 8, WGM = 8;
DI int lds_byte(int r, int c) { const int st = (r >> 4) * 2 + (c >> 5), rr = r & 15, cc = c & 31, ob = rr * 64 + cc * 2; return st * 1024 + (ob ^ (((ob >> 9) & 1) << 5)); }
DI void stage_rc(int b, int& R, int& C) { const int st = b / 1024, sb = b % 1024, swz = sb ^ (((sb >> 9) & 1) << 5); R = (st >> 1) * 16 + swz / 64; C = (st & 1) * 32 + (swz % 64) / 2; }
DI int perm32(int rho) { const int n = rho >> 4, i = rho & 15; return 8 * (i >> 2) + 4 * n + (i & 3); }
struct Unit { int pm, pn; };
struct OrderBase {
    int nM, nN, nwg, G, c;
    DI void init(int nM_, int nN_, int G_, int c_) { nM = nM_; nN = nN_; nwg = nM * nN; G = G_; c = c_; }
    DI void map(const long L, Unit& u) const {
        int wgid = (int)L; { const int q = nwg / NXCD, r = nwg % NXCD, xcd = wgid % NXCD, off = wgid / NXCD; wgid = (xcd < r ? xcd * (q + 1) : r * (q + 1) + (xcd - r) * q) + off; }
        const int nig = WGM * nN, gid = wgid / nig, fm = gid * WGM, gsz = (nM - fm) < WGM ? (nM - fm) : WGM;
        u.pm = fm + ((wgid % nig) % gsz); u.pn = (wgid % nig) / gsz;
    }
    DI bool next(int i, Unit& u) const { const long L = (long)i * G + c; if (L >= nwg) return false; map(L, u); return true; }
};
struct DenseSched : OrderBase {
    static constexpr bool GATHER = false;
    const char* A; const char* Bt; size_t tstep;
    DI const char* a_base(const Unit& u) const { return A + (size_t)u.pm * tstep; }
    DI const char* b_base(const Unit& u) const { return Bt + (size_t)u.pn * tstep; }
    DI void a_offs(const Unit&, const int (&)[2], const int (&)[2], unsigned (&)[2][2]) const {}
};
struct MoeGuSched : OrderBase {
    static constexpr bool GATHER = true;
    const char* A; const char* Bt; const int* row_tok; const int* tile_e;
    DI const char* a_base(const Unit&) const { return A; }
    DI const char* b_base(const Unit& u) const { const int e = __builtin_amdgcn_readfirstlane(tile_e[u.pm]); return Bt + ((size_t)e * (2 * FE) + (size_t)u.pn * 256) * (size_t)D; }
    DI void a_offs(const Unit& u, const int (&R)[2], const int (&C)[2], unsigned (&o)[2][2]) const {
#pragma unroll
        for (int h = 0; h < 2; ++h)
#pragma unroll
            for (int i = 0; i < 2; ++i) { int tok = row_tok[u.pm * 256 + h * 128 + R[i]]; tok = tok < 0 ? M : tok; o[h][i] = (unsigned)tok * (unsigned)D + (unsigned)(C[i] * 2); }
    }
};
struct MoeDnSched : OrderBase {
    static constexpr bool GATHER = false;
    const char* A; const char* Bt; const int* tile_e; size_t tstep;
    DI bool next(int i, Unit& u) const { if (i >= nwg / G) return false; map((long)i * G + c, u); return true; }
    DI const char* a_base(const Unit& u) const { return A + (size_t)u.pm * tstep; }
    DI const char* b_base(const Unit& u) const { const int e = __builtin_amdgcn_readfirstlane(tile_e[u.pm]); return Bt + ((size_t)e * D + (size_t)u.pn * 256) * (size_t)FE; }
    DI void a_offs(const Unit&, const int (&)[2], const int (&)[2], unsigned (&)[2][2]) const {}
};
constexpr int DN_KSPLIT = 7, DN_KT = FE / 128 / DN_KSPLIT;
struct MoeDnLeftSched : OrderBase {
    static constexpr bool GATHER = false;
    const char* A; const char* Bt; const int* tile_e; size_t tstep;
    DI bool next(int i, Unit& u) const { const int main = (nwg / G) * G, left = nwg - main; if (i > 0 || c >= DN_KSPLIT * left) return false; map((long)main + (c / DN_KSPLIT), u); return true; }
    DI const char* a_base(const Unit& u) const { return A + (size_t)u.pm * tstep + (size_t)(c % DN_KSPLIT) * (DN_KT * 128); }
    DI const char* b_base(const Unit& u) const { const int e = __builtin_amdgcn_readfirstlane(tile_e[u.pm]); return Bt + ((size_t)e * D + (size_t)u.pn * 256) * (size_t)FE + (size_t)(c % DN_KSPLIT) * (DN_KT * 128); }
    DI void a_offs(const Unit&, const int (&)[2], const int (&)[2], unsigned (&)[2][2]) const {}
};

struct EpiBf16 {
    static constexpr bool PERM = true;
    bf16* O; int ldc;
    DI void operator()(const f32x4 (&acc)[2][2][4][2], const Unit& u, int wr, int wc, int fr, int fq) const {
        const int row0 = u.pm * BM + wr * 64 + fr, col0 = u.pn * BM + wc * 32 + 8 * fq;
#pragma unroll
        for (int ai = 0; ai < 2; ++ai)
#pragma unroll
            for (int m = 0; m < 4; ++m) { bf16* rowp = O + (size_t)(row0 + ai * HALF + m * 16) * ldc + col0;
#pragma unroll
                for (int bj = 0; bj < 2; ++bj) { const f32x4 v0 = acc[ai][bj][m][0], v1 = acc[ai][bj][m][1];
                    u32x4 w; w.x = pk2(v0[0], v0[1]); w.y = pk2(v0[2], v0[3]); w.z = pk2(v1[0], v1[1]); w.w = pk2(v1[2], v1[3]);
                    *(u32x4*)(rowp + bj * HALF) = w; } }
    }
};
struct EpiSwiglu {
    static constexpr bool PERM = true;
    bf16* O; int ldc;
    DI void operator()(const f32x4 (&acc)[2][2][4][2], const Unit& u, int wr, int wc, int fr, int fq) const {
        const int row0 = u.pm * BM + wr * 64 + fr, col0 = u.pn * HALF + wc * 32 + 8 * fq;
#pragma unroll
        for (int ai = 0; ai < 2; ++ai)
#pragma unroll
            for (int m = 0; m < 4; ++m) { bf16* rowp = O + (size_t)(row0 + ai * HALF + m * 16) * ldc + col0;
                float h[8];
#pragma unroll
                for (int n = 0; n < 2; ++n)
#pragma unroll
                    for (int j = 0; j < 4; ++j) { const float g = acc[ai][0][m][n][j], up = acc[ai][1][m][n][j]; h[n * 4 + j] = siluf_(g) * up; }
                *(u32x4*)rowp = pack8(h); }
    }
};
struct EpiSwigluF8 {
    static constexpr bool PERM = true;
    unsigned char* O; int ldc;
    DI void operator()(const f32x4 (&acc)[2][2][4][2], const Unit& u, int wr, int wc, int fr, int fq) const {
        const int row0 = u.pm * BM + wr * 64 + fr, col0 = u.pn * HALF + wc * 32 + 8 * fq;
#pragma unroll
        for (int ai = 0; ai < 2; ++ai)
#pragma unroll
            for (int m = 0; m < 4; ++m) { unsigned char* rowp = O + (size_t)(row0 + ai * HALF + m * 16) * ldc + col0;
                float h[8];
#pragma unroll
                for (int n = 0; n < 2; ++n)
#pragma unroll
                    for (int j = 0; j < 4; ++j) { const float ag = acc[ai][0][m][n][j], au = acc[ai][1][m][n][j];
                        constexpr float KK = 1.f / (F8S_H * F8_GU_INV * F8_GU_INV), LK = 13.f; static_assert(KK == 8192.f, "log2 of K");
                        h[n * 4 + j] = (ag * au) * __builtin_amdgcn_rcpf(KK + __builtin_amdgcn_exp2f(__builtin_fmaf(ag, -1.44269504088896f * F8_GU_INV, LK))); }
                u32x2 w; w.x = pk4_f8(h[0], h[1], h[2], h[3]); w.y = pk4_f8(h[4], h[5], h[6], h[7]);
                *(u32x2*)rowp = w; }
    }
};
template <bool BASE_F32> struct EpiResid {
    static constexpr bool PERM = true;
    const void* base; bf16* out; int ldc;
    DI void operator()(const f32x4 (&acc)[2][2][4][2], const Unit& u, int wr, int wc, int fr, int fq) const {
        const int row0 = u.pm * BM + wr * 64 + fr, col0 = u.pn * BM + wc * 32 + 8 * fq;
        u32x4 bball[BASE_F32 ? 1 : 2][4][2];
        if constexpr (!BASE_F32) {
#pragma unroll
            for (int ai = 0; ai < 2; ++ai)
#pragma unroll
                for (int m = 0; m < 4; ++m)
#pragma unroll
                    for (int bj = 0; bj < 2; ++bj) bball[ai][m][bj] = *(const u32x4*)((const bf16*)base + (size_t)(row0 + ai * HALF + m * 16) * ldc + col0 + bj * HALF);
            asm volatile("" ::: "memory");
        }
#pragma unroll
        for (int ai = 0; ai < 2; ++ai) {
            f32x4 bf[BASE_F32 ? 4 : 1][2][2]; u32x4 bb[4][2];
#pragma unroll
            for (int m = 0; m < 4; ++m) { const size_t off = (size_t)(row0 + ai * HALF + m * 16) * ldc + col0;
#pragma unroll
                for (int bj = 0; bj < 2; ++bj) { if (BASE_F32) { bf[BASE_F32 ? m : 0][bj][0] = *(const f32x4*)((const float*)base + off + bj * HALF); bf[BASE_F32 ? m : 0][bj][1] = *(const f32x4*)((const float*)base + off + bj * HALF + 4); }
                                                 else bb[m][bj] = bball[BASE_F32 ? 0 : ai][m][bj]; } }
            asm volatile("" ::: "memory");
#pragma unroll
            for (int m = 0; m < 4; ++m) { const size_t off = (size_t)(row0 + ai * HALF + m * 16) * ldc + col0;
#pragma unroll
                for (int bj = 0; bj < 2; ++bj) { float h[8];
                    if (BASE_F32) {
#pragma unroll
                        for (int j = 0; j < 4; ++j) { h[j] = bf[BASE_F32 ? m : 0][bj][0][j]; h[4 + j] = bf[BASE_F32 ? m : 0][bj][1][j]; } }
                    else unpack8(bb[m][bj], h);
#pragma unroll
                    for (int j = 0; j < 4; ++j) { h[j] += acc[ai][bj][m][0][j]; h[4 + j] += acc[ai][bj][m][1][j]; }
                    *(u32x4*)(out + off + bj * HALF) = pack8(h); } }
            asm volatile("" ::: "memory");
        }
    }
};
struct EpiMoeDown {
    static constexpr bool PERM = true;
    const bf16* hin; bf16* hout; const int* row_tok; const float* row_gate; float sc;
    DI void operator()(const f32x4 (&acc)[2][2][4][2], const Unit& u, int wr, int wc, int fr, int fq) const {
        const int row0 = u.pm * BM + wr * 64 + fr, col0 = u.pn * BM + wc * 32 + 8 * fq;
        int tok[2][4]; float g[2][4];
#pragma unroll
        for (int ai = 0; ai < 2; ++ai)
#pragma unroll
            for (int m = 0; m < 4; ++m) { const int r = row0 + ai * HALF + m * 16; tok[ai][m] = row_tok[r]; g[ai][m] = row_gate[r] * sc; }
        u32x4 bball[2][4][2];
#pragma unroll
        for (int ai = 0; ai < 2; ++ai)
#pragma unroll
            for (int m = 0; m < 4; ++m) { const int tk = tok[ai][m]; const bf16* hp = hin + (size_t)(tk < 0 ? 0 : tk) * D + col0;
#pragma unroll
                for (int bj = 0; bj < 2; ++bj) bball[ai][m][bj] = *(const u32x4*)(hp + bj * HALF); }
        asm volatile("" ::: "memory");
#pragma unroll
        for (int ai = 0; ai < 2; ++ai) {
            u32x4 bb[4][2];
#pragma unroll
            for (int m = 0; m < 4; ++m)
#pragma unroll
                for (int bj = 0; bj < 2; ++bj) bb[m][bj] = bball[ai][m][bj];
#pragma unroll
            for (int m = 0; m < 4; ++m) { const int tk = tok[ai][m]; if (tk >= 0) { bf16* hp = hout + (size_t)tk * D + col0; const float gg = g[ai][m];
#pragma unroll
                for (int bj = 0; bj < 2; ++bj) { float h[8]; unpack8(bb[m][bj], h);
#pragma unroll
                    for (int j = 0; j < 4; ++j) { h[j] += acc[ai][bj][m][0][j] * gg; h[4 + j] += acc[ai][bj][m][1][j] * gg; }
                    *(u32x4*)(hp + bj * HALF) = pack8(h); } } }
            asm volatile("" ::: "memory");
        }
    }
};

struct EpiPartTile {
    static constexpr bool PERM = true;
    float* slab;
    DI void operator()(const f32x4 (&acc)[2][2][4][2], const Unit&, int wr, int wc, int fr, int fq) const {
        float* base = slab + (size_t)(wr * 64 + fr) * 256 + wc * 32 + 8 * fq;
#pragma unroll
        for (int ai = 0; ai < 2; ++ai)
#pragma unroll
            for (int m = 0; m < 4; ++m)
#pragma unroll
                for (int bj = 0; bj < 2; ++bj) { float* p = base + (size_t)(ai * HALF + m * 16) * 256 + bj * HALF; *(f32x4*)p = acc[ai][bj][m][0]; *(f32x4*)(p + 4) = acc[ai][bj][m][1]; }
    }
};

template <class Epi, class Sched, bool ALIGN_EPI, bool SP2, bool F8 = false>
DI void gemm_phase(LAS unsigned char* lds, const int K, const Sched& S, const Epi& E, const int ktiles = 0) {
    const int tid = threadIdx.x, wid = __builtin_amdgcn_readfirstlane(tid >> 6), lane = tid & 63, wr = wid >> 2, wc = wid & 3, fr = lane & 15, fq = lane >> 4;
    const int nt = ktiles ? ktiles : K / BK;
    unsigned voffA[2], voffB[2]; int RA[2], CA[2];
#pragma unroll
    for (int i = 0; i < 2; ++i) { int R, C; stage_rc(tid * 16 + i * 8192, R, C); const int Rb = Epi::PERM ? ((R & ~31) + perm32(R & 31)) : R;
        RA[i] = R; CA[i] = C; voffA[i] = (unsigned)(R * K + C) * 2u; voffB[i] = (unsigned)(Rb * K + C) * 2u; }
    unsigned gc[2][2] = {{0u, 0u}, {0u, 0u}}, gn[2][2] = {{0u, 0u}, {0u, 0u}};
    const size_t kstep = (size_t)(BK * 2);
    const size_t hstep = (size_t)HALF * K * 2;
    const unsigned ldsw = (unsigned)wid * 1024u;
    const int aoff = lds_byte(wr * 64 + fr, fq * 8), boff = lds_byte(wc * 32 + fr, fq * 8);
#define PG8_SA(b, h) (((b) * 2 + (h)) * HTB)
#define PG8_SB(b, h) ((4 + (b) * 2 + (h)) * HTB)
#define PG8_STAGE(bufoff, gbase, voff) do { _Pragma("unroll") for (int _i = 0; _i < 2; ++_i) \
        __builtin_amdgcn_global_load_lds((const unsigned*)((const char*)(gbase) + (voff)[_i]), (LAS unsigned*)(lds + (bufoff) + ldsw + _i * 8192), 16, 0, 0); } while (0)
#define PG8_STAGE_A(bufoff, kbase, h, go) do { if constexpr (Sched::GATHER) { PG8_STAGE(bufoff, kbase, (go)[h]); } else { PG8_STAGE(bufoff, (kbase) + (h) * hstep, voffA); } } while (0)
#define PG8_LDA(dst, b, h) do { _Pragma("unroll") for (int m = 0; m < 4; ++m) { if constexpr (F8) dst##8[m] = __builtin_shufflevector(*(const LAS i32x4*)(lds + PG8_SA(b, h) + aoff + m * 2048), *(const LAS i32x4*)(lds + PG8_SA(b, h) + aoff + m * 2048 + 1024), 0, 1, 2, 3, 4, 5, 6, 7); \
        else { _Pragma("unroll") for (int k = 0; k < 2; ++k) dst[m][k] = *(const LAS bf16x8*)(lds + PG8_SA(b, h) + aoff + m * 2048 + k * 1024); } } } while (0)
#define PG8_LDB(dst, b, h) do { _Pragma("unroll") for (int n = 0; n < 2; ++n) { if constexpr (F8) dst##8[n] = __builtin_shufflevector(*(const LAS i32x4*)(lds + PG8_SB(b, h) + boff + n * 2048), *(const LAS i32x4*)(lds + PG8_SB(b, h) + boff + n * 2048 + 1024), 0, 1, 2, 3, 4, 5, 6, 7); \
        else { _Pragma("unroll") for (int k = 0; k < 2; ++k) dst[n][k] = *(const LAS bf16x8*)(lds + PG8_SB(b, h) + boff + n * 2048 + k * 1024); } } } while (0)
#define PG8_MMA(ai, bj, At, Bt) do { __builtin_amdgcn_s_setprio(1); _Pragma("unroll") for (int m = 0; m < 4; ++m) _Pragma("unroll") for (int n = 0; n < 2; ++n) { \
        if constexpr (F8) asm volatile("v_mfma_f32_16x16x128_f8f6f4 %0, %1, %2, %0" : "+v"(acc[ai][bj][m][n]) : "v"(Bt##8[n]), "v"(At##8[m])); \
        else { _Pragma("unroll") for (int k = 0; k < 2; ++k) acc[ai][bj][m][n] = __builtin_amdgcn_mfma_f32_16x16x32_bf16(Bt[n][k], At[m][k], acc[ai][bj][m][n], 0, 0, 0); } } __builtin_amdgcn_s_setprio(0); } while (0)
#define PG8_WAIT_V(n) asm volatile("s_waitcnt vmcnt(" #n ")" ::: "memory")
#define PG8_WAIT_L(n) asm volatile("s_waitcnt lgkmcnt(" #n ")" ::: "memory")
#define PG8_BAR __builtin_amdgcn_s_barrier()
#define PG8_SCHED __builtin_amdgcn_sched_barrier(0)
    Unit cur, nxt; int ui = 0;
    if (!S.next(0, cur)) return;
    f32x4 acc[2][2][4][2];
#pragma unroll
    for (int a = 0; a < 2; ++a)
#pragma unroll
        for (int b = 0; b < 2; ++b)
#pragma unroll
            for (int m = 0; m < 4; ++m)
#pragma unroll
                for (int n = 0; n < 2; ++n) acc[a][b][m][n] = (f32x4){0.f, 0.f, 0.f, 0.f};
    bf16x8 At[4][2], B0[2][2], B1[2][2];
    i32x8 At8[4], B08[2], B18[2];
    const char* cA = S.a_base(cur); const char* cB = S.b_base(cur);
    if constexpr (Sched::GATHER) { S.a_offs(cur, RA, CA, gc); asm volatile("" : "+v"(gc[0][0]), "+v"(gc[0][1]), "+v"(gc[1][0]), "+v"(gc[1][1])); }
    if constexpr (SP2) {
        PG8_STAGE(PG8_SB(0, 0), cB, voffB); PG8_STAGE(PG8_SB(0, 1), cB + hstep, voffB); PG8_STAGE_A(PG8_SA(0, 0), cA, 0, gc); PG8_STAGE_A(PG8_SA(0, 1), cA, 1, gc);
        if (wr == 1) PG8_BAR;
        PG8_WAIT_V(2); PG8_BAR;
        PG8_STAGE(PG8_SB(1, 0), cB + kstep, voffB); PG8_STAGE_A(PG8_SA(1, 0), cA + kstep, 0, gc); PG8_STAGE(PG8_SB(1, 1), cB + hstep + kstep, voffB);
        PG8_WAIT_V(6); PG8_BAR;
    } else {
        PG8_STAGE(PG8_SB(0, 0), cB, voffB); PG8_STAGE_A(PG8_SA(0, 0), cA, 0, gc); PG8_STAGE(PG8_SB(0, 1), cB + hstep, voffB); PG8_STAGE_A(PG8_SA(0, 1), cA, 1, gc);
        if (wr == 1) PG8_BAR;
        PG8_WAIT_V(4); PG8_BAR;
        PG8_STAGE(PG8_SB(1, 0), cB + kstep, voffB); PG8_STAGE_A(PG8_SA(1, 0), cA + kstep, 0, gc); PG8_STAGE(PG8_SB(1, 1), cB + hstep + kstep, voffB);
        PG8_WAIT_V(6); PG8_BAR;
    }
    for (;;) {
        const bool has_next = S.next(ui + 1, nxt);
        const char* nA = has_next ? S.a_base(nxt) : cA; const char* nB = has_next ? S.b_base(nxt) : cB;
        if constexpr (Sched::GATHER) {
            if (has_next) { S.a_offs(nxt, RA, CA, gn); asm volatile("" : "+v"(gn[0][0]), "+v"(gn[0][1]), "+v"(gn[1][0]), "+v"(gn[1][1])); }
            else { gn[0][0] = gc[0][0]; gn[0][1] = gc[0][1]; gn[1][0] = gc[1][0]; gn[1][1] = gc[1][1]; }
        }
#pragma unroll 1
        for (int t = 0; t < nt; t += 2) {
            const bool last = (t == nt - 2);
            const char* a1 = cA + (size_t)(t + 1) * kstep;
            const char* a2 = last ? nA : cA + (size_t)(t + 2) * kstep; const char* b2 = last ? nB : cB + (size_t)(t + 2) * kstep;
            const char* a3 = a2 + kstep; const char* b3 = b2 + kstep;
            unsigned g2[2][2];
            if constexpr (Sched::GATHER) {
#pragma unroll
                for (int h = 0; h < 2; ++h)
#pragma unroll
                    for (int i = 0; i < 2; ++i) g2[h][i] = last ? gn[h][i] : gc[h][i];
            }
            if constexpr (SP2) {
            PG8_LDB(B0, 0, 0); PG8_LDB(B1, 0, 1); PG8_SCHED; PG8_LDA(At, 0, 0); PG8_STAGE_A(PG8_SA(1, 1), a1, 1, gc);
            PG8_WAIT_V(8); PG8_WAIT_L(0); PG8_BAR; PG8_MMA(0, 0, At, B0); PG8_MMA(0, 1, At, B1); PG8_BAR; PG8_SCHED;
            PG8_LDA(At, 0, 1); PG8_STAGE(PG8_SB(0, 0), b2, voffB); PG8_STAGE(PG8_SB(0, 1), b2 + hstep, voffB); PG8_STAGE_A(PG8_SA(0, 0), a2, 0, g2);
            PG8_WAIT_V(8); PG8_WAIT_L(0); PG8_BAR; PG8_MMA(1, 0, At, B0); PG8_MMA(1, 1, At, B1); PG8_BAR; PG8_SCHED;
            PG8_LDB(B0, 1, 0); PG8_LDB(B1, 1, 1); PG8_SCHED; PG8_LDA(At, 1, 0); PG8_STAGE_A(PG8_SA(0, 1), a2, 1, g2);
            PG8_WAIT_V(8); PG8_WAIT_L(0); PG8_BAR; PG8_MMA(0, 0, At, B0); PG8_MMA(0, 1, At, B1); PG8_BAR; PG8_SCHED;
            PG8_LDA(At, 1, 1); PG8_STAGE(PG8_SB(1, 0), b3, voffB); PG8_STAGE(PG8_SB(1, 1), b3 + hstep, voffB); PG8_STAGE_A(PG8_SA(1, 0), a3, 0, g2);
            PG8_WAIT_V(8); PG8_WAIT_L(0); PG8_BAR; PG8_MMA(1, 0, At, B0); PG8_MMA(1, 1, At, B1); PG8_BAR; PG8_SCHED;
            } else {
            PG8_LDB(B0, 0, 0); PG8_SCHED; PG8_LDA(At, 0, 0); PG8_STAGE_A(PG8_SA(1, 1), a1, 1, gc);
            PG8_WAIT_L(8); PG8_BAR; PG8_WAIT_L(0); PG8_MMA(0, 0, At, B0); PG8_BAR; PG8_SCHED;
            PG8_LDB(B1, 0, 1); PG8_STAGE(PG8_SB(0, 0), b2, voffB);
            PG8_BAR; PG8_WAIT_L(0); PG8_MMA(0, 1, At, B1); PG8_BAR;
            PG8_LDA(At, 0, 1); PG8_STAGE_A(PG8_SA(0, 0), a2, 0, g2);
            PG8_BAR; PG8_WAIT_L(0); PG8_MMA(1, 0, At, B0); PG8_BAR; PG8_SCHED;
            PG8_STAGE(PG8_SB(0, 1), b2 + hstep, voffB);
            PG8_WAIT_V(6); PG8_BAR; PG8_MMA(1, 1, At, B1); PG8_BAR;
            PG8_LDB(B0, 1, 0); PG8_SCHED; PG8_LDA(At, 1, 0); PG8_STAGE_A(PG8_SA(0, 1), a2, 1, g2);
            PG8_WAIT_L(8); PG8_BAR; PG8_WAIT_L(0); PG8_MMA(0, 0, At, B0); PG8_BAR; PG8_SCHED;
            PG8_LDB(B1, 1, 1); PG8_STAGE(PG8_SB(1, 0), b3, voffB);
            PG8_BAR; PG8_WAIT_L(0); PG8_MMA(0, 1, At, B1); PG8_BAR;
            PG8_LDA(At, 1, 1); PG8_STAGE_A(PG8_SA(1, 0), a3, 0, g2);
            PG8_BAR; PG8_WAIT_L(0); PG8_MMA(1, 0, At, B0); PG8_BAR; PG8_SCHED;
            PG8_STAGE(PG8_SB(1, 1), b3 + hstep, voffB);
            PG8_WAIT_V(6); PG8_BAR; PG8_MMA(1, 1, At, B1); PG8_BAR;
            }
        }
        if constexpr (ALIGN_EPI) { if (wr == 0) PG8_BAR; }
        if constexpr (F8) {
            asm volatile("s_nop 15\n\ts_nop 15" : "+v"(acc[0][0][0][0]), "+v"(acc[0][0][0][1]), "+v"(acc[0][0][1][0]), "+v"(acc[0][0][1][1]), "+v"(acc[0][0][2][0]), "+v"(acc[0][0][2][1]), "+v"(acc[0][0][3][0]), "+v"(acc[0][0][3][1]) :: "memory");
            asm volatile("" : "+v"(acc[0][1][0][0]), "+v"(acc[0][1][0][1]), "+v"(acc[0][1][1][0]), "+v"(acc[0][1][1][1]), "+v"(acc[0][1][2][0]), "+v"(acc[0][1][2][1]), "+v"(acc[0][1][3][0]), "+v"(acc[0][1][3][1]));
            asm volatile("" : "+v"(acc[1][0][0][0]), "+v"(acc[1][0][0][1]), "+v"(acc[1][0][1][0]), "+v"(acc[1][0][1][1]), "+v"(acc[1][0][2][0]), "+v"(acc[1][0][2][1]), "+v"(acc[1][0][3][0]), "+v"(acc[1][0][3][1]));
            asm volatile("" : "+v"(acc[1][1][0][0]), "+v"(acc[1][1][0][1]), "+v"(acc[1][1][1][0]), "+v"(acc[1][1][1][1]), "+v"(acc[1][1][2][0]), "+v"(acc[1][1][2][1]), "+v"(acc[1][1][3][0]), "+v"(acc[1][1][3][1]));
        }
        E(acc, cur, wr, wc, fr, fq);
        if (!has_next) break;
#pragma unroll
        for (int a = 0; a < 2; ++a)
#pragma unroll
            for (int b = 0; b < 2; ++b)
#pragma unroll
                for (int m = 0; m < 4; ++m)
#pragma unroll
                    for (int n = 0; n < 2; ++n) acc[a][b][m][n] = (f32x4){0.f, 0.f, 0.f, 0.f};
        cur = nxt; cA = nA; cB = nB; ++ui;
        if constexpr (Sched::GATHER) { gc[0][0] = gn[0][0]; gc[0][1] = gn[0][1]; gc[1][0] = gn[1][0]; gc[1][1] = gn[1][1]; }
        if constexpr (ALIGN_EPI) { if (wr == 1) PG8_BAR; }
    }
    PG8_WAIT_V(0);
    if constexpr (!ALIGN_EPI) { if (wr == 0) PG8_BAR; }
    PG8_BAR;
#undef PG8_SA
#undef PG8_SB
#undef PG8_STAGE
#undef PG8_STAGE_A
#undef PG8_LDA
#undef PG8_LDB
#undef PG8_MMA
#undef PG8_WAIT_V
#undef PG8_WAIT_L
#undef PG8_BAR
#undef PG8_SCHED
}
}

constexpr size_t MiB = 1u << 20;
constexpr size_t WS_CTL = 0, CTL_ZERO_BYTES = 64 * 1024;
constexpr size_t WS_SMALL = 1 * MiB;
constexpr size_t SM_POOLT = WS_SMALL;
constexpr size_t SM_W2T = SM_POOLT + 2 * 4 * 64 * 64 * 2;
constexpr size_t SM_A2T = SM_W2T + 2 * 512 * 64 * 2;
constexpr size_t SM_G2T = SM_A2T + 2 * 512 * 64 * 2;
constexpr size_t SM_V1T = SM_G2T + 2 * 512 * 128 * 2;
constexpr size_t SM_V2T = SM_V1T + 32 * 512 * 2;
constexpr size_t SM_END = SM_V2T + 512 * 32 * 2;
constexpr size_t TB_TKE = 2 * MiB;
constexpr size_t TB_TKG = TB_TKE + 2 * M * 4;
constexpr size_t TB_CNT = TB_TKG + 2 * M * 4;
constexpr size_t TB_ROWTOK = TB_CNT + 256 * 16 * 4;
constexpr size_t TB_ROWGATE = TB_ROWTOK + 2 * MOE_ROWS * 4;
constexpr size_t TB_TILEE = TB_ROWGATE + 2 * MOE_ROWS * 4;
constexpr size_t TB_NTILES = TB_TILEE + 2 * MOE_TILES * 4;
constexpr size_t TB_END = TB_NTILES + 64;
static_assert(SM_END <= TB_TKE && TB_END <= 4 * MiB, "small region");
constexpr size_t WS_WIN = 4 * MiB;
constexpr size_t WS_WOUT = WS_WIN + (size_t)2 * NIN * D * 2;
constexpr size_t WS_WGU = WS_WOUT + (size_t)2 * D * D * 2;
constexpr size_t WS_WDN = WS_WGU + (size_t)2 * FF * D * 2;
constexpr size_t WS_WEND = WS_WDN + (size_t)D * FF * 2;
static_assert(WS_WEND <= 36 * MiB, "main weights");
constexpr size_t WS_HN = 36 * MiB;
constexpr size_t WS_MIX = 101 * MiB;
constexpr size_t WS_VF = 165 * MiB;
constexpr size_t WS_VV1 = 197 * MiB;
constexpr size_t WS_PROJ = 204 * MiB;
constexpr size_t WS_ZB = 364 * MiB, WS_Y0B = 396 * MiB, WS_PTB = 428 * MiB, WS_QB = 460 * MiB;
constexpr size_t WS_SB = 492 * MiB;
constexpr size_t WS_RKB = 524 * MiB;
constexpr size_t WS_GB = 36 * MiB;
constexpr size_t WS_VMB = 68 * MiB;
constexpr size_t WS_HID = 204 * MiB;
constexpr size_t WS_WMGU = 165 * MiB;
constexpr size_t WS_WMDN = 101 * MiB;
constexpr size_t WS_MHID = 277 * MiB;
constexpr size_t WS_PART = 221 * MiB;
constexpr size_t WS_NEED = 526 * MiB;
static_assert(WS_WMGU + (size_t)NE * 2 * FE * D <= WS_PART && WS_PART + (size_t)32 * 7 * 65536 * 4 <= WS_MHID && WS_WMDN + (size_t)NE * D * FE <= 165 * MiB && WS_MHID + (size_t)2 * MOE_ROWS * FE <= 526 * MiB && WS_RKB + (size_t)M * 8 * 4 <= 526 * MiB, "moe map");
static_assert(WS_HN + (size_t)(M + 1) * D * 2 <= WS_MIX && WS_PROJ + (size_t)M * NIN * 2 <= 364 * MiB && WS_HID + (size_t)M * FF * 2 <= 526 * MiB, "map");
constexpr int CW_LEFT = 8192;
constexpr int CW_BAR = 1024;

constexpr int LDS_BYTES = 163840 - 1024;
constexpr int MISC_OFF = LDS_BYTES - 256;

#define XB_TMO      128
#define XB_XCNT(j)  (256  + 64 * (j))
#define XB_XSUB(j)  (1280 + 64 * (j))
#define XB_XGEN(j)  (2304 + 64 * (j))
#define XB_TOP      3328
#define XB_TOPGEN   3392
#define XCD_BAR_WORDS 3456
#define XB_SPIN_CAP (1u << 22)
DI unsigned xb_ld(unsigned* p)              { return __hip_atomic_load(p, __ATOMIC_RELAXED, __HIP_MEMORY_SCOPE_AGENT); }
DI unsigned xb_add(unsigned* p, unsigned v) { return __hip_atomic_fetch_add(p, v, __ATOMIC_RELAXED, __HIP_MEMORY_SCOPE_AGENT); }
DI unsigned xb_xcc_id() { return (unsigned)__builtin_amdgcn_s_getreg((3 << 11) | 20) & 0xFu; }
#define XB_SPIN(cond, bar) do { unsigned _sp = 0; while (cond) { __builtin_amdgcn_s_sleep(1); \
    if ((++_sp & 255u) == 0u) { if (xb_ld(&(bar)[XB_TMO])) break; if (_sp > XB_SPIN_CAP) { atomicAdd(&(bar)[XB_TMO], 1u); break; } } } } while (0)
struct XcdBarrier { unsigned* bar; unsigned x; volatile LAS unsigned* st; };
DI XcdBarrier xcd_barrier_post(unsigned* bar, volatile LAS unsigned* st) {
    XcdBarrier b; b.bar = bar; b.x = xb_xcc_id(); b.st = st;
    if (threadIdx.x == 0) (void)xb_add(&bar[XB_XCNT(b.x)], 1u);
    return b;
}
DI void xcd_barrier_complete(unsigned* bar, unsigned x, unsigned& nloc, unsigned& nx) {
    const unsigned G = gridDim.x * gridDim.y * gridDim.z;
    unsigned sum, cnt, mine, sp = 0u;
    for (;;) {
        sum = 0u; cnt = 0u; mine = 0u;
#pragma unroll
        for (unsigned j = 0; j < 16; ++j) { const unsigned c = xb_ld(&bar[XB_XCNT(j)]); sum += c; cnt += (c > 0u) ? 1u : 0u; mine = (j == x) ? c : mine; }
        if (sum == G) break;
        __builtin_amdgcn_s_sleep(1);
        if ((++sp & 255u) == 0u) { if (xb_ld(&bar[XB_TMO])) break; if (sp > XB_SPIN_CAP) { atomicAdd(&bar[XB_TMO], 1u); break; } }
    }
    nloc = mine > 0u ? mine : 1u; nx = cnt > 0u ? cnt : 1u;
}
DI void xcd_barrier(const XcdBarrier& b) {
    asm volatile("s_waitcnt vmcnt(0)" ::: "memory");
    __syncthreads();
    if (threadIdx.x == 0) {
        unsigned* bar = b.bar;
        __builtin_amdgcn_s_waitcnt(0);
        unsigned nloc = b.st[0], nx = b.st[1];
        if (nloc == 0u) { xcd_barrier_complete(bar, b.x, nloc, nx); b.st[0] = nloc; b.st[1] = nx; }
        const unsigned old = xb_add(&bar[XB_XSUB(b.x)], 1u);
        const unsigned gen = old / nloc;
        if (old + 1u == (gen + 1u) * nloc) {
            __builtin_amdgcn_fence(__ATOMIC_RELEASE, "agent");
            asm volatile("s_waitcnt vmcnt(0)" ::: "memory");
            const unsigned og = xb_add(&bar[XB_TOP], 1u);
            const unsigned tg = og / nx;
            if (og + 1u == (tg + 1u) * nx) xb_add(&bar[XB_TOPGEN], 1u);
            else XB_SPIN(xb_ld(&bar[XB_TOPGEN]) == tg, bar);
            __builtin_amdgcn_fence(__ATOMIC_ACQUIRE, "agent");
            xb_add(&bar[XB_XGEN(b.x)], 1u);
            asm volatile("s_waitcnt vmcnt(0)" ::: "memory");
        } else {
            XB_SPIN(xb_ld(&bar[XB_XGEN(b.x)]) == gen, bar);
            __builtin_amdgcn_fence(__ATOMIC_ACQUIRE, "agent");
            asm volatile("s_waitcnt vmcnt(0)" ::: "memory");
        }
    }
    __syncthreads();
}

struct Args { const float* in[33]; float* out; unsigned char* ws; int ph_lo, ph_hi; };
struct Frame {
    LAS unsigned char* lds;
    int wave, wg, G;
    const struct Args* A; float* out; unsigned char* ws;
};
enum In { I_X = 0, I_N1G, I_WIN, I_POOLW, I_POOLS, I_CONVW, I_CONVB, I_CLNG, I_CLNB, I_MU, I_W0, I_W2, I_A0, I_A2, I_G2, I_KK, I_KA, I_RK, I_GNG, I_GNB, I_V0, I_V1, I_V2, I_WOUT, I_N2G,
          I_FG, I_FU, I_FD, I_ROUTER, I_MG, I_MU2, I_MD, I_FINALG };

#define LDS_WAIT() asm volatile("s_waitcnt lgkmcnt(0)" ::: "memory")
#define LDS_BAR() do { asm volatile("s_waitcnt lgkmcnt(0)" ::: "memory"); __builtin_amdgcn_s_barrier(); asm volatile("" ::: "memory"); } while (0)
#define PIN_MEM() asm volatile("" ::: "memory")
DI u32x4 ldg16(const bf16* p) { return *(const u32x4*)p; }
struct CvItem { const float* W; bf16* WT; int K, N, k0, n0, drow0; };
DI void cv_load(const CvItem& c, const int lane, f32x4 (&r)[16]) {
#pragma unroll
    for (int i = 0; i < 16; ++i) r[i] = __builtin_nontemporal_load((const f32x4*)(c.W + (size_t)(c.k0 + 4 * i + (lane >> 4)) * c.N + c.n0 + 4 * (lane & 15)));
}
DI bf16x8 cv_trfrag(const LAS unsigned char* img, const int c0, const int kb, const int lane);
template <int F8SC> DI void cv_store(const CvItem& c, const int lane, const f32x4 (&r)[16], LAS unsigned char* img) {
#pragma unroll
    for (int i = 0; i < 16; ++i) { u32x2 w; w.x = pk2(r[i][0], r[i][1]); w.y = pk2(r[i][2], r[i][3]); *(LAS u32x2*)(img + ((4 * i + (lane >> 4)) * 72 + 4 * (lane & 15)) * 2) = w; }
    LDS_WAIT(); asm volatile("" ::: "memory");
#pragma unroll
    for (int nb = 0; nb < 4; ++nb)
#pragma unroll
        for (int kh = 0; kh < 2; ++kh) { const bf16x8 v = cv_trfrag(img, 16 * nb, kh, lane);
            if constexpr (F8SC == 0) *(bf16x8*)(c.WT + (size_t)(c.drow0 + 16 * nb + (lane & 15)) * c.K + c.k0 + 32 * kh + 8 * (lane >> 4)) = v;
            else { float f[8]; unpack8(__builtin_bit_cast(u32x4, v), f); constexpr float sc = (float)F8SC; u32x2 w; w.x = pk4_f8(f[0] * sc, f[1] * sc, f[2] * sc, f[3] * sc); w.y = pk4_f8(f[4] * sc, f[5] * sc, f[6] * sc, f[7] * sc);
                *(u32x2*)((unsigned char*)c.WT + (size_t)(c.drow0 + 16 * nb + (lane & 15)) * c.K + c.k0 + 32 * kh + 8 * (lane >> 4)) = w; } }
    LDS_WAIT(); asm volatile("" ::: "memory");
}
DI CvItem cv_plain(const float* W, int K, int N, bf16* WT, int item) { const int nblk = N / 64, kb = item / nblk, nb = item % nblk; return CvItem{W, WT, K, N, 64 * kb, 64 * nb, 64 * nb}; }
DI CvItem cv_gu(const float* W, int K, int Fh, bf16* WT, int up, int item) { const int nblk = Fh / 64, kb = item / nblk, nb = item % nblk, n0 = 64 * nb; return CvItem{W, WT, K, Fh, 64 * kb, n0, 256 * (n0 / 128) + up * 128 + (n0 % 128)}; }
template <int F8SC, class Desc> DI void cv_run(const Desc& desc, const int nitems, const int first, const int stride, const int lane, LAS float* scr_) {
    if (first >= nitems) return;
    LAS unsigned char* img = (LAS unsigned char*)scr_;
    f32x4 ra[16], rb[16];
    CvItem ca = desc(first), cb = ca;
    cv_load(ca, lane, ra);
    for (int it = first; it < nitems; it += 2 * stride) {
        const bool hb = (it + stride) < nitems;
        if (hb) { cb = desc(it + stride); cv_load(cb, lane, rb); }
        PIN_MEM();
        cv_store<F8SC>(ca, lane, ra, img);
        const bool ha = (it + 2 * stride) < nitems;
        if (ha) { ca = desc(it + 2 * stride); cv_load(ca, lane, ra); }
        PIN_MEM();
        if (hb) cv_store<F8SC>(cb, lane, rb, img);
    }
}

DI void store_row_bf16(bf16* orow, int lane, const f32x4 (&y)[4]) {
    u32x2* o8 = (u32x2*)orow + lane;
#pragma unroll
    for (int j = 0; j < 4; ++j) { u32x2 w; w.x = pk2(y[j].x, y[j].y); w.y = pk2(y[j].z, y[j].w); o8[64 * j] = w; }
}
DI void store_row_f8(unsigned char* orow, int lane, const f32x4 (&y)[4]) {
    unsigned* o4 = (unsigned*)orow + lane;
#pragma unroll
    for (int j = 0; j < 4; ++j) o4[64 * j] = pk4_f8(y[j].x * F8S_X, y[j].y * F8S_X, y[j].z * F8S_X, y[j].w * F8S_X);
}
DI void norm_rows_phase(Frame& F, const float* src, const float* g, bf16* dst) {
    const int lane = (int)threadIdx.x & 63, gw = F.wg * NWAVES + F.wave, NGW = F.G * NWAVES;
    f32x4 cr[2][4], nr[2][4];
#pragma unroll
    for (int q = 0; q < 2; ++q) { const int mq = (gw + q * NGW < M) ? gw + q * NGW : gw;
#pragma unroll
        for (int j = 0; j < 4; ++j) cr[q][j] = ((const f32x4*)(src + (size_t)mq * D) + lane)[64 * j]; }
#pragma unroll 1
    for (int m = gw; m < M; m += 2 * NGW) {
#pragma unroll
        for (int q = 0; q < 2; ++q) { const int mq = (m + (2 + q) * NGW < M) ? m + (2 + q) * NGW : m;
#pragma unroll
            for (int j = 0; j < 4; ++j) nr[q][j] = ((const f32x4*)(src + (size_t)mq * D) + lane)[64 * j]; }
        float ss[2] = {0.f, 0.f};
#pragma unroll
        for (int q = 0; q < 2; ++q)
#pragma unroll
            for (int j = 0; j < 4; ++j) ss[q] += (cr[q][j].x * cr[q][j].x + cr[q][j].y * cr[q][j].y) + (cr[q][j].z * cr[q][j].z + cr[q][j].w * cr[q][j].w);
#pragma unroll
        for (int q = 0; q < 2; ++q) { const float rstd = 1.0f / sqrtf(wave_sum(ss[q]) * (1.f / D) + RMS_EPS); const int mq = m + q * NGW; f32x4 y[4];
#pragma unroll
            for (int j = 0; j < 4; ++j) y[j] = cr[q][j] * rstd * ((const f32x4*)g + lane)[64 * j];
            if (mq < M) store_row_bf16(dst + (size_t)mq * D, lane, y); }
#pragma unroll
        for (int q = 0; q < 2; ++q)
#pragma unroll
            for (int j = 0; j < 4; ++j) cr[q][j] = nr[q][j];
    }
}
template <bool OUT_F32> DI void norm_rows_phase_b(Frame& F, const bf16* src, const float* g, void* dst) {
    const int lane = (int)threadIdx.x & 63, gw = F.wg * NWAVES + F.wave, NGW = F.G * NWAVES;
    f32x4 gg[4];
#pragma unroll
    for (int j = 0; j < 4; ++j) gg[j] = ((const f32x4*)g + lane)[64 * j];
    u32x2 cr[2][4], nr[2][4];
#pragma unroll
    for (int q = 0; q < 2; ++q) { const int mq = (gw + q * NGW < M) ? gw + q * NGW : gw;
#pragma unroll
        for (int j = 0; j < 4; ++j) cr[q][j] = ((const u32x2*)(src + (size_t)mq * D) + lane)[64 * j]; }
#pragma unroll 1
    for (int m = gw; m < M; m += 2 * NGW) {
#pragma unroll
        for (int q = 0; q < 2; ++q) { const int mq = (m + (2 + q) * NGW < M) ? m + (2 + q) * NGW : m;
#pragma unroll
            for (int j = 0; j < 4; ++j) nr[q][j] = ((const u32x2*)(src + (size_t)mq * D) + lane)[64 * j]; }
        f32x4 y[2][4]; float ss[2] = {0.f, 0.f};
#pragma unroll
        for (int q = 0; q < 2; ++q)
#pragma unroll
            for (int j = 0; j < 4; ++j) { const u32x2 v = cr[q][j]; y[q][j] = (f32x4){bflo(v.x), bfhi(v.x), bflo(v.y), bfhi(v.y)}; ss[q] += (y[q][j].x * y[q][j].x + y[q][j].y * y[q][j].y) + (y[q][j].z * y[q][j].z + y[q][j].w * y[q][j].w); }
#pragma unroll
        for (int q = 0; q < 2; ++q) { const float rstd = 1.0f / sqrtf(wave_sum(ss[q]) * (1.f / D) + RMS_EPS); const int mq = m + q * NGW;
#pragma unroll
            for (int j = 0; j < 4; ++j) y[q][j] = y[q][j] * rstd * gg[j];
            if (mq < M) { if constexpr (OUT_F32) { f32x4* o = (f32x4*)((float*)dst + (size_t)mq * D) + lane;
#pragma unroll
                    for (int j = 0; j < 4; ++j) o[64 * j] = y[q][j]; }
                else store_row_bf16((bf16*)dst + (size_t)mq * D, lane, y[q]); } }
#pragma unroll
        for (int q = 0; q < 2; ++q)
#pragma unroll
            for (int j = 0; j < 4; ++j) cr[q][j] = nr[q][j];
    }
}
template <int JOB> DI void convert_main(Frame& F, const int first, const int stride, LAS float* scr) {
    unsigned char* ws = F.ws; const Args* A = F.A;
    constexpr int I_IN = (D / 64) * (NIN / 64), I_OUT = (D / 64) * (D / 64), I_GU = (D / 64) * (FF / 64), I_DN = (FF / 64) * (D / 64);
    if (JOB == 0) {
        auto desc = [=](int it) -> CvItem { return cv_plain(A->in[I_WIN], D, NIN, (bf16*)(ws + WS_WIN), it); };
        cv_run<0>(desc, I_IN, first, stride, ((int)threadIdx.x & 63), scr);
    } else {
        constexpr int NITEMS = I_IN + 2 * I_OUT + 2 * I_GU + I_DN;
        auto desc = [=](int it) -> CvItem {
            int r = it;
            if (r < I_IN) return cv_plain(A->in[I_WIN] + (size_t)D * NIN, D, NIN, (bf16*)(ws + WS_WIN) + (size_t)NIN * D, r); r -= I_IN;
            if (r < 2 * I_OUT) { const int l = r / I_OUT; return cv_plain(A->in[I_WOUT] + (size_t)l * D * D, D, D, (bf16*)(ws + WS_WOUT) + (size_t)l * D * D, r % I_OUT); } r -= 2 * I_OUT;
            if (r < I_GU) return cv_gu(A->in[I_FG], D, FF, (bf16*)(ws + WS_WGU), 0, r); r -= I_GU;
            if (r < I_GU) return cv_gu(A->in[I_FU], D, FF, (bf16*)(ws + WS_WGU), 1, r); r -= I_GU;
            return cv_plain(A->in[I_FD], FF, D, (bf16*)(ws + WS_WDN), r);
        };
        cv_run<0>(desc, NITEMS, first, stride, ((int)threadIdx.x & 63), scr);
    }
}
DI void p0_prologue(Frame& F) {
    LAS float* scr = (LAS float*)(F.lds + F.wave * 16384);
    const int gw = F.wg * NWAVES + F.wave, NGW = F.G * NWAVES;
    unsigned char* ws = F.ws;
    convert_main<0>(F, gw, NGW, scr);
    const int gt = F.wg * NTHR + ((int)threadIdx.x), NGT = F.G * NTHR;
    for (int i = gt; i < 2 * 4 * 64 * 64; i += NGT) { const int c = i & 63, n = (i >> 6) & 63, lg = i >> 12; ((bf16*)(ws + SM_POOLT))[i] = (bf16)(pk2(F.A->in[I_POOLW][(size_t)lg * 4096 + c * 64 + n], 0.f) & 0xffffu); }
    for (int i = gt; i < 2 * 512 * 64; i += NGT) { const int j = i & 63, n = (i >> 6) & 511, l = i >> 15;
        ((bf16*)(ws + SM_W2T))[i] = (bf16)(pk2(F.A->in[I_W2][(size_t)l * 64 * 512 + j * 512 + n], 0.f) & 0xffffu);
        ((bf16*)(ws + SM_A2T))[i] = (bf16)(pk2(F.A->in[I_A2][(size_t)l * 64 * 512 + j * 512 + n], 0.f) & 0xffffu); }
    for (int i = gt; i < 2 * 512 * 128; i += NGT) { const int j = i & 127, n = (i >> 7) & 511, l = i >> 16; ((bf16*)(ws + SM_G2T))[i] = (bf16)(pk2(F.A->in[I_G2][(size_t)l * 128 * 512 + j * 512 + n], 0.f) & 0xffffu); }
    for (int i = gt; i < 32 * 512; i += NGT) { const int c = i & 511, r = i >> 9; ((bf16*)(ws + SM_V1T))[i] = (bf16)(pk2(F.A->in[I_V1][(size_t)c * 32 + r], 0.f) & 0xffffu); }
    for (int i = gt; i < 512 * 32; i += NGT) { const int r = i & 31, n = i >> 5; ((bf16*)(ws + SM_V2T))[i] = (bf16)(pk2(F.A->in[I_V2][(size_t)r * 512 + n], 0.f) & 0xffffu); }
}
template <int JOB> DI void moe_weight_convert(Frame& F, const int first, const int stride, LAS float* scr) {
    constexpr int I_G = (D / 64) * (FE / 64), I_D = (FE / 64) * (D / 64);
    const Args* A = F.A; unsigned char* ws = F.ws;
    if (JOB == 0) {
        auto desc = [=](int it) -> CvItem {
            const int e = it / (2 * I_G); int r = it % (2 * I_G);
            bf16* gu = (bf16*)(ws + WS_WMGU + (size_t)e * 2 * FE * D);
            if (r < I_G) return cv_gu(A->in[I_MG] + (size_t)e * D * FE, D, FE, gu, 0, r);
            return cv_gu(A->in[I_MU2] + (size_t)e * D * FE, D, FE, gu, 1, r - I_G);
        };
        cv_run<(int)F8S_WGU>(desc, NE * 2 * I_G, first, stride, ((int)threadIdx.x & 63), scr);
    } else {
        auto desc = [=](int it) -> CvItem { const int e = it / I_D, r = it % I_D; return cv_plain(A->in[I_MD] + (size_t)e * FE * D, FE, D, (bf16*)(ws + WS_WMDN + (size_t)e * D * FE), r); };
        cv_run<(int)F8S_WDN>(desc, NE * I_D, first, stride, ((int)threadIdx.x & 63), scr);
    }
}

DI void mixc_unit(Frame& F, const int l, const int tile) {
    int tid_ = ((int)threadIdx.x); asm volatile("" : "+v"(tid_));
    const int tid = tid_, lane = tid & 63, wave = __builtin_amdgcn_readfirstlane(tid >> 6);
    const int row0 = tile * 64, tseq = row0 & (T - 1);
    const bf16* proj = (const bf16*)(F.ws + WS_PROJ);
    bf16* mix = (bf16*)(F.ws + WS_MIX);
    u32x4 pv[5]; bool pok[5];
#pragma unroll
    for (int k = 0; k < 5; ++k) { const int idx = tid + k * NTHR, r = idx >> 5, cc = idx & 31; pok[k] = (idx < 79 * 32) && (tseq - 15 + r >= 0); pv[k] = ldg16(proj + (size_t)(pok[k] ? row0 - 15 + r : row0) * NIN + cc * 8); }
    u32x4 ca[6], cb[6]; bool cok[6];
#pragma unroll
    for (int k = 0; k < 6; ++k) { const int idx = tid + k * NTHR, r = idx >> 5, cc = idx & 31; cok[k] = (idx < 94 * 32) && (tseq - 30 + r >= 0); const bf16* p = proj + (size_t)(cok[k] ? row0 - 30 + r : row0) * NIN + cc * 8;
        ca[k] = ldg16(p + C_CONVA); cb[k] = ldg16(p + C_CONVB); }
    const int cch = tid & 255, half = tid >> 8; const float* cw = F.A->in[I_CONVW] + (size_t)l * 31 * 256 + cch; float w[31];
#pragma unroll
    for (int j = 0; j < 31; ++j) w[j] = cw[j * 256];
    const float bias = F.A->in[I_CONVB][l * 256 + cch];
    bf16x8 pfr[4][2]; f32x4 psc[4];
    { const bf16* PT = (const bf16*)(F.ws + SM_POOLT) + (size_t)(l * 4 + (wave >> 1)) * 4096; const float* sc = F.A->in[I_POOLS] + l * 256 + (wave >> 1) * 64;
#pragma unroll
      for (int nt = 0; nt < 4; ++nt) { psc[nt] = *(const f32x4*)(sc + nt * 16 + 4 * (lane >> 4));
#pragma unroll
          for (int ks = 0; ks < 2; ++ks) pfr[nt][ks] = *(const bf16x8*)(PT + (nt * 16 + (lane & 15)) * 64 + ks * 32 + (lane >> 4) * 8); } }
    PIN_MEM();
    LAS bf16* PU = (LAS bf16*)F.lds; LAS bf16* DM = (LAS bf16*)(F.lds + 79 * 264 * 2 + 16);
#pragma unroll
    for (int k = 0; k < 5; ++k) { const int idx = tid + k * NTHR, r = idx >> 5, cc = idx & 31; if (idx < 79 * 32) *(LAS u32x4*)(PU + r * 264 + cc * 8) = pok[k] ? pv[k] : (u32x4){0u, 0u, 0u, 0u}; }
    LDS_BAR();
    {
        const int g = wave >> 1, win = 2 << g, cc = g * 8 + (lane & 7);
#pragma unroll
        for (int it = 0; it < 4; ++it) { const int t = (wave & 1) * 32 + it * 8 + (lane >> 3); const int pos = tseq + t; const int cnt = (pos + 1 < win) ? pos + 1 : win;
            float s[8], u[8];
#pragma unroll
            for (int k = 0; k < 8; ++k) s[k] = 0.f;
            unpack8(*(const LAS u32x4*)(PU + (15 + t) * 264 + cc * 8), u);
            for (int j = 0; j < win; ++j) { float x[8]; unpack8(*(const LAS u32x4*)(PU + (15 + t - j) * 264 + cc * 8), x);
#pragma unroll
                for (int k = 0; k < 8; ++k) s[k] += x[k]; }
            const float inv = 1.0f / (float)cnt;
#pragma unroll
            for (int k = 0; k < 8; ++k) s[k] = s[k] * inv - u[k];
            *(LAS u32x4*)(DM + t * 264 + cc * 8) = pack8(s); }
    }
    LDS_BAR();
    {
        const int g = wave >> 1;
#pragma unroll
        for (int tt2 = 0; tt2 < 2; ++tt2) { const int tt = (wave & 1) * 2 + tt2;
            bf16x8 bfr[2];
#pragma unroll
            for (int ks = 0; ks < 2; ++ks) bfr[ks] = *(const LAS bf16x8*)(DM + (tt * 16 + (lane & 15)) * 264 + g * 64 + ks * 32 + (lane >> 4) * 8);
#pragma unroll
            for (int nt = 0; nt < 4; ++nt) { f32x4 acc = (f32x4){0.f, 0.f, 0.f, 0.f};
#pragma unroll
                for (int ks = 0; ks < 2; ++ks) acc = MFMA16(pfr[nt][ks], bfr[ks], acc);
                const int t = tt * 16 + (lane & 15), col = g * 64 + nt * 16 + 4 * (lane >> 4); const f32x4 s4 = psc[nt];
                u32x2 wv; wv.x = pk2(acc[0] * s4[0], acc[1] * s4[1]); wv.y = pk2(acc[2] * s4[2], acc[3] * s4[3]);
                *(u32x2*)(mix + (size_t)(row0 + t) * D + col) = wv; } }
    }
    LDS_BAR();
    LAS float* U = (LAS float*)F.lds;
#pragma unroll
    for (int k = 0; k < 6; ++k) { const int idx = tid + k * NTHR, r = idx >> 5, cc = idx & 31; float u[8], a[8], b[8]; unpack8(ca[k], a); unpack8(cb[k], b);
#pragma unroll
        for (int e = 0; e < 8; ++e) u[e] = cok[k] ? a[e] * sigmoidf_(b[e]) : 0.f;
        if (idx < 94 * 32) { *(LAS f32x4*)(U + r * 256 + cc * 8) = (f32x4){u[0], u[1], u[2], u[3]}; *(LAS f32x4*)(U + r * 256 + cc * 8 + 4) = (f32x4){u[4], u[5], u[6], u[7]}; } }
    u32x4 vc[8], vp[8];
    if (l == 1) {
#pragma unroll
        for (int k = 0; k < 8; ++k) { const int idx = tid + k * NTHR, t = idx >> 6, cc = idx & 63; const bf16* p = proj + (size_t)(row0 + t) * NIN + C_V + cc * 8; vc[k] = ldg16(p); vp[k] = ldg16(p - ((tseq + t > 0) ? NIN : 0)); }
        PIN_MEM();
    }
    LDS_BAR();
    {
        float y[32];
#pragma unroll
        for (int i = 0; i < 32; ++i) y[i] = bias;
#pragma unroll
        for (int r = 0; r < 62; ++r) { const float val = U[(half * 32 + r) * 256 + cch];
#pragma unroll
            for (int i = 0; i < 32; ++i) { const int j = r - i; if (j >= 0 && j <= 30) y[i] += w[j] * val; } }
        LDS_BAR();
#pragma unroll
        for (int i = 0; i < 32; ++i) U[(half * 32 + i) * 256 + cch] = y[i];
    }
    LDS_BAR();
    {
        const f32x4 lg = *(const f32x4*)(F.A->in[I_CLNG] + l * 256 + lane * 4), lb = *(const f32x4*)(F.A->in[I_CLNB] + l * 256 + lane * 4);
#pragma unroll 2
        for (int i = 0; i < 8; ++i) { const int t = wave * 8 + i; const f32x4 v = *(const LAS f32x4*)(U + t * 256 + lane * 4);
            const float mu = wave_sum((v.x + v.y) + (v.z + v.w)) * (1.f / 256.f); const f32x4 d = v - mu;
            const float var = wave_sum((d.x * d.x + d.y * d.y) + (d.z * d.z + d.w * d.w)) * (1.f / 256.f); const float rstd = 1.0f / sqrtf(var + LN_EPS);
            f32x4 o = d * rstd * lg + lb; u32x2 wv; wv.x = pk2(siluf_(o.x), siluf_(o.y)); wv.y = pk2(siluf_(o.z), siluf_(o.w));
            *(u32x2*)(mix + (size_t)(row0 + t) * D + 256 + lane * 4) = wv; }
    }
    if (l == 1) {
        LDS_BAR();
        LAS bf16* VS = (LAS bf16*)F.lds;
        const float* mu = F.A->in[I_MU] + l * NRC + (C_V - C_R);
#pragma unroll
        for (int k = 0; k < 8; ++k) { const int idx = tid + k * NTHR, t = idx >> 6, cc = idx & 63; float c8[8], p8[8]; unpack8(vc[k], c8); unpack8(vp[k], p8); const bool hp = (tseq + t) > 0;
            const f32x4 m0 = *(const f32x4*)(mu + cc * 8), m1 = *(const f32x4*)(mu + cc * 8 + 4);
#pragma unroll
            for (int e = 0; e < 8; ++e) c8[e] = c8[e] + (e < 4 ? m0[e & 3] : m1[e & 3]) * ((hp ? p8[e] : 0.f) - c8[e]);
            *(LAS u32x4*)(VS + t * 520 + cc * 8) = pack8(c8); }
        LDS_BAR();
        const int tt = wave & 3, rt = wave >> 2; const bf16* V1T = (const bf16*)(F.ws + SM_V1T); f32x4 acc = (f32x4){0.f, 0.f, 0.f, 0.f};
#pragma unroll 4
        for (int ks = 0; ks < 16; ++ks) { const bf16x8 a = *(const bf16x8*)(V1T + (rt * 16 + (lane & 15)) * 512 + ks * 32 + (lane >> 4) * 8);
            const bf16x8 b = *(const LAS bf16x8*)(VS + (tt * 16 + (lane & 15)) * 520 + ks * 32 + (lane >> 4) * 8); acc = MFMA16(a, b, acc); }
        *(f32x4*)((float*)(F.ws + WS_VV1) + (size_t)(row0 + tt * 16 + (lane & 15)) * 32 + rt * 16 + 4 * (lane >> 4)) = acc;
    }
    asm volatile("s_waitcnt vmcnt(0)" ::: "memory");
    LDS_BAR();
}

constexpr int S1_XW = 0, S1_XA = 9216, S1_XG = 18432, S1_XV = 35840;
constexpr int S1_AAB = 40960, S1_AAK = S1_AAB + 9216, S1_ARB = S1_AAK + 9216, S1_ARK = S1_ARB + 9216, S1_MT = S1_ARK + 9216, S1_XT = S1_MT + 9216, S1_TII = S1_XT + 9216;
constexpr int S1_RT = S1_TII + 3072, S1_AT = S1_RT + 9216, S1_BT = S1_AT + 9216, S1_KT = S1_BT + 9216, S1_VN = S1_KT + 9216;
constexpr int S1_WTOT = S1_VN + 9216, S1_NRM = S1_WTOT + 1024, S1_RKX = S1_NRM + 2048, S1_LC = S1_RKX + 2048, S1_MU = S1_LC + 256, S1_END = S1_MU + NRC * 4;
static_assert(S1_XV + 5120 <= S1_AAB && S1_END <= MISC_OFF, "S1 lds map");
#define LD_F8(ptr) (*(const LAS bf16x8*)(ptr))
typedef short s16x4 __attribute__((ext_vector_type(4)));
DI bf16x8 mk8(unsigned a, unsigned b, unsigned c, unsigned d) { u32x4 w = {a, b, c, d}; return __builtin_bit_cast(bf16x8, w); }
DI u32x2 pk4f(const f32x4 v) { u32x2 p; p.x = pk2(v[0], v[1]); p.y = pk2(v[2], v[3]); return p; }
DI f32x4 up4(const u32x2 v) { return (f32x4){bflo(v.x), bfhi(v.x), bflo(v.y), bfhi(v.y)}; }
DI bf16x8 mk8h(const u32x2 p) { return mk8(p.x, p.y, 0u, 0u); }
DI u32x2 tr_read(const LAS unsigned char* p) { return __builtin_bit_cast(u32x2, __builtin_amdgcn_ds_read_tr16_b64_v4i16((LAS s16x4*)p)); }
DI const LAS unsigned char* tr_addr(const LAS unsigned char* img, const int r0, const int c0, const int lane) { return img + ((r0 + ((lane & 15) >> 2)) * 72 + c0 + 4 * (lane & 3)) * 2; }
DI bf16x8 tr_frag(const LAS unsigned char* img, const int c0, const int kb, const int lane) {
    const int r0 = 32 * kb + 8 * (lane >> 4);
    const u32x2 lo = tr_read(tr_addr(img, r0, c0, lane)), hi = tr_read(tr_addr(img, r0 + 4, c0, lane));
    return mk8(lo.x, lo.y, hi.x, hi.y);
}
DI bf16x8 cv_trfrag(const LAS unsigned char* img, const int c0, const int kb, const int lane) { return tr_frag(img, c0, kb, lane); }
DI void shift8(const u32x4 cur, const u32x4 prev, const bool hasprev, const LAS unsigned char* L, const int col, float (&o)[8]) {
    float c8[8], p8[8]; unpack8(cur, c8); unpack8(prev, p8);
    const f32x4 m0 = *(const LAS f32x4*)(L + S1_MU + (col - C_R) * 4), m1 = *(const LAS f32x4*)(L + S1_MU + (col - C_R + 4) * 4);
#pragma unroll
    for (int k = 0; k < 8; ++k) o[k] = c8[k] + (k < 4 ? m0[k & 3] : m1[k & 3]) * ((hasprev ? p8[k] : 0.f) - c8[k]);
}
DI f32x4 shift4(const u32x2 cur, const u32x2 prev, const bool hasprev, const LAS unsigned char* L, const int col) {
    const f32x4 c = up4(cur), p = hasprev ? up4(prev) : (f32x4){0.f, 0.f, 0.f, 0.f}, m = *(const LAS f32x4*)(L + S1_MU + (col - C_R) * 4);
    return c + m * (p - c);
}
DI void s1_stage_mu(Frame& F, const int l) {
    for (int i = ((int)threadIdx.x); i < NRC / 4; i += NTHR) *(LAS f32x4*)(F.lds + S1_MU + i * 16) = *(const f32x4*)(F.A->in[I_MU] + l * NRC + i * 4);
    LDS_BAR();
}
DI void s1_chunk_prep(Frame& F, const int l, const int gchunk) {
    int tid_ = ((int)threadIdx.x); asm volatile("" : "+v"(tid_));
    const int t = tid_ >> 3, n8 = tid_ & 7, row0 = gchunk * 64;
    const bool hasprev = ((row0 & (T - 1)) + t) > 0;
    const bf16* prow = (const bf16*)(F.ws + WS_PROJ) + (size_t)(row0 + t) * NIN; const bf16* pprev = prow - (hasprev ? NIN : 0);
    LAS unsigned char* L = F.lds;
    const u32x4 cxw = ldg16(prow + C_XW + n8 * 8), pxw = ldg16(pprev + C_XW + n8 * 8), cxa = ldg16(prow + C_XA + n8 * 8), pxa = ldg16(pprev + C_XA + n8 * 8);
    const u32x4 cg0 = ldg16(prow + C_XG + n8 * 16), pg0 = ldg16(pprev + C_XG + n8 * 16), cg1 = ldg16(prow + C_XG + n8 * 16 + 8), pg1 = ldg16(pprev + C_XG + n8 * 16 + 8);
    f32x4 vv1 = (f32x4){0.f, 0.f, 0.f, 0.f}; if (l == 1) vv1 = *(const f32x4*)((const float*)(F.ws + WS_VV1) + (size_t)(row0 + t) * 32 + n8 * 4);
    PIN_MEM();
    float x[8];
    shift8(cxw, pxw, hasprev, L, C_XW + n8 * 8, x);
#pragma unroll
    for (int k = 0; k < 8; ++k) { const float e = fast_exp(2.0f * x[k]); x[k] = 1.0f - 2.0f * __builtin_amdgcn_rcpf(e + 1.0f); }
    *(LAS u32x4*)(L + S1_XW + (t * 72 + n8 * 8) * 2) = pack8(x);
    shift8(cxa, pxa, hasprev, L, C_XA + n8 * 8, x);
    *(LAS u32x4*)(L + S1_XA + (t * 72 + n8 * 8) * 2) = pack8(x);
    shift8(cg0, pg0, hasprev, L, C_XG + n8 * 16, x);
#pragma unroll
    for (int k = 0; k < 8; ++k) x[k] = sigmoidf_(x[k]);
    *(LAS u32x4*)(L + S1_XG + (t * 136 + n8 * 16) * 2) = pack8(x);
    shift8(cg1, pg1, hasprev, L, C_XG + n8 * 16 + 8, x);
#pragma unroll
    for (int k = 0; k < 8; ++k) x[k] = sigmoidf_(x[k]);
    *(LAS u32x4*)(L + S1_XG + (t * 136 + n8 * 16 + 8) * 2) = pack8(x);
    if (l == 1) *(LAS u32x2*)(L + S1_XV + (t * 40 + n8 * 4) * 2) = pk4f(vv1);
    LDS_BAR();
}
struct S1Pre { u32x2 cr[2], pr[2], ck[2], pk[2], cv[2], pv[2], vf[2]; };
DI void s1_issue(Frame& F, const int l, const int gchunk, const int h, S1Pre& P) {
    int tid_ = ((int)threadIdx.x); asm volatile("" : "+v"(tid_));
    const int lane = tid_ & 63, wave = tid_ >> 6, t = 16 * (wave & 3) + (lane & 15), row0 = gchunk * 64;
    const bool hasprev = ((row0 & (T - 1)) + t) > 0;
    const bf16* prow = (const bf16*)(F.ws + WS_PROJ) + (size_t)(row0 + t) * NIN; const bf16* pprev = prow - (hasprev ? NIN : 0);
#pragma unroll
    for (int nn = 0; nn < 2; ++nn) { const int c = h * 64 + (2 * (wave >> 2) + nn) * 16 + 4 * (lane >> 4);
        P.cr[nn] = *(const u32x2*)(prow + C_R + c); P.pr[nn] = *(const u32x2*)(pprev + C_R + c); P.ck[nn] = *(const u32x2*)(prow + C_K + c); P.pk[nn] = *(const u32x2*)(pprev + C_K + c);
        P.cv[nn] = *(const u32x2*)(prow + C_V + c); P.pv[nn] = *(const u32x2*)(pprev + C_V + c);
        P.vf[nn] = (l == 1) ? *(const u32x2*)((const bf16*)(F.ws + WS_VF) + (size_t)(row0 + t) * RW + c) : P.cv[nn]; }
    PIN_MEM();
}

DI void s1_unit(Frame& F, const int l, const int gchunk, const int h, const S1Pre& pre, const int hn, S1Pre& nxt) {
    int tid_ = ((int)threadIdx.x); asm volatile("" : "+v"(tid_));
    const int tid = tid_, lane = tid & 63, wave = __builtin_amdgcn_readfirstlane(tid >> 6), fr = lane & 15, fq = lane >> 4;
    const int row0 = gchunk * 64, tseq0 = row0 & (T - 1), unit = gchunk * 8 + h;
    const int tt = wave & 3, nh = wave >> 2, t = 16 * tt + fr;
    const bool hasprev = (tseq0 + t) > 0;
    LAS unsigned char* L = F.lds;
    bf16x8 fw[2][2], fa[2][2], fg[2][4], fv[2];
    f32x4 cw0[2], ca0[2], ckk[2], cka[2], crk[2], cv0[2];
    {
        const bf16* W2T = (const bf16*)(F.ws + SM_W2T) + (size_t)(l * 512 + h * 64) * 64; const bf16* A2T = (const bf16*)(F.ws + SM_A2T) + (size_t)(l * 512 + h * 64) * 64;
        const bf16* G2T = (const bf16*)(F.ws + SM_G2T) + (size_t)(l * 512 + h * 64) * 128; const bf16* V2T = (const bf16*)(F.ws + SM_V2T) + (size_t)(h * 64) * 32;
#pragma unroll
        for (int nn = 0; nn < 2; ++nn) { const int nr = (nh * 2 + nn) * 16 + fr, hc = h * 64 + (nh * 2 + nn) * 16 + 4 * fq;
#pragma unroll
            for (int ks = 0; ks < 2; ++ks) { fw[nn][ks] = *(const bf16x8*)(W2T + nr * 64 + ks * 32 + fq * 8); fa[nn][ks] = *(const bf16x8*)(A2T + nr * 64 + ks * 32 + fq * 8); }
#pragma unroll
            for (int ks = 0; ks < 4; ++ks) fg[nn][ks] = *(const bf16x8*)(G2T + nr * 128 + ks * 32 + fq * 8);
            fv[nn] = (l == 1) ? *(const bf16x8*)(V2T + nr * 32 + fq * 8) : fw[nn][0];
            cw0[nn] = *(const f32x4*)(F.A->in[I_W0] + l * RW + hc); ca0[nn] = *(const f32x4*)(F.A->in[I_A0] + l * RW + hc); ckk[nn] = *(const f32x4*)(F.A->in[I_KK] + l * RW + hc);
            cka[nn] = *(const f32x4*)(F.A->in[I_KA] + l * RW + hc); crk[nn] = *(const f32x4*)(F.A->in[I_RK] + l * RW + hc); cv0[nn] = (l == 1) ? *(const f32x4*)(F.A->in[I_V0] + hc) : cw0[nn]; }
    }
    PIN_MEM();
    f32x4 lw[2], cs[2], av[2], kk[2], km[2], vm[2], r4[2], k4[2], v4[2];
    float nrm = 0.f, rk = 0.f;
#pragma unroll
    for (int nn = 0; nn < 2; ++nn) { const int c0 = h * 64 + (nh * 2 + nn) * 16 + 4 * fq;
        r4[nn] = shift4(pre.cr[nn], pre.pr[nn], hasprev, L, C_R + c0); k4[nn] = shift4(pre.ck[nn], pre.pk[nn], hasprev, L, C_K + c0); v4[nn] = shift4(pre.cv[nn], pre.pv[nn], hasprev, L, C_V + c0); }
#pragma unroll
    for (int nn = 0; nn < 2; ++nn) { const int nt = nh * 2 + nn; f32x4 aw = (f32x4){0.f, 0.f, 0.f, 0.f}, aa = aw, ag = aw, ap = aw;
#pragma unroll
        for (int ks = 0; ks < 2; ++ks) { const int ko = ks * 32 + fq * 8;
            aw = MFMA16(fw[nn][ks], LD_F8(L + S1_XW + (t * 72 + ko) * 2), aw);
            aa = MFMA16(fa[nn][ks], LD_F8(L + S1_XA + (t * 72 + ko) * 2), aa); }
#pragma unroll
        for (int ks = 0; ks < 4; ++ks) ag = MFMA16(fg[nn][ks], LD_F8(L + S1_XG + (t * 136 + ks * 32 + fq * 8) * 2), ag);
        if (l == 1) ap = MFMA16(fv[nn], LD_F8(L + S1_XV + (t * 40 + fq * 8) * 2), ap);
        *(u32x2*)((bf16*)(F.ws + WS_GB) + (size_t)(row0 + t) * RW + h * 64 + nt * 16 + 4 * fq) = pk4f(ag);
        const int c0 = h * 64 + nt * 16 + 4 * fq;
        const f32x4 vf4 = up4(pre.vf[nn]);
#pragma unroll
        for (int j = 0; j < 4; ++j) {
            const float x = -(cw0[nn][j] + aw[j]);
            const float sp = fmaxf(x, 0.f) + __logf(1.0f + __expf(-fabsf(x)));
            lw[nn][j] = -__expf(-sp - 0.5f);
            av[nn][j] = __builtin_amdgcn_rcpf(1.0f + __expf(-(ca0[nn][j] + aa[j])));
            kk[nn][j] = k4[nn][j] * ckk[nn][j]; nrm += kk[nn][j] * kk[nn][j];
            km[nn][j] = k4[nn][j] * (1.0f + (av[nn][j] - 1.0f) * cka[nn][j]);
            rk += r4[nn][j] * km[nn][j] * crk[nn][j];
            vm[nn][j] = (l == 1) ? v4[nn][j] + (vf4[j] - v4[nn][j]) * __builtin_amdgcn_rcpf(1.0f + __expf(-(cv0[nn][j] + ap[j]))) : v4[nn][j];
        }
        cs[nn] = lw[nn];
        *(u32x2*)((bf16*)(F.ws + (l == 0 ? WS_VF : WS_VMB)) + (size_t)(row0 + t) * RW + c0) = pk4f(vm[nn]);
    }
    *(LAS float*)(L + S1_NRM + (t * 8 + nh * 4 + fq) * 4) = nrm; *(LAS float*)(L + S1_RKX + (t * 8 + nh * 4 + fq) * 4) = rk;
#pragma unroll
    for (int nn = 0; nn < 2; ++nn)
#pragma unroll
        for (int j = 0; j < 4; ++j) cs[nn][j] = row_scan16(cs[nn][j]);
    if (fr == 15) {
#pragma unroll
        for (int nn = 0; nn < 2; ++nn) *(LAS f32x4*)(L + S1_WTOT + (tt * 64 + (nh * 2 + nn) * 16 + 4 * fq) * 4) = cs[nn]; }
    LDS_BAR();
    {
        const f32x4 na = *(const LAS f32x4*)(L + S1_NRM + t * 32), nb = *(const LAS f32x4*)(L + S1_NRM + t * 32 + 16);
        const float n2 = ((na[0] + na[1]) + (na[2] + na[3])) + ((nb[0] + nb[1]) + (nb[2] + nb[3]));
        const float inv = __builtin_amdgcn_rsqf(fmaxf(n2, 1e-24f));
        if (nh == 0 && fq == 0) { const f32x4 ra = *(const LAS f32x4*)(L + S1_RKX + t * 32), rb = *(const LAS f32x4*)(L + S1_RKX + t * 32 + 16); ((float*)(F.ws + WS_RKB))[(size_t)(row0 + t) * 8 + h] = ((ra[0] + ra[1]) + (ra[2] + ra[3])) + ((rb[0] + rb[1]) + (rb[2] + rb[3])); }
#pragma unroll
        for (int nn = 0; nn < 2; ++nn) { const int nc = (nh * 2 + nn) * 16 + 4 * fq;
            f32x4 off = (f32x4){0.f, 0.f, 0.f, 0.f}, tot = off;
#pragma unroll
            for (int w = 0; w < 4; ++w) { const f32x4 x = *(const LAS f32x4*)(L + S1_WTOT + (w * 64 + nc) * 4); tot = tot + x; if (w < tt) off = off + x; }
            f32x4 rt, kt, at, bt;
#pragma unroll
            for (int j = 0; j < 4; ++j) { const float Lc = cs[nn][j] + off[j];
                const float eL = __expf(Lc), eN = __expf(-Lc), eP = __expf(Lc - lw[nn][j]); const float kkn = kk[nn][j] * inv;
                rt[j] = r4[nn][j] * eL; kt[j] = km[nn][j] * eN; at[j] = -kkn * eP; bt[j] = kkn * av[nn][j] * eN; }
            if (tt == 0 && fr == 0) *(LAS f32x4*)(L + S1_LC + nc * 4) = tot;
            const int on = (t * 72 + nc) * 2;
            *(LAS u32x2*)(L + S1_RT + on) = pk4f(rt); *(LAS u32x2*)(L + S1_AT + on) = pk4f(at); *(LAS u32x2*)(L + S1_BT + on) = pk4f(bt); *(LAS u32x2*)(L + S1_KT + on) = pk4f(kt); *(LAS u32x2*)(L + S1_VN + on) = pk4f(vm[nn]); }
    }
    LDS_BAR();
    f32x4 rhs[4];
    {
        const int mi = wave >> 1, par = wave & 1;
        const int xo = (mi < 2) ? S1_AT : S1_RT, yo = (mi & 1) ? S1_KT : S1_BT, dst = S1_AAB + mi * 9216;
        int idx = 0;
#pragma unroll
        for (int ti = 0; ti < 4; ++ti)
#pragma unroll
            for (int si = 0; si < 4; ++si, ++idx) {
                if ((idx & 1) != par) continue;
                u32x2 w = {0u, 0u};
                if (si <= ti) {
                    f32x4 acc = (f32x4){0.f, 0.f, 0.f, 0.f};
#pragma unroll
                    for (int ks = 0; ks < 2; ++ks) acc = MFMA16(LD_F8(L + yo + ((si * 16 + fr) * 72 + ks * 32 + fq * 8) * 2), LD_F8(L + xo + ((ti * 16 + fr) * 72 + ks * 32 + fq * 8) * 2), acc);
                    if (si == ti) {
#pragma unroll
                        for (int j = 0; j < 4; ++j) { const int sl = 4 * fq + j; const bool keep = (mi < 2) ? (sl < fr) : (sl <= fr); acc[j] = keep ? acc[j] : 0.f; }
                    }
                    w = pk4f(acc);
                }
                *(LAS u32x2*)(L + dst + ((ti * 16 + fr) * 72 + si * 16 + 4 * fq) * 2) = w;
            }
    }
    if (wave < 4) {
        const f32x4 z4 = (f32x4){0.f, 0.f, 0.f, 0.f};
        f32x4 va = z4, ua = z4;
#pragma unroll
        for (int ks = 0; ks < 2; ++ks) { const bf16x8 fA = LD_F8(L + S1_AT + ((wave * 16 + fr) * 72 + ks * 32 + fq * 8) * 2), fB = LD_F8(L + S1_BT + ((wave * 16 + fr) * 72 + ks * 32 + fq * 8) * 2);
            va = MFMA16(fB, fA, va); ua = MFMA16(fA, fB, ua); }
#pragma unroll
        for (int j = 0; j < 4; ++j) { va[j] = (4 * fq + j < fr) ? va[j] : 0.f; ua[j] = (fr < 4 * fq + j) ? ua[j] : 0.f; }
        const u32x2 v0 = pk4f(va), u0 = pk4f(ua);
        f32x4 w1 = up4(v0);
#pragma unroll
        for (int j = 0; j < 4; ++j) w1[j] += (4 * fq + j == fr) ? 1.0f : 0.0f;
        const u32x2 w1p = pk4f(w1);
        const u32x2 u1 = pk4f(MFMA16(mk8h(v0), mk8h(u0), z4)), v1 = pk4f(MFMA16(mk8h(u0), mk8h(v0), z4));
        const f32x4 w2 = MFMA16(mk8h(u1), mk8h(w1p), w1); const u32x2 w2p = pk4f(w2);
        const u32x2 u2 = pk4f(MFMA16(mk8h(v1), mk8h(u1), z4)), v2 = pk4f(MFMA16(mk8h(u1), mk8h(v1), z4));
        const f32x4 w3 = MFMA16(mk8h(u2), mk8h(w2p), w2); const u32x2 w3p = pk4f(w3);
        const u32x2 u3 = pk4f(MFMA16(mk8h(v2), mk8h(u2), z4));
        const f32x4 w4 = MFMA16(mk8h(u3), mk8h(w3p), w3);
        *(LAS u32x2*)(L + S1_TII + ((wave * 16 + fr) * 24 + 4 * fq) * 2) = pk4f(w4);
#pragma unroll
        for (int i = 0; i < 4; ++i) rhs[i] = up4(tr_read(tr_addr(L + S1_AT, 16 * i + 4 * fq, wave * 16, lane)));
    }
    s1_issue(F, l, gchunk, hn, nxt);
    LDS_BAR();
    {
        if (wave >= 4) {
            bf16x8 vfr2[2];
#pragma unroll
            for (int ks = 0; ks < 2; ++ks) vfr2[ks] = tr_frag(L + S1_VN, (wave - 4) * 16, ks, lane);
#pragma unroll
            for (int i = 0; i < 4; ++i) { f32x4 acc = (f32x4){0.f, 0.f, 0.f, 0.f};
#pragma unroll
                for (int ks = 0; ks < 2; ++ks) acc = MFMA16(LD_F8(L + S1_AAK + ((i * 16 + fr) * 72 + ks * 32 + fq * 8) * 2), vfr2[ks], acc);
                rhs[i] = acc; }
        }
        const f32x4 z4 = (f32x4){0.f, 0.f, 0.f, 0.f};
        u32x2 sp[4];
#define TII_FRAG(i) mk8h(*(const LAS u32x2*)(L + S1_TII + (((i) * 16 + fr) * 24 + 4 * fq) * 2))
#define AAB_P(i, j0) (*(const LAS u32x2*)(L + S1_AAB + (((i) * 16 + fr) * 72 + (j0) * 16 + 4 * fq) * 2))
        const u32x2 z2 = {0u, 0u};
        sp[0] = pk4f(MFMA16(TII_FRAG(0), mk8h(pk4f(rhs[0])), z4));
        { const u32x2 a = AAB_P(1, 0); const f32x4 a1 = MFMA16(mk8(a.x, a.y, 0u, 0u), mk8h(sp[0]), rhs[1]); sp[1] = pk4f(MFMA16(TII_FRAG(1), mk8h(pk4f(a1)), z4)); }
        { const u32x2 a = AAB_P(2, 0), b = AAB_P(2, 1); const f32x4 a2 = MFMA16(mk8(a.x, a.y, b.x, b.y), mk8(sp[0].x, sp[0].y, sp[1].x, sp[1].y), rhs[2]); sp[2] = pk4f(MFMA16(TII_FRAG(2), mk8h(pk4f(a2)), z4)); }
        { const u32x2 a = AAB_P(3, 0), b = AAB_P(3, 1), c = AAB_P(3, 2); f32x4 a3 = MFMA16(mk8(a.x, a.y, b.x, b.y), mk8(sp[0].x, sp[0].y, sp[1].x, sp[1].y), rhs[3]);
          a3 = MFMA16(mk8(c.x, c.y, 0u, 0u), mk8h(sp[2]), a3); sp[3] = pk4f(MFMA16(TII_FRAG(3), mk8h(pk4f(a3)), z4)); }
        (void)z2;
#undef TII_FRAG
#undef AAB_P
        const int dsto = (wave < 4) ? (S1_MT + ((wave * 16 + fr) * 72) * 2) : (S1_XT + (((wave - 4) * 16 + fr) * 72) * 2);
#pragma unroll
        for (int i = 0; i < 4; ++i) *(LAS u32x2*)(L + dsto + (16 * i + 4 * fq) * 2) = sp[i];
    }
    LDS_BAR();
    {
        bf16* ZB = (bf16*)(F.ws + WS_ZB) + (size_t)unit * 4096; bf16* Y0B = (bf16*)(F.ws + WS_Y0B) + (size_t)unit * 4096;
        bf16* PTB = (bf16*)(F.ws + WS_PTB) + (size_t)unit * 4096; bf16* QB = (bf16*)(F.ws + WS_QB) + (size_t)unit * 4096;
        const int ta = wave >> 1;
        const int ra = ((ta * 16 + fr) * 72 + fq * 8) * 2;
        bf16x8 fmt[2], fxt[2], fvn[2], fbt[2], fkt[2];
#pragma unroll
        for (int ks = 0; ks < 2; ++ks) { fmt[ks] = LD_F8(L + S1_MT + ra + ks * 64); fxt[ks] = LD_F8(L + S1_XT + ra + ks * 64); fvn[ks] = tr_frag(L + S1_VN, ta * 16, ks, lane); fbt[ks] = tr_frag(L + S1_BT, ta * 16, ks, lane); fkt[ks] = tr_frag(L + S1_KT, ta * 16, ks, lane); }
        const f32x4 lc = *(const LAS f32x4*)(L + S1_LC + (ta * 16 + 4 * fq) * 4);
#pragma unroll
        for (int ii = 0; ii < 2; ++ii) { const int tb = (wave & 1) * 2 + ii;
            const int rb = ((tb * 16 + fr) * 72 + fq * 8) * 2;
            const int so = (tb * 16 + fr) * 64 + 16 * fq + 4 * ta;
            bf16x8 frb[2], frk[2], fbc[2], fxc[2], fvc[2];
#pragma unroll
            for (int ks = 0; ks < 2; ++ks) { frb[ks] = LD_F8(L + S1_ARB + rb + ks * 64); frk[ks] = LD_F8(L + S1_ARK + rb + ks * 64); fbc[ks] = tr_frag(L + S1_BT, tb * 16, ks, lane); fxc[ks] = LD_F8(L + S1_XT + rb + ks * 64); fvc[ks] = tr_frag(L + S1_VN, tb * 16, ks, lane); }
            {
                f32x4 acc = (f32x4){0.f, 0.f, 0.f, 0.f};
#pragma unroll
                for (int ks = 0; ks < 2; ++ks) acc = MFMA16(fmt[ks], frb[ks], acc);
                acc = acc + up4(*(const LAS u32x2*)(L + S1_RT + ((tb * 16 + fr) * 72 + ta * 16 + 4 * fq) * 2));
                *(u32x2*)(ZB + so) = pk4f(acc); }
            {
                f32x4 acc = (f32x4){0.f, 0.f, 0.f, 0.f};
#pragma unroll
                for (int ks = 0; ks < 2; ++ks) { acc = MFMA16(fxt[ks], frb[ks], acc); acc = MFMA16(fvn[ks], frk[ks], acc); }
                *(u32x2*)(Y0B + so) = pk4f(acc); }
            {
                f32x4 acc = (f32x4){0.f, 0.f, 0.f, 0.f};
#pragma unroll
                for (int ks = 0; ks < 2; ++ks) acc = MFMA16(fmt[ks], fbc[ks], acc);
                const float dn = __expf(*(const LAS float*)(L + S1_LC + (tb * 16 + fr) * 4));
#pragma unroll
                for (int j = 0; j < 4; ++j) acc[j] = (acc[j] + ((ta == tb && 4 * fq + j == fr) ? 1.0f : 0.0f)) * dn;
                *(u32x2*)(PTB + (tb * 16 + fr) * 64 + 32 * (ta >> 1) + 8 * fq + 4 * (ta & 1)) = pk4f(acc); }
            {
                f32x4 acc = (f32x4){0.f, 0.f, 0.f, 0.f};
#pragma unroll
                for (int ks = 0; ks < 2; ++ks) { acc = MFMA16(fbt[ks], fxc[ks], acc); acc = MFMA16(fkt[ks], fvc[ks], acc); }
#pragma unroll
                for (int j = 0; j < 4; ++j) acc[j] *= __expf(lc[j]);
                *(u32x2*)(QB + so) = pk4f(acc); }
        }
    }
}
struct S2Buf { bf16x8 pa[4][2]; u32x4 q0, q1; };
DI void s2_load(S2Buf& B, const bf16* PT, const bf16* Q, const int fr, const int fq, const int vs) {
#pragma unroll
    for (int io = 0; io < 4; ++io)
#pragma unroll
        for (int kb = 0; kb < 2; ++kb) B.pa[io][kb] = *(const bf16x8*)(PT + (16 * io + fr) * 64 + 32 * kb + 8 * fq);
    B.q0 = *(const u32x4*)(Q + (16 * vs + fr) * 64 + 16 * fq); B.q1 = *(const u32x4*)(Q + (16 * vs + fr) * 64 + 16 * fq + 8);
    PIN_MEM();
}
DI void s2_step(const S2Buf& B, f32x4 (&acc)[4], bf16* SBu, const int fr, const int fq, const int vs) {
    u32x4 bw[2];
#pragma unroll
    for (int kb = 0; kb < 2; ++kb) { bw[kb].x = pk2(acc[2 * kb][0], acc[2 * kb][1]); bw[kb].y = pk2(acc[2 * kb][2], acc[2 * kb][3]); bw[kb].z = pk2(acc[2 * kb + 1][0], acc[2 * kb + 1][1]); bw[kb].w = pk2(acc[2 * kb + 1][2], acc[2 * kb + 1][3]);
        *(u32x4*)(SBu + (16 * vs + fr) * 64 + 16 * fq + 8 * kb) = bw[kb]; }
    const unsigned qw[8] = {B.q0.x, B.q0.y, B.q0.z, B.q0.w, B.q1.x, B.q1.y, B.q1.z, B.q1.w};
#pragma unroll
    for (int io = 0; io < 4; ++io) { f32x4 c = (f32x4){bflo(qw[2 * io]), bfhi(qw[2 * io]), bflo(qw[2 * io + 1]), bfhi(qw[2 * io + 1])};
#pragma unroll
        for (int kb = 0; kb < 2; ++kb) c = MFMA16(B.pa[io][kb], __builtin_bit_cast(bf16x8, bw[kb]), c);
        acc[io] = c; }
    PIN_MEM();
}
DI void s2_phase(Frame& F, const int l) {
    if (F.wg >= 128 || F.wave != 0) {
        const int widx = (F.wg < 128) ? F.wg * 7 + (F.wave - 1) : 896 + (F.wg - 128) * 8 + F.wave;
        LAS float* scr = (LAS float*)(F.lds + F.wave * 16384);
        if (l == 0) convert_main<1>(F, widx, 1920, scr); else moe_weight_convert<0>(F, widx, 1920, scr);
        return;
    }
    const int seq = F.wg >> 2, vs = F.wg & 3, b = seq >> 3, h = seq & 7, fr = ((int)threadIdx.x & 63) & 15, fq = ((int)threadIdx.x & 63) >> 4;
    const bf16* PTB = (const bf16*)(F.ws + WS_PTB); const bf16* QB = (const bf16*)(F.ws + WS_QB); bf16* SB = (bf16*)(F.ws + WS_SB);
    f32x4 acc[4];
#pragma unroll
    for (int i = 0; i < 4; ++i) acc[i] = (f32x4){0.f, 0.f, 0.f, 0.f};
    const size_t u0 = ((size_t)b * 128 * 8 + h) * 4096;
    S2Buf B0, B1, B2, B3;
    s2_load(B0, PTB + u0, QB + u0, fr, fq, vs); s2_load(B1, PTB + u0 + 32768, QB + u0 + 32768, fr, fq, vs); s2_load(B2, PTB + u0 + 2 * 32768, QB + u0 + 2 * 32768, fr, fq, vs);
#pragma unroll 1
    for (int c = 0; c < 128; c += 4) {
        const size_t uc = u0 + (size_t)c * 32768;
        const size_t un = (c + 4 < 128) ? uc + 4 * 32768 : uc;
        s2_load(B3, PTB + uc + 3 * 32768, QB + uc + 3 * 32768, fr, fq, vs);
        s2_step(B0, acc, SB + uc, fr, fq, vs);
        s2_load(B0, PTB + un, QB + un, fr, fq, vs);
        s2_step(B1, acc, SB + uc + 32768, fr, fq, vs);
        s2_load(B1, PTB + un + 32768, QB + un + 32768, fr, fq, vs);
        s2_step(B2, acc, SB + uc + 2 * 32768, fr, fq, vs);
        s2_load(B2, PTB + un + 2 * 32768, QB + un + 2 * 32768, fr, fq, vs);
        s2_step(B3, acc, SB + uc + 3 * 32768, fr, fq, vs);
    }
}
DI void s3_phase(Frame& F, const int l) {
    const int fr = ((int)threadIdx.x & 63) & 15, fq = ((int)threadIdx.x & 63) >> 4;
    const bf16* VM = (const bf16*)(F.ws + (l == 0 ? WS_VF : WS_VMB)); const bf16* GB = (const bf16*)(F.ws + WS_GB); const float* RKB = (const float*)(F.ws + WS_RKB);
    bf16* mix = (bf16*)(F.ws + WS_MIX);
    for (int u = F.wg * NWAVES + F.wave; u < (M / 64) * NH; u += F.G * NWAVES) {
        const int gchunk = u >> 3, h = u & 7, row0 = gchunk * 64;
        const bf16* SBu = (const bf16*)(F.ws + WS_SB) + (size_t)u * 4096; const bf16* ZBu = (const bf16*)(F.ws + WS_ZB) + (size_t)u * 4096; const bf16* Y0u = (const bf16*)(F.ws + WS_Y0B) + (size_t)u * 4096;
        bf16x8 sa[4][2], zf[4][2]; u32x4 y0a[4], y0b[4]; float rkv[4];
#pragma unroll
        for (int vt = 0; vt < 4; ++vt)
#pragma unroll
            for (int kb = 0; kb < 2; ++kb) sa[vt][kb] = *(const bf16x8*)(SBu + (16 * vt + fr) * 64 + 16 * fq + 8 * kb);
#pragma unroll
        for (int tt = 0; tt < 4; ++tt) { const int t = 16 * tt + fr; zf[tt][0] = *(const bf16x8*)(ZBu + t * 64 + 16 * fq); zf[tt][1] = *(const bf16x8*)(ZBu + t * 64 + 16 * fq + 8);
            y0a[tt] = *(const u32x4*)(Y0u + t * 64 + 16 * fq); y0b[tt] = *(const u32x4*)(Y0u + t * 64 + 16 * fq + 8); rkv[tt] = RKB[(size_t)(row0 + t) * 8 + h]; }
        f32x4 gg[4], gb[4];
#pragma unroll
        for (int vt = 0; vt < 4; ++vt) { gg[vt] = *(const f32x4*)(F.A->in[I_GNG] + l * RW + h * 64 + 16 * vt + 4 * fq); gb[vt] = *(const f32x4*)(F.A->in[I_GNB] + l * RW + h * 64 + 16 * vt + 4 * fq); }
        PIN_MEM();
#pragma unroll
        for (int tt = 0; tt < 4; ++tt) {
            const int t = 16 * tt + fr;
            u32x2 vmr[4], ggr[4];
#pragma unroll
            for (int vt = 0; vt < 4; ++vt) { const size_t o = (size_t)(row0 + t) * RW + h * 64 + 16 * vt + 4 * fq; vmr[vt] = *(const u32x2*)(VM + o); ggr[vt] = *(const u32x2*)(GB + o); }
            const unsigned yw[8] = {y0a[tt].x, y0a[tt].y, y0a[tt].z, y0a[tt].w, y0b[tt].x, y0b[tt].y, y0b[tt].z, y0b[tt].w};
            f32x4 y[4]; float s = 0.f;
#pragma unroll
            for (int vt = 0; vt < 4; ++vt) { f32x4 c = (f32x4){bflo(yw[2 * vt]), bfhi(yw[2 * vt]), bflo(yw[2 * vt + 1]), bfhi(yw[2 * vt + 1])};
                c = MFMA16(sa[vt][0], zf[tt][0], c); c = MFMA16(sa[vt][1], zf[tt][1], c); y[vt] = c; s += (c[0] + c[1]) + (c[2] + c[3]); }
            s += __shfl_xor(s, 16); s += __shfl_xor(s, 32);
            const float mean = s * (1.f / 64.f); float q = 0.f;
#pragma unroll
            for (int vt = 0; vt < 4; ++vt) { y[vt] = y[vt] - mean; q += (y[vt][0] * y[vt][0] + y[vt][1] * y[vt][1]) + (y[vt][2] * y[vt][2] + y[vt][3] * y[vt][3]); }
            q += __shfl_xor(q, 16); q += __shfl_xor(q, 32);
            const float rstd = 1.0f / sqrtf(q * (1.f / 64.f) + GN_EPS);
            const float rk = rkv[tt];
#pragma unroll
            for (int vt = 0; vt < 4; ++vt) {
                const f32x4 vv = (f32x4){bflo(vmr[vt].x), bfhi(vmr[vt].x), bflo(vmr[vt].y), bfhi(vmr[vt].y)}, gv = (f32x4){bflo(ggr[vt].x), bfhi(ggr[vt].x), bflo(ggr[vt].y), bfhi(ggr[vt].y)};
                const f32x4 ov = (y[vt] * rstd * gg[vt] + gb[vt] + vv * rk) * gv;
                u32x2 w; w.x = pk2(ov[0], ov[1]); w.y = pk2(ov[2], ov[3]);
                *(u32x2*)(mix + (size_t)(row0 + t) * D + 512 + h * 64 + 16 * vt + 4 * fq) = w; }
        }
    }
}

DI void norm2_router_phase(Frame& F, const bf16* hsrc, const float* g, const float* router) {
    LAS float* RT = (LAS float*)F.lds;
    LAS int* E01 = (LAS int*)(F.lds + 131072);
    for (int i = ((int)threadIdx.x); i < 2048; i += NTHR) { const int col = i >> 1, half = i & 1; *(LAS f32x4*)(RT + ((((col >> 8) * 4 + (col & 3)) * 2 + half) * 64 + ((col & 255) >> 2)) * 4) = *(const f32x4*)(router + i * 4); }
    __syncthreads();
    unsigned char* hn = F.ws + WS_HN;
    int* tke = (int*)(F.ws + TB_TKE); float* tkg = (float*)(F.ws + TB_TKG);
    const int lane = (int)threadIdx.x & 63, mb = F.wg * 128 + F.wave * 16;
    f32x4 gg[4];
#pragma unroll
    for (int j = 0; j < 4; ++j) gg[j] = ((const f32x4*)g + lane)[64 * j];
    u32x2 cr[2][4], nr[2][4];
#pragma unroll
    for (int q = 0; q < 2; ++q)
#pragma unroll
        for (int j = 0; j < 4; ++j) cr[q][j] = ((const u32x2*)(hsrc + (size_t)(mb + q) * D) + lane)[64 * j];
#pragma unroll 1
    for (int i = 0; i < 16; i += 2) {
        const int in = (i + 2 < 16) ? i + 2 : i;
#pragma unroll
        for (int q = 0; q < 2; ++q)
#pragma unroll
            for (int j = 0; j < 4; ++j) nr[q][j] = ((const u32x2*)(hsrc + (size_t)(mb + in + q) * D) + lane)[64 * j];
        f32x4 y[2][4]; float ss[2] = {0.f, 0.f};
#pragma unroll
        for (int q = 0; q < 2; ++q)
#pragma unroll
            for (int j = 0; j < 4; ++j) { const u32x2 v = cr[q][j]; y[q][j] = (f32x4){bflo(v.x), bfhi(v.x), bflo(v.y), bfhi(v.y)}; ss[q] += (y[q][j].x * y[q][j].x + y[q][j].y * y[q][j].y) + (y[q][j].z * y[q][j].z + y[q][j].w * y[q][j].w); }
#pragma unroll
        for (int q = 0; q < 2; ++q) { const float rstd = 1.0f / sqrtf(wave_sum(ss[q]) * (1.f / D) + RMS_EPS);
#pragma unroll
            for (int j = 0; j < 4; ++j) y[q][j] = y[q][j] * rstd * gg[j];
            store_row_f8(hn + (size_t)(mb + i + q) * D, lane, y[q]); }
        float lg[2][8];
#pragma unroll
        for (int q = 0; q < 2; ++q)
#pragma unroll
            for (int e = 0; e < 8; ++e) lg[q][e] = 0.f;
#pragma unroll
        for (int j = 0; j < 4; ++j)
#pragma unroll
            for (int k = 0; k < 4; ++k) { const LAS f32x4* rp = (const LAS f32x4*)RT + (j * 4 + k) * 128 + lane; const f32x4 r0 = rp[0], r1 = rp[64];
#pragma unroll
                for (int q = 0; q < 2; ++q) { const float x = y[q][j][k];
                    lg[q][0] += x * r0[0]; lg[q][1] += x * r0[1]; lg[q][2] += x * r0[2]; lg[q][3] += x * r0[3]; lg[q][4] += x * r1[0]; lg[q][5] += x * r1[1]; lg[q][6] += x * r1[2]; lg[q][7] += x * r1[3]; } }
#pragma unroll
        for (int q = 0; q < 2; ++q)
#pragma unroll
            for (int e = 0; e < 8; ++e) lg[q][e] = wave_sum(lg[q][e]);
        if (lane == 0) {
#pragma unroll
            for (int q = 0; q < 2; ++q) { const int lt = F.wave * 16 + i + q, m = mb + i + q;
                int e0 = 0; float v0 = lg[q][0];
#pragma unroll
                for (int e = 1; e < 8; ++e) if (lg[q][e] > v0) { v0 = lg[q][e]; e0 = e; }
                int e1 = -1; float v1 = -3.0e38f;
#pragma unroll
                for (int e = 0; e < 8; ++e) if (e != e0 && lg[q][e] > v1) { v1 = lg[q][e]; e1 = e; }
                const float g0 = 1.0f / (1.0f + __expf(v1 - v0));
                tke[m] = e0; tke[M + m] = e1; tkg[m] = g0; tkg[M + m] = 1.0f - g0;
                E01[lt] = e0; E01[128 + lt] = e1; }
        }
#pragma unroll
        for (int q = 0; q < 2; ++q)
#pragma unroll
            for (int j = 0; j < 4; ++j) cr[q][j] = nr[q][j];
    }
    if (F.wg == 0) for (int i = ((int)threadIdx.x); i < D / 4; i += NTHR) ((unsigned*)(hn + (size_t)M * D))[i] = 0u;
    __syncthreads();
    if (((int)threadIdx.x) < 16) { const int s = ((int)threadIdx.x) >> 3, e = ((int)threadIdx.x) & 7; int c = 0; for (int i = 0; i < 128; ++i) c += (E01[s * 128 + i] == e) ? 1 : 0; ((int*)(F.ws + TB_CNT))[F.wg * 16 + ((int)threadIdx.x)] = c; }
}
DI void moe_dispatch_phase(Frame& F) {
    LAS int* C = (LAS int*)F.lds;
    LAS int* TOT = C + 4096; LAS int* MINE = TOT + 16; LAS int* START = MINE + 16; LAS int* PAD = START + 16; LAS int* EL = PAD + 16;
    const int* cnt = (const int*)(F.ws + TB_CNT);
    { const int k = ((int)threadIdx.x) & 15, part = ((int)threadIdx.x) >> 4; int tot = 0, mine = 0;
#pragma unroll
      for (int j = 0; j < 8; ++j) { const int w = part * 8 + j, c = cnt[w * 16 + k]; tot += c; mine += (w < F.wg) ? c : 0; }
      C[part * 16 + k] = tot; C[512 + part * 16 + k] = mine; }
    __syncthreads();
    if (((int)threadIdx.x) < 16) { int tot = 0, mine = 0; for (int p = 0; p < 32; ++p) { tot += C[p * 16 + ((int)threadIdx.x)]; mine += C[512 + p * 16 + ((int)threadIdx.x)]; } TOT[((int)threadIdx.x)] = tot; MINE[((int)threadIdx.x)] = mine; }
    __syncthreads();
    if (((int)threadIdx.x) == 0) { int acc = 0; for (int k = 0; k < 16; ++k) { START[k] = acc; const int p = (TOT[k] + 255) & ~255; PAD[k] = p; acc += p; } }
    const int* tke = (const int*)(F.ws + TB_TKE); const float* tkg = (const float*)(F.ws + TB_TKG);
    int* rowtok = (int*)(F.ws + TB_ROWTOK); float* rowgate = (float*)(F.ws + TB_ROWGATE);
    if (((int)threadIdx.x) < 256) EL[((int)threadIdx.x)] = tke[(((int)threadIdx.x) >> 7) * M + F.wg * 128 + (((int)threadIdx.x) & 127)];
    __syncthreads();
    if (((int)threadIdx.x) < 256) { const int s = ((int)threadIdx.x) >> 7, i = ((int)threadIdx.x) & 127, e = EL[((int)threadIdx.x)]; int rank = 0; for (int j = 0; j < i; ++j) rank += (EL[s * 128 + j] == e) ? 1 : 0;
        const int dest = START[s * 8 + e] + MINE[s * 8 + e] + rank, tok = F.wg * 128 + i;
        rowtok[dest] = tok; rowgate[dest] = tkg[s * M + tok]; }
    if (F.wg < 16) { const int k = F.wg; for (int r = START[k] + TOT[k] + ((int)threadIdx.x); r < START[k] + PAD[k]; r += NTHR) { rowtok[r] = -1; rowgate[r] = 0.f; } }
    if (F.wg == 0) {
        int* tile_e = (int*)(F.ws + TB_TILEE); int* ntiles = (int*)(F.ws + TB_NTILES);
        if (((int)threadIdx.x) < 2 * MOE_TILES) { const int r = ((int)threadIdx.x) * 256; int e = 0; for (int k = 0; k < 16; ++k) if (r >= START[k]) e = k & 7; tile_e[((int)threadIdx.x)] = e; }
        if (((int)threadIdx.x) == 0) { const int n0 = START[8] >> 8; ntiles[0] = n0; ntiles[1] = ((START[15] + PAD[15]) >> 8) - n0; }
    }
}

__device__ __attribute__((noinline)) void moe_dn_combine(const int wg, const int nM, const int G, float* part, unsigned* cnt, const bf16* hin, bf16* hout, const int* row_tok, const float* row_gate, const float sc) {
    pg8::OrderBase S; S.init(nM, D / 256, G, wg);
    const int main = (S.nwg / S.G) * S.G, left = S.nwg - main;
    if (wg >= pg8::DN_KSPLIT * left) return;
    const int j = wg / pg8::DN_KSPLIT, q = wg % pg8::DN_KSPLIT, tid = (int)threadIdx.x;
    pg8::Unit u; S.map((long)main + j, u);
    asm volatile("s_waitcnt vmcnt(0)" ::: "memory");
    __syncthreads();
    if (tid == 0) { __builtin_amdgcn_fence(__ATOMIC_RELEASE, "agent"); asm volatile("s_waitcnt vmcnt(0)" ::: "memory"); __hip_atomic_fetch_add(cnt + 64 * j, 1u, __ATOMIC_RELAXED, __HIP_MEMORY_SCOPE_AGENT);
        unsigned sp = 0; while (__hip_atomic_load(cnt + 64 * j, __ATOMIC_RELAXED, __HIP_MEMORY_SCOPE_AGENT) < (unsigned)pg8::DN_KSPLIT) { __builtin_amdgcn_s_sleep(2); if (++sp > (1u << 22)) break; }
        __builtin_amdgcn_fence(__ATOMIC_ACQUIRE, "agent"); asm volatile("s_waitcnt vmcnt(0)" ::: "memory"); }
    __syncthreads();
    constexpr int KS = pg8::DN_KSPLIT, RPW = (256 + KS - 1) / KS;
    const float* slab = part + (size_t)j * KS * 65536;
    const int cg = (tid & 31) * 8, r1 = (q * RPW + RPW < 256) ? q * RPW + RPW : 256;
    for (int r = q * RPW + (tid >> 5); r < r1; r += 16) {
        const int row = u.pm * 256 + r; const int tok = row_tok[row]; const float g = row_gate[row] * sc;
        if (tok >= 0) {
            f32x4 a[KS][2];
#pragma unroll
            for (int k = 0; k < KS; ++k) { a[k][0] = *(const f32x4*)(slab + (size_t)k * 65536 + r * 256 + cg); a[k][1] = *(const f32x4*)(slab + (size_t)k * 65536 + r * 256 + cg + 4); }
            float h[8]; unpack8(*(const u32x4*)(hin + (size_t)tok * D + u.pn * 256 + cg), h);
            f32x4 s0 = a[0][0], s1 = a[0][1];
#pragma unroll
            for (int k = 1; k < KS; ++k) { s0 += a[k][0]; s1 += a[k][1]; }
#pragma unroll
            for (int e = 0; e < 4; ++e) { h[e] += g * s0[e]; h[4 + e] += g * s1[e]; }
            *(u32x4*)(hout + (size_t)tok * D + u.pn * 256 + cg) = pack8(h);
        }
    }
}

constexpr int NPHASES = 21;
__global__ void __launch_bounds__(NTHR, 2) fwd(Args args) {
    extern __shared__ __attribute__((aligned(16))) unsigned char lds[];
    Frame F;
    F.lds = (LAS unsigned char*)lds;
    F.wave = __builtin_amdgcn_readfirstlane((int)threadIdx.x >> 6);
    F.G = gridDim.x; F.wg = blockIdx.x;
    F.A = &args; F.out = args.out; F.ws = args.ws;
    volatile LAS unsigned* MISC = (volatile LAS unsigned*)(F.lds + MISC_OFF);
    if (((int)threadIdx.x) < 64) MISC[((int)threadIdx.x)] = 0u;
    __syncthreads();
    const int lo = args.ph_lo, hi = args.ph_hi;
    XcdBarrier bar; bar.bar = (unsigned*)(F.ws + WS_CTL) + CW_BAR; bar.x = 0; bar.st = nullptr;
    if (hi - lo > 1) bar = xcd_barrier_post((unsigned*)(F.ws + WS_CTL) + CW_BAR, MISC + 8);
#ifndef ONLY_PHASE
#define ONLY_PHASE -1
#endif
#define IN(k) ((ONLY_PHASE < 0 || (k) == ONLY_PHASE) && lo <= (k) && (k) < hi)
#define SEAM(k) do { if (IN(k) && IN((k) + 1)) xcd_barrier(bar); } while (0)
    unsigned char* ws = F.ws;
    bf16* HN = (bf16*)(ws + WS_HN); bf16* MIX = (bf16*)(ws + WS_MIX); bf16* PROJ = (bf16*)(ws + WS_PROJ);
    bf16* HB = (bf16*)F.out;

    if (IN(0)) { p0_prologue(F); norm_rows_phase(F, F.A->in[I_X], F.A->in[I_N1G], HN); }
    SEAM(0);
#define LAYER_MIXER(l) do { \
        constexpr int pb = 1 + (l) * 9; \
        if (IN(pb + 0)) { pg8::DenseSched S; S.init(M / 256, NIN / 256, F.G, F.wg); S.A = (const char*)HN; S.Bt = (const char*)(ws + WS_WIN) + (size_t)(l) * NIN * D * 2; S.tstep = (size_t)256 * D * 2; \
            pg8::EpiBf16 E{PROJ, NIN}; pg8::gemm_phase<pg8::EpiBf16, pg8::DenseSched, true, true>(F.lds, D, S, E); } \
        SEAM(pb + 0); \
        if (IN(pb + 1)) { s1_stage_mu(F, (l)); for (int gc = F.wg; gc < M / 64; gc += F.G) { mixc_unit(F, (l), gc); s1_chunk_prep(F, (l), gc); S1Pre pa, pb2; s1_issue(F, (l), gc, 0, pa); for (int h = 0; h < NH; h += 2) { s1_unit(F, (l), gc, h, pa, h + 1, pb2); s1_unit(F, (l), gc, h + 1, pb2, (h + 2 < NH) ? h + 2 : h + 1, pa); } LDS_BAR(); } } \
        SEAM(pb + 1); \
        if (IN(pb + 2)) { s2_phase(F, (l)); } \
        SEAM(pb + 2); \
        if (IN(pb + 3)) { s3_phase(F, (l)); } \
        SEAM(pb + 3); \
        if (IN(pb + 4)) { pg8::DenseSched S; S.init(M / 256, D / 256, F.G, F.wg); S.A = (const char*)MIX; S.Bt = (const char*)(ws + WS_WOUT) + (size_t)(l) * D * D * 2; S.tstep = (size_t)256 * D * 2; \
            if ((l) == 0) { pg8::EpiResid<true> E{(const void*)F.A->in[I_X], HB, D}; pg8::gemm_phase<pg8::EpiResid<true>, pg8::DenseSched, true, true>(F.lds, D, S, E); } \
            else { pg8::EpiResid<false> E{(const void*)HB, HB, D}; pg8::gemm_phase<pg8::EpiResid<false>, pg8::DenseSched, true, true>(F.lds, D, S, E); } } \
        SEAM(pb + 4); } while (0)
    LAYER_MIXER(0);
    {
        if (IN(6)) norm_rows_phase_b<false>(F, HB, F.A->in[I_N2G], HN);
        SEAM(6);
        if (IN(7)) { pg8::DenseSched S; S.init(M / 256, 2 * FF / 256, F.G, F.wg); S.A = (const char*)HN; S.Bt = (const char*)(ws + WS_WGU); S.tstep = (size_t)256 * D * 2;
            pg8::EpiSwiglu E{(bf16*)(ws + WS_HID), FF}; pg8::gemm_phase<pg8::EpiSwiglu, pg8::DenseSched, true, true>(F.lds, D, S, E); }
        SEAM(7);
        if (IN(8)) { pg8::DenseSched S; S.init(M / 256, D / 256, F.G, F.wg); S.A = (const char*)(ws + WS_HID); S.Bt = (const char*)(ws + WS_WDN); S.tstep = (size_t)256 * FF * 2;
            pg8::EpiResid<false> E{(const void*)HB, HB, D}; pg8::gemm_phase<pg8::EpiResid<false>, pg8::DenseSched, true, true>(F.lds, FF, S, E); }
        SEAM(8);
        if (IN(9)) norm_rows_phase_b<false>(F, HB, F.A->in[I_N1G] + D, HN);
        SEAM(9);
    }
    LAYER_MIXER(1);
    if (IN(15)) { norm2_router_phase(F, HB, F.A->in[I_N2G] + D, F.A->in[I_ROUTER]); moe_weight_convert<1>(F, F.wg * NWAVES + F.wave, F.G * NWAVES, (LAS float*)(F.lds + 32768 + F.wave * 9216)); }
    SEAM(15);
    if (IN(16)) moe_dispatch_phase(F);
    SEAM(16);
    {
        const int* rowtok = (const int*)(ws + TB_ROWTOK); const float* rowgate = (const float*)(ws + TB_ROWGATE); const int* tile_e = (const int*)(ws + TB_TILEE);
        if (IN(17)) { const int nt = __builtin_amdgcn_readfirstlane(((const int*)(ws + TB_NTILES))[0] + ((const int*)(ws + TB_NTILES))[1]);
            pg8::MoeGuSched S; S.init(nt, 2 * FE / 256, F.G, F.wg); S.A = (const char*)HN; S.Bt = (const char*)(ws + WS_WMGU); S.row_tok = rowtok; S.tile_e = tile_e;
            pg8::EpiSwigluF8 E{ws + WS_MHID, FE}; pg8::gemm_phase<pg8::EpiSwigluF8, pg8::MoeGuSched, true, true, true>(F.lds, D / 2, S, E); }
        SEAM(17);
#pragma unroll
        for (int s = 0; s < 2; ++s) {
            if (IN(18 + s)) { const int nt0 = __builtin_amdgcn_readfirstlane(((const int*)(ws + TB_NTILES))[0]), nt = s ? __builtin_amdgcn_readfirstlane(((const int*)(ws + TB_NTILES))[1]) : nt0, t0 = s ? nt0 : 0;
                const int* rt = rowtok + t0 * 256; const float* rg = rowgate + t0 * 256; const int* te = tile_e + t0; const char* hid = (const char*)(ws + WS_MHID) + (size_t)t0 * 256 * FE;
                { pg8::MoeDnSched S; S.init(nt, D / 256, F.G, F.wg); S.A = hid; S.Bt = (const char*)(ws + WS_WMDN); S.tile_e = te; S.tstep = (size_t)256 * FE;
                  pg8::EpiMoeDown E{HB, (s == 0) ? HB : HN, rt, rg, F8_DN_INV}; pg8::gemm_phase<pg8::EpiMoeDown, pg8::MoeDnSched, true, true, true>(F.lds, FE / 2, S, E); }
                { pg8::MoeDnLeftSched S; S.init(nt, D / 256, F.G, F.wg); S.A = hid; S.Bt = (const char*)(ws + WS_WMDN); S.tile_e = te; S.tstep = (size_t)256 * FE;
                  float* part = (float*)(ws + WS_PART); unsigned* cnt = (unsigned*)(ws + WS_CTL) + CW_LEFT + s * 32 * 64;
                  pg8::EpiPartTile E{part + (size_t)F.wg * 65536};
                  pg8::gemm_phase<pg8::EpiPartTile, pg8::MoeDnLeftSched, true, true, true>(F.lds, FE / 2, S, E, pg8::DN_KT);
                  moe_dn_combine(F.wg, nt, F.G, part, cnt, HB, (s == 0) ? HB : HN, rt, rg, F8_DN_INV); } }
            SEAM(18 + s);
        }
    }
    if (IN(20)) norm_rows_phase_b<true>(F, HN, F.A->in[I_FINALG], F.out);
#undef IN
#undef SEAM
}

extern "C" void kernel_launch(void* const* d_in, const int* in_sizes, int n_in, void* d_out, int out_size, void* d_ws, size_t ws_size, hipStream_t stream) {
    static int ready = 0;
    if (ready == 0) {
        if (n_in != 33 || out_size != M * D || ws_size < WS_NEED) { fprintf(stderr, "kernel_launch: unexpected shapes (n_in %d, out %d, ws %zu, need %zu)\n", n_in, out_size, ws_size, (size_t)WS_NEED); ready = -1; return; }
        if (hipFuncSetAttribute((const void*)fwd, hipFuncAttributeMaxDynamicSharedMemorySize, LDS_BYTES) != hipSuccess) { fprintf(stderr, "kernel_launch: hipFuncSetAttribute failed\n"); ready = -1; return; }
        int per_cu = 0; (void)hipOccupancyMaxActiveBlocksPerMultiprocessor(&per_cu, (const void*)fwd, NTHR, LDS_BYTES); (void)hipGetLastError();
        if (per_cu < 1) fprintf(stderr, "kernel_launch: occupancy query reports %d\n", per_cu);
        ready = 1;
    }
    if (ready < 0) return;
    (void)hipMemsetAsync((char*)d_ws + WS_CTL, 0, CTL_ZERO_BYTES, stream);
    Args a{};
    for (int i = 0; i < 33; ++i) a.in[i] = (const float*)d_in[i];
    a.out = (float*)d_out; a.ws = (unsigned char*)d_ws;
#if N_LAUNCH_MODE == 1
    a.ph_lo = 0; a.ph_hi = NPHASES;
    hipLaunchKernelGGL(fwd, dim3(GRID), dim3(NTHR), LDS_BYTES, stream, a);
#else
    for (int p = 0; p < NPHASES; ++p) { a.ph_lo = p; a.ph_hi = p + 1; const int reps = ((PROBE_PHASES >> p) & 1u) ? 2 : 1;
        for (int r = 0; r < reps; ++r) hipLaunchKernelGGL(fwd, dim3(GRID), dim3(NTHR), LDS_BYTES, stream, a); }
#endif
    (void)in_sizes;
}
```

```cpp
#include <hip/hip_runtime.h>
#include <cstdio>
#include <cstdint>

#define DI __device__ __forceinline__
#define LAS __attribute__((address_space(3)))
typedef unsigned short bf16;
typedef short bf16x8 __attribute__((ext_vector_type(8)));
typedef float f32x4 __attribute__((ext_vector_type(4)));
typedef float f32x2 __attribute__((ext_vector_type(2)));
typedef unsigned u32x4 __attribute__((ext_vector_type(4)));
typedef unsigned u32x2 __attribute__((ext_vector_type(2)));
typedef __bf16 bf2_t __attribute__((ext_vector_type(2)));

#ifndef PROBE_PHASES
#define PROBE_PHASES 0x0u
#endif
#ifndef N_LAUNCH_MODE
#define N_LAUNCH_MODE 1
#endif

constexpr int BATCH = 4, T = 8192, D = 1024, M = BATCH * T;
constexpr int NIN = 2560, RW = 512, NH = 8;
constexpr int C_CONVA = 256, C_CONVB = 512, C_R = 768, C_K = 1280, C_V = 1792, C_XW = 2304, C_XA = 2368, C_XG = 2432;
constexpr int NRC = 1792;
constexpr int FF = 2816, FE = 3584, NE = 8;
constexpr int MOE_ROWS = M + NE * 256;
constexpr int MOE_TILES = MOE_ROWS / 256;
constexpr float RMS_EPS = 1e-6f, LN_EPS = 1e-5f, GN_EPS = 64e-5f;
constexpr int NWAVES = 8, NTHR = 512, GRID = 256;

DI unsigned pk2(float lo, float hi) { f32x2 v = {lo, hi}; return __builtin_bit_cast(unsigned, __builtin_convertvector(v, bf2_t)); }
DI float bflo(unsigned u) { return __uint_as_float(u << 16); }
DI float bfhi(unsigned u) { return __uint_as_float(u & 0xffff0000u); }
DI float fast_exp(float x) { return __builtin_amdgcn_exp2f(x * 1.44269504088896f); }
DI float sigmoidf_(float x) { return __builtin_amdgcn_rcpf(1.0f + fast_exp(-x)); }
DI float siluf_(float x) { return x * sigmoidf_(x); }
template <int D> DI float row_shr(float x) { return __builtin_bit_cast(float, __builtin_amdgcn_update_dpp(0, __builtin_bit_cast(int, x), 0x110 + D, 0xf, 0xf, false)); }
DI float row_scan16(float x) { x += row_shr<1>(x); x += row_shr<2>(x); x += row_shr<4>(x); x += row_shr<8>(x); return x; }
DI float wave_sum(float v) {
    v = row_scan16(v);
    const int iv = __builtin_bit_cast(int, v);
    const float a = __builtin_bit_cast(float, __builtin_amdgcn_readlane(iv, 15)), b = __builtin_bit_cast(float, __builtin_amdgcn_readlane(iv, 31));
    const float c = __builtin_bit_cast(float, __builtin_amdgcn_readlane(iv, 47)), d = __builtin_bit_cast(float, __builtin_amdgcn_readlane(iv, 63));
    return (a + b) + (c + d);
}
DI void unpack8(const u32x4 w, float (&f)[8]) { f[0] = bflo(w.x); f[1] = bfhi(w.x); f[2] = bflo(w.y); f[3] = bfhi(w.y); f[4] = bflo(w.z); f[5] = bfhi(w.z); f[6] = bflo(w.w); f[7] = bfhi(w.w); }
DI u32x4 pack8(const float (&f)[8]) { u32x4 w; w.x = pk2(f[0], f[1]); w.y = pk2(f[2], f[3]); w.z = pk2(f[4], f[5]); w.w = pk2(f[6], f[7]); return w; }
#define MFMA16(a, b, c) __builtin_amdgcn_mfma_f32_16x16x32_bf16((a), (b), (c), 0, 0, 0)
typedef int i32x8 __attribute__((ext_vector_type(8)));
typedef int i32x4 __attribute__((ext_vector_type(4)));
constexpr float F8S_X = 4.f, F8S_WGU = 64.f, F8S_H = 8.f, F8S_WDN = 128.f;
constexpr float F8_GU_INV = 1.f / (F8S_X * F8S_WGU), F8_DN_INV = 1.f / (F8S_H * F8S_WDN);
DI float f8clamp(float x) { return __builtin_amdgcn_fmed3f(x, -448.f, 448.f); }
DI unsigned pk4_f8(float a, float b, float c, float d) { int p = __builtin_amdgcn_cvt_pk_fp8_f32(f8clamp(a), f8clamp(b), 0, false); p = __builtin_amdgcn_cvt_pk_fp8_f32(f8clamp(c), f8clamp(d), p, true); return (unsigned)p; }
DI i32x8 cat8(const bf16x8 a, const bf16x8 b) { return __builtin_shufflevector(__builtin_bit_cast(i32x4, a), __builtin_bit_cast(i32x4, b), 0, 1, 2, 3, 4, 5, 6, 7); }

namespace pg8 {
constexpr int BM = 256, BK = 64, HALF = 128, HTB = HALF * BK * 2, STAGE_BYTES = 8 * HTB, NXCD = 8, WGM = 8;
DI int lds_byte(int r, int c) { const int st = (r >> 4) * 2 + (c >> 5), rr = r & 15, cc = c & 31, ob = rr * 64 + cc * 2; return st * 1024 + (ob ^ (((ob >> 9) & 1) << 5)); }
DI void stage_rc(int b, int& R, int& C) { const int st = b / 1024, sb = b % 1024, swz = sb ^ (((sb >> 9) & 1) << 5); R = (st >> 1) * 16 + swz / 64; C = (st & 1) * 32 + (swz % 64) / 2; }
DI int perm32(int rho) { const int n = rho >> 4, i = rho & 15; return 8 * (i >> 2) + 4 * n + (i & 3); }
struct Unit { int pm, pn; };
struct OrderBase {
    int nM, nN, nwg, G, c;
    DI void init(int nM_, int nN_, int G_, int c_) { nM = nM_; nN = nN_; nwg = nM * nN; G = G_; c = c_; }
    DI void map(const long L, Unit& u) const {
        int wgid = (int)L; { const int q = nwg / NXCD, r = nwg % NXCD, xcd = wgid % NXCD, off = wgid / NXCD; wgid = (xcd < r ? xcd * (q + 1) : r * (q + 1) + (xcd - r) * q) + off; }
        const int nig = WGM * nN, gid = wgid / nig, fm = gid * WGM, gsz = (nM - fm) < WGM ? (nM - fm) : WGM;
        u.pm = fm + ((wgid % nig) % gsz); u.pn = (wgid % nig) / gsz;
    }
    DI bool next(int i, Unit& u) const { const long L = (long)i * G + c; if (L >= nwg) return false; map(L, u); return true; }
};
struct DenseSched : OrderBase {
    static constexpr bool GATHER = false;
    const char* A; const char* Bt; size_t tstep;
    DI const char* a_base(const Unit& u) const { return A + (size_t)u.pm * tstep; }
    DI const char* b_base(const Unit& u) const { return Bt + (size_t)u.pn * tstep; }
    DI void a_offs(const Unit&, const int (&)[2], const int (&)[2], unsigned (&)[2][2]) const {}
};
struct MoeGuSched : OrderBase {
    static constexpr bool GATHER = true;
    const char* A; const char* Bt; const int* row_tok; const int* tile_e;
    DI const char* a_base(const Unit&) const { return A; }
    DI const char* b_base(const Unit& u) const { const int e = __builtin_amdgcn_readfirstlane(tile_e[u.pm]); return Bt + ((size_t)e * (2 * FE) + (size_t)u.pn * 256) * (size_t)D; }
    DI void a_offs(const Unit& u, const int (&R)[2], const int (&C)[2], unsigned (&o)[2][2]) const {
#pragma unroll
        for (int h = 0; h < 2; ++h)
#pragma unroll
            for (int i = 0; i < 2; ++i) { int tok = row_tok[u.pm * 256 + h * 128 + R[i]]; tok = tok < 0 ? M : tok; o[h][i] = (unsigned)tok * (unsigned)D + (unsigned)(C[i] * 2); }
    }
};
struct MoeDnSched : OrderBase {
    static constexpr bool GATHER = false;
    const char* A; const char* Bt; const int* tile_e; size_t tstep;
    DI bool next(int i, Unit& u) const { if (i >= nwg / G) return false; map((long)i * G + c, u); return true; }
    DI const char* a_base(const Unit& u) const { return A + (size_t)u.pm * tstep; }
    DI const char* b_base(const Unit& u) const { const int e = __builtin_amdgcn_readfirstlane(tile_e[u.pm]); return Bt + ((size_t)e * D + (size_t)u.pn * 256) * (size_t)FE; }
    DI void a_offs(const Unit&, const int (&)[2], const int (&)[2], unsigned (&)[2][2]) const {}
};
constexpr int DN_KSPLIT = 7, DN_KT = FE / 128 / DN_KSPLIT;
struct MoeDnLeftSched : OrderBase {
    static constexpr bool GATHER = false;
    const char* A; const char* Bt; const int* tile_e; size_t tstep;
    DI bool next(int i, Unit& u) const { const int main = (nwg / G) * G, left = nwg - main; if (i > 0 || c >= DN_KSPLIT * left) return false; map((long)main + (c / DN_KSPLIT), u); return true; }
    DI const char* a_base(const Unit& u) const { return A + (size_t)u.pm * tstep + (size_t)(c % DN_KSPLIT) * (DN_KT * 128); }
    DI const char* b_base(const Unit& u) const { const int e = __builtin_amdgcn_readfirstlane(tile_e[u.pm]); return Bt + ((size_t)e * D + (size_t)u.pn * 256) * (size_t)FE + (size_t)(c % DN_KSPLIT) * (DN_KT * 128); }
    DI void a_offs(const Unit&, const int (&)[2], const int (&)[2], unsigned (&)[2][2]) const {}
};

struct EpiBf16 {
    static constexpr bool PERM = true;
    bf16* O; int ldc;
    DI void operator()(const f32x4 (&acc)[2][2][4][2], const Unit& u, int wr, int wc, int fr, int fq) const {
        const int row0 = u.pm * BM + wr * 64 + fr, col0 = u.pn * BM + wc * 32 + 8 * fq;
#pragma unroll
        for (int ai = 0; ai < 2; ++ai)
#pragma unroll
            for (int m = 0; m < 4; ++m) { bf16* rowp = O + (size_t)(row0 + ai * HALF + m * 16) * ldc + col0;
#pragma unroll
                for (int bj = 0; bj < 2; ++bj) { const f32x4 v0 = acc[ai][bj][m][0], v1 = acc[ai][bj][m][1];
                    u32x4 w; w.x = pk2(v0[0], v0[1]); w.y = pk2(v0[2], v0[3]); w.z = pk2(v1[0], v1[1]); w.w = pk2(v1[2], v1[3]);
                    *(u32x4*)(rowp + bj * HALF) = w; } }
    }
};
struct EpiSwiglu {
    static constexpr bool PERM = true;
    bf16* O; int ldc;
    DI void operator()(const f32x4 (&acc)[2][2][4][2], const Unit& u, int wr, int wc, int fr, int fq) const {
        const int row0 = u.pm * BM + wr * 64 + fr, col0 = u.pn * HALF + wc * 32 + 8 * fq;
#pragma unroll
        for (int ai = 0; ai < 2; ++ai)
#pragma unroll
            for (int m = 0; m < 4; ++m) { bf16* rowp = O + (size_t)(row0 + ai * HALF + m * 16) * ldc + col0;
                float h[8];
#pragma unroll
                for (int n = 0; n < 2; ++n)
#pragma unroll
                    for (int j = 0; j < 4; ++j) { const float g = acc[ai][0][m][n][j], up = acc[ai][1][m][n][j]; h[n * 4 + j] = (g * up) * __builtin_amdgcn_rcpf(1.0f + __builtin_amdgcn_exp2f(g * -1.44269504088896f)); }
                *(u32x4*)rowp = pack8(h); }
    }
};
struct EpiSwigluF8 {
    static constexpr bool PERM = true;
    unsigned char* O; int ldc;
    DI void operator()(const f32x4 (&acc)[2][2][4][2], const Unit& u, int wr, int wc, int fr, int fq) const {
        const int row0 = u.pm * BM + wr * 64 + fr, col0 = u.pn * HALF + wc * 32 + 8 * fq;
#pragma unroll
        for (int ai = 0; ai < 2; ++ai)
#pragma unroll
            for (int m = 0; m < 4; ++m) { unsigned char* rowp = O + (size_t)(row0 + ai * HALF + m * 16) * ldc + col0;
                float h[8];
#pragma unroll
                for (int n = 0; n < 2; ++n)
#pragma unroll
                    for (int j = 0; j < 4; ++j) { const float ag = acc[ai][0][m][n][j], au = acc[ai][1][m][n][j];
                        constexpr float KK = 1.f / (F8S_H * F8_GU_INV * F8_GU_INV), LK = 13.f; static_assert(KK == 8192.f, "log2 of K");
                        h[n * 4 + j] = (ag * au) * __builtin_amdgcn_rcpf(KK + __builtin_amdgcn_exp2f(__builtin_fmaf(ag, -1.44269504088896f * F8_GU_INV, LK))); }
                u32x2 w; w.x = pk4_f8(h[0], h[1], h[2], h[3]); w.y = pk4_f8(h[4], h[5], h[6], h[7]);
                *(u32x2*)rowp = w; }
    }
};
template <bool BASE_F32> struct EpiResid {
    static constexpr bool PERM = true;
    const void* base; bf16* out; int ldc;
    DI void operator()(const f32x4 (&acc)[2][2][4][2], const Unit& u, int wr, int wc, int fr, int fq) const {
        const int row0 = u.pm * BM + wr * 64 + fr, col0 = u.pn * BM + wc * 32 + 8 * fq;
        u32x4 bball[BASE_F32 ? 1 : 2][4][2];
        if constexpr (!BASE_F32) {
#pragma unroll
            for (int ai = 0; ai < 2; ++ai)
#pragma unroll
                for (int m = 0; m < 4; ++m)
#pragma unroll
                    for (int bj = 0; bj < 2; ++bj) bball[ai][m][bj] = *(const u32x4*)((const bf16*)base + (size_t)(row0 + ai * HALF + m * 16) * ldc + col0 + bj * HALF);
            asm volatile("" ::: "memory");
        }
#pragma unroll
        for (int ai = 0; ai < 2; ++ai) {
            f32x4 bf[BASE_F32 ? 4 : 1][2][2]; u32x4 bb[4][2];
#pragma unroll
            for (int m = 0; m < 4; ++m) { const size_t off = (size_t)(row0 + ai * HALF + m * 16) * ldc + col0;
#pragma unroll
                for (int bj = 0; bj < 2; ++bj) { if (BASE_F32) { bf[BASE_F32 ? m : 0][bj][0] = *(const f32x4*)((const float*)base + off + bj * HALF); bf[BASE_F32 ? m : 0][bj][1] = *(const f32x4*)((const float*)base + off + bj * HALF + 4); }
                                                 else bb[m][bj] = bball[BASE_F32 ? 0 : ai][m][bj]; } }
            asm volatile("" ::: "memory");
#pragma unroll
            for (int m = 0; m < 4; ++m) { const size_t off = (size_t)(row0 + ai * HALF + m * 16) * ldc + col0;
#pragma unroll
                for (int bj = 0; bj < 2; ++bj) { float h[8];
                    if (BASE_F32) {
#pragma unroll
                        for (int j = 0; j < 4; ++j) { h[j] = bf[BASE_F32 ? m : 0][bj][0][j]; h[4 + j] = bf[BASE_F32 ? m : 0][bj][1][j]; } }
                    else unpack8(bb[m][bj], h);
#pragma unroll
                    for (int j = 0; j < 4; ++j) { h[j] += acc[ai][bj][m][0][j]; h[4 + j] += acc[ai][bj][m][1][j]; }
                    *(u32x4*)(out + off + bj * HALF) = pack8(h); } }
            asm volatile("" ::: "memory");
        }
    }
};
struct EpiMoeDown {
    static constexpr bool PERM = true;
    const bf16* hin; bf16* hout; const int* row_tok; const float* row_gate; float sc;
    DI void operator()(const f32x4 (&acc)[2][2][4][2], const Unit& u, int wr, int wc, int fr, int fq) const {
        const int row0 = u.pm * BM + wr * 64 + fr, col0 = u.pn * BM + wc * 32 + 8 * fq;
        int tok[2][4]; float g[2][4];
#pragma unroll
        for (int ai = 0; ai < 2; ++ai)
#pragma unroll
            for (int m = 0; m < 4; ++m) { const int r = row0 + ai * HALF + m * 16; tok[ai][m] = row_tok[r]; g[ai][m] = row_gate[r] * sc; }
        u32x4 bball[2][4][2];
#pragma unroll
        for (int ai = 0; ai < 2; ++ai)
#pragma unroll
            for (int m = 0; m < 4; ++m) { const int tk = tok[ai][m]; const bf16* hp = hin + (size_t)(tk < 0 ? 0 : tk) * D + col0;
#pragma unroll
                for (int bj = 0; bj < 2; ++bj) bball[ai][m][bj] = *(const u32x4*)(hp + bj * HALF); }
        asm volatile("" ::: "memory");
#pragma unroll
        for (int ai = 0; ai < 2; ++ai) {
            u32x4 bb[4][2];
#pragma unroll
            for (int m = 0; m < 4; ++m)
#pragma unroll
                for (int bj = 0; bj < 2; ++bj) bb[m][bj] = bball[ai][m][bj];
#pragma unroll
            for (int m = 0; m < 4; ++m) { const int tk = tok[ai][m]; if (tk >= 0) { bf16* hp = hout + (size_t)tk * D + col0; const float gg = g[ai][m];
#pragma unroll
                for (int bj = 0; bj < 2; ++bj) { float h[8]; unpack8(bb[m][bj], h);
#pragma unroll
                    for (int j = 0; j < 4; ++j) { h[j] += acc[ai][bj][m][0][j] * gg; h[4 + j] += acc[ai][bj][m][1][j] * gg; }
                    *(u32x4*)(hp + bj * HALF) = pack8(h); } } }
            asm volatile("" ::: "memory");
        }
    }
};

struct EpiPartTile {
    static constexpr bool PERM = true;
    float* slab;
    DI void operator()(const f32x4 (&acc)[2][2][4][2], const Unit&, int wr, int wc, int fr, int fq) const {
        float* base = slab + (size_t)(wr * 64 + fr) * 256 + wc * 32 + 8 * fq;
#pragma unroll
        for (int ai = 0; ai < 2; ++ai)
#pragma unroll
            for (int m = 0; m < 4; ++m)
#pragma unroll
                for (int bj = 0; bj < 2; ++bj) { float* p = base + (size_t)(ai * HALF + m * 16) * 256 + bj * HALF; *(f32x4*)p = acc[ai][bj][m][0]; *(f32x4*)(p + 4) = acc[ai][bj][m][1]; }
    }
};

template <class Epi, class Sched, bool ALIGN_EPI, bool SP2, bool F8 = false>
DI void gemm_phase(LAS unsigned char* lds, const int K, const Sched& S, const Epi& E, const int ktiles = 0) {
    const int tid = threadIdx.x, wid = __builtin_amdgcn_readfirstlane(tid >> 6), lane = tid & 63, wr = wid >> 2, wc = wid & 3, fr = lane & 15, fq = lane >> 4;
    const int nt = ktiles ? ktiles : K / BK;
    unsigned voffA[2], voffB[2]; int RA[2], CA[2];
#pragma unroll
    for (int i = 0; i < 2; ++i) { int R, C; stage_rc(tid * 16 + i * 8192, R, C); const int Rb = Epi::PERM ? ((R & ~31) + perm32(R & 31)) : R;
        RA[i] = R; CA[i] = C; voffA[i] = (unsigned)(R * K + C) * 2u; voffB[i] = (unsigned)(Rb * K + C) * 2u; }
    unsigned gc[2][2] = {{0u, 0u}, {0u, 0u}}, gn[2][2] = {{0u, 0u}, {0u, 0u}};
    const size_t kstep = (size_t)(BK * 2);
    const size_t hstep = (size_t)HALF * K * 2;
    const unsigned ldsw = (unsigned)wid * 1024u;
    const int aoff = lds_byte(wr * 64 + fr, fq * 8), boff = lds_byte(wc * 32 + fr, fq * 8);
#define PG8_SA(b, h) (((b) * 2 + (h)) * HTB)
#define PG8_SB(b, h) ((4 + (b) * 2 + (h)) * HTB)
#define PG8_STAGE(bufoff, gbase, voff) do { _Pragma("unroll") for (int _i = 0; _i < 2; ++_i) \
        __builtin_amdgcn_global_load_lds((const unsigned*)((const char*)(gbase) + (voff)[_i]), (LAS unsigned*)(lds + (bufoff) + ldsw + _i * 8192), 16, 0, 0); } while (0)
#define PG8_STAGE_A(bufoff, kbase, h, go) do { if constexpr (Sched::GATHER) { PG8_STAGE(bufoff, kbase, (go)[h]); } else { PG8_STAGE(bufoff, (kbase) + (h) * hstep, voffA); } } while (0)
#define PG8_LDA(dst, b, h) do { _Pragma("unroll") for (int m = 0; m < 4; ++m) { if constexpr (F8) dst##8[m] = __builtin_shufflevector(*(const LAS i32x4*)(lds + PG8_SA(b, h) + aoff + m * 2048), *(const LAS i32x4*)(lds + PG8_SA(b, h) + aoff + m * 2048 + 1024), 0, 1, 2, 3, 4, 5, 6, 7); \
        else { _Pragma("unroll") for (int k = 0; k < 2; ++k) dst[m][k] = *(const LAS bf16x8*)(lds + PG8_SA(b, h) + aoff + m * 2048 + k * 1024); } } } while (0)
#define PG8_LDB(dst, b, h) do { _Pragma("unroll") for (int n = 0; n < 2; ++n) { if constexpr (F8) dst##8[n] = __builtin_shufflevector(*(const LAS i32x4*)(lds + PG8_SB(b, h) + boff + n * 2048), *(const LAS i32x4*)(lds + PG8_SB(b, h) + boff + n * 2048 + 1024), 0, 1, 2, 3, 4, 5, 6, 7); \
        else { _Pragma("unroll") for (int k = 0; k < 2; ++k) dst[n][k] = *(const LAS bf16x8*)(lds + PG8_SB(b, h) + boff + n * 2048 + k * 1024); } } } while (0)
#define PG8_MMA(ai, bj, At, Bt) do { __builtin_amdgcn_s_setprio(1); _Pragma("unroll") for (int m = 0; m < 4; ++m) _Pragma("unroll") for (int n = 0; n < 2; ++n) { \
        if constexpr (F8) asm volatile("v_mfma_f32_16x16x128_f8f6f4 %0, %1, %2, %0" : "+v"(acc[ai][bj][m][n]) : "v"(Bt##8[n]), "v"(At##8[m])); \
        else { _Pragma("unroll") for (int k = 0; k < 2; ++k) acc[ai][bj][m][n] = __builtin_amdgcn_mfma_f32_16x16x32_bf16(Bt[n][k], At[m][k], acc[ai][bj][m][n], 0, 0, 0); } } __builtin_amdgcn_s_setprio(0); } while (0)
#define PG8_WAIT_V(n) asm volatile("s_waitcnt vmcnt(" #n ")" ::: "memory")
#define PG8_WAIT_L(n) asm volatile("s_waitcnt lgkmcnt(" #n ")" ::: "memory")
#define PG8_BAR __builtin_amdgcn_s_barrier()
#define PG8_SCHED __builtin_amdgcn_sched_barrier(0)
    Unit cur, nxt; int ui = 0;
    if (!S.next(0, cur)) return;
    f32x4 acc[2][2][4][2];
#pragma unroll
    for (int a = 0; a < 2; ++a)
#pragma unroll
        for (int b = 0; b < 2; ++b)
#pragma unroll
            for (int m = 0; m < 4; ++m)
#pragma unroll
                for (int n = 0; n < 2; ++n) acc[a][b][m][n] = (f32x4){0.f, 0.f, 0.f, 0.f};
    bf16x8 At[4][2], B0[2][2], B1[2][2];
    i32x8 At8[4], B08[2], B18[2];
    const char* cA = S.a_base(cur); const char* cB = S.b_base(cur);
    if constexpr (Sched::GATHER) { S.a_offs(cur, RA, CA, gc); asm volatile("" : "+v"(gc[0][0]), "+v"(gc[0][1]), "+v"(gc[1][0]), "+v"(gc[1][1])); }
    if constexpr (SP2) {
        PG8_STAGE(PG8_SB(0, 0), cB, voffB); PG8_STAGE(PG8_SB(0, 1), cB + hstep, voffB); PG8_STAGE_A(PG8_SA(0, 0), cA, 0, gc); PG8_STAGE_A(PG8_SA(0, 1), cA, 1, gc);
        if (wr == 1) PG8_BAR;
        PG8_WAIT_V(2); PG8_BAR;
        PG8_STAGE(PG8_SB(1, 0), cB + kstep, voffB); PG8_STAGE_A(PG8_SA(1, 0), cA + kstep, 0, gc); PG8_STAGE(PG8_SB(1, 1), cB + hstep + kstep, voffB);
        PG8_WAIT_V(6); PG8_BAR;
    } else {
        PG8_STAGE(PG8_SB(0, 0), cB, voffB); PG8_STAGE_A(PG8_SA(0, 0), cA, 0, gc); PG8_STAGE(PG8_SB(0, 1), cB + hstep, voffB); PG8_STAGE_A(PG8_SA(0, 1), cA, 1, gc);
        if (wr == 1) PG8_BAR;
        PG8_WAIT_V(4); PG8_BAR;
        PG8_STAGE(PG8_SB(1, 0), cB + kstep, voffB); PG8_STAGE_A(PG8_SA(1, 0), cA + kstep, 0, gc); PG8_STAGE(PG8_SB(1, 1), cB + hstep + kstep, voffB);
        PG8_WAIT_V(6); PG8_BAR;
    }
    for (;;) {
        const bool has_next = S.next(ui + 1, nxt);
        const char* nA = has_next ? S.a_base(nxt) : cA; const char* nB = has_next ? S.b_base(nxt) : cB;
        if constexpr (Sched::GATHER) {
            if (has_next) { S.a_offs(nxt, RA, CA, gn); asm volatile("" : "+v"(gn[0][0]), "+v"(gn[0][1]), "+v"(gn[1][0]), "+v"(gn[1][1])); }
            else { gn[0][0] = gc[0][0]; gn[0][1] = gc[0][1]; gn[1][0] = gc[1][0]; gn[1][1] = gc[1][1]; }
        }
#pragma unroll 1
        for (int t = 0; t < nt; t += 2) {
            const bool last = (t == nt - 2);
            const char* a1 = cA + (size_t)(t + 1) * kstep;
            const char* a2 = last ? nA : cA + (size_t)(t + 2) * kstep; const char* b2 = last ? nB : cB + (size_t)(t + 2) * kstep;
            const char* a3 = a2 + kstep; const char* b3 = b2 + kstep;
            unsigned g2[2][2];
            if constexpr (Sched::GATHER) {
#pragma unroll
                for (int h = 0; h < 2; ++h)
#pragma unroll
                    for (int i = 0; i < 2; ++i) g2[h][i] = last ? gn[h][i] : gc[h][i];
            }
            if constexpr (SP2) {
            PG8_LDB(B0, 0, 0); PG8_LDB(B1, 0, 1); PG8_SCHED; PG8_LDA(At, 0, 0); PG8_STAGE_A(PG8_SA(1, 1), a1, 1, gc);
            PG8_WAIT_V(8); PG8_WAIT_L(0); PG8_BAR; PG8_MMA(0, 0, At, B0); PG8_MMA(0, 1, At, B1); PG8_BAR; PG8_SCHED;
            PG8_LDA(At, 0, 1); PG8_STAGE(PG8_SB(0, 0), b2, voffB); PG8_STAGE(PG8_SB(0, 1), b2 + hstep, voffB); PG8_STAGE_A(PG8_SA(0, 0), a2, 0, g2);
            PG8_WAIT_V(8); PG8_WAIT_L(0); PG8_BAR; PG8_MMA(1, 0, At, B0); PG8_MMA(1, 1, At, B1); PG8_BAR; PG8_SCHED;
            PG8_LDB(B0, 1, 0); PG8_LDB(B1, 1, 1); PG8_SCHED; PG8_LDA(At, 1, 0); PG8_STAGE_A(PG8_SA(0, 1), a2, 1, g2);
            PG8_WAIT_V(8); PG8_WAIT_L(0); PG8_BAR; PG8_MMA(0, 0, At, B0); PG8_MMA(0, 1, At, B1); PG8_BAR; PG8_SCHED;
            PG8_LDA(At, 1, 1); PG8_STAGE(PG8_SB(1, 0), b3, voffB); PG8_STAGE(PG8_SB(1, 1), b3 + hstep, voffB); PG8_STAGE_A(PG8_SA(1, 0), a3, 0, g2);
            PG8_WAIT_V(8); PG8_WAIT_L(0); PG8_BAR; PG8_MMA(1, 0, At, B0); PG8_MMA(1, 1, At, B1); PG8_BAR; PG8_SCHED;
            } else {
            PG8_LDB(B0, 0, 0); PG8_SCHED; PG8_LDA(At, 0, 0); PG8_STAGE_A(PG8_SA(1, 1), a1, 1, gc);
            PG8_WAIT_L(8); PG8_BAR; PG8_WAIT_L(0); PG8_MMA(0, 0, At, B0); PG8_BAR; PG8_SCHED;
            PG8_LDB(B1, 0, 1); PG8_STAGE(PG8_SB(0, 0), b2, voffB);
            PG8_BAR; PG8_WAIT_L(0); PG8_MMA(0, 1, At, B1); PG8_BAR;
            PG8_LDA(At, 0, 1); PG8_STAGE_A(PG8_SA(0, 0), a2, 0, g2);
            PG8_BAR; PG8_WAIT_L(0); PG8_MMA(1, 0, At, B0); PG8_BAR; PG8_SCHED;
            PG8_STAGE(PG8_SB(0, 1), b2 + hstep, voffB);
            PG8_WAIT_V(6); PG8_BAR; PG8_MMA(1, 1, At, B1); PG8_BAR;
            PG8_LDB(B0, 1, 0); PG8_SCHED; PG8_LDA(At, 1, 0); PG8_STAGE_A(PG8_SA(0, 1), a2, 1, g2);
            PG8_WAIT_L(8); PG8_BAR; PG8_WAIT_L(0); PG8_MMA(0, 0, At, B0); PG8_BAR; PG8_SCHED;
            PG8_LDB(B1, 1, 1); PG8_STAGE(PG8_SB(1, 0), b3, voffB);
            PG8_BAR; PG8_WAIT_L(0); PG8_MMA(0, 1, At, B1); PG8_BAR;
            PG8_LDA(At, 1, 1); PG8_STAGE_A(PG8_SA(1, 0), a3, 0, g2);
            PG8_BAR; PG8_WAIT_L(0); PG8_MMA(1, 0, At, B0); PG8_BAR; PG8_SCHED;
            PG8_STAGE(PG8_SB(1, 1), b3 + hstep, voffB);
            PG8_WAIT_V(6); PG8_BAR; PG8_MMA(1, 1, At, B1); PG8_BAR;
            }
        }
        if constexpr (ALIGN_EPI) { if (wr == 0) PG8_BAR; }
        if constexpr (F8) {
            asm volatile("s_nop 15\n\ts_nop 15" : "+v"(acc[0][0][0][0]), "+v"(acc[0][0][0][1]), "+v"(acc[0][0][1][0]), "+v"(acc[0][0][1][1]), "+v"(acc[0][0][2][0]), "+v"(acc[0][0][2][1]), "+v"(acc[0][0][3][0]), "+v"(acc[0][0][3][1]) :: "memory");
            asm volatile("" : "+v"(acc[0][1][0][0]), "+v"(acc[0][1][0][1]), "+v"(acc[0][1][1][0]), "+v"(acc[0][1][1][1]), "+v"(acc[0][1][2][0]), "+v"(acc[0][1][2][1]), "+v"(acc[0][1][3][0]), "+v"(acc[0][1][3][1]));
            asm volatile("" : "+v"(acc[1][0][0][0]), "+v"(acc[1][0][0][1]), "+v"(acc[1][0][1][0]), "+v"(acc[1][0][1][1]), "+v"(acc[1][0][2][0]), "+v"(acc[1][0][2][1]), "+v"(acc[1][0][3][0]), "+v"(acc[1][0][3][1]));
            asm volatile("" : "+v"(acc[1][1][0][0]), "+v"(acc[1][1][0][1]), "+v"(acc[1][1][1][0]), "+v"(acc[1][1][1][1]), "+v"(acc[1][1][2][0]), "+v"(acc[1][1][2][1]), "+v"(acc[1][1][3][0]), "+v"(acc[1][1][3][1]));
        }
        E(acc, cur, wr, wc, fr, fq);
        if (!has_next) break;
#pragma unroll
        for (int a = 0; a < 2; ++a)
#pragma unroll
            for (int b = 0; b < 2; ++b)
#pragma unroll
                for (int m = 0; m < 4; ++m)
#pragma unroll
                    for (int n = 0; n < 2; ++n) acc[a][b][m][n] = (f32x4){0.f, 0.f, 0.f, 0.f};
        cur = nxt; cA = nA; cB = nB; ++ui;
        if constexpr (Sched::GATHER) { gc[0][0] = gn[0][0]; gc[0][1] = gn[0][1]; gc[1][0] = gn[1][0]; gc[1][1] = gn[1][1]; }
        if constexpr (ALIGN_EPI) { if (wr == 1) PG8_BAR; }
    }
    PG8_WAIT_V(0);
    if constexpr (!ALIGN_EPI) { if (wr == 0) PG8_BAR; }
    PG8_BAR;
#undef PG8_SA
#undef PG8_SB
#undef PG8_STAGE
#undef PG8_STAGE_A
#undef PG8_LDA
#undef PG8_LDB
#undef PG8_MMA
#undef PG8_WAIT_V
#undef PG8_WAIT_L
#undef PG8_BAR
#undef PG8_SCHED
}
}

constexpr size_t MiB = 1u << 20;
constexpr size_t WS_CTL = 0, CTL_ZERO_BYTES = 64 * 1024;
constexpr size_t WS_SMALL = 1 * MiB;
constexpr size_t SM_POOLT = WS_SMALL;
constexpr size_t SM_W2T = SM_POOLT + 2 * 4 * 64 * 64 * 2;
constexpr size_t SM_A2T = SM_W2T + 2 * 512 * 64 * 2;
constexpr size_t SM_G2T = SM_A2T + 2 * 512 * 64 * 2;
constexpr size_t SM_V1T = SM_G2T + 2 * 512 * 128 * 2;
constexpr size_t SM_V2T = SM_V1T + 32 * 512 * 2;
constexpr size_t SM_END = SM_V2T + 512 * 32 * 2;
constexpr size_t TB_TKE = 2 * MiB;
constexpr size_t TB_TKG = TB_TKE + 2 * M * 4;
constexpr size_t TB_CNT = TB_TKG + 2 * M * 4;
constexpr size_t TB_ROWTOK = TB_CNT + 256 * 16 * 4;
constexpr size_t TB_ROWGATE = TB_ROWTOK + 2 * MOE_ROWS * 4;
constexpr size_t TB_TILEE = TB_ROWGATE + 2 * MOE_ROWS * 4;
constexpr size_t TB_NTILES = TB_TILEE + 2 * MOE_TILES * 4;
constexpr size_t TB_END = TB_NTILES + 64;
static_assert(SM_END <= TB_TKE && TB_END <= 4 * MiB, "small region");
constexpr size_t WS_WIN = 4 * MiB;
constexpr size_t WS_WOUT = WS_WIN + (size_t)2 * NIN * D * 2;
constexpr size_t WS_WGU = WS_WOUT + (size_t)2 * D * D * 2;
constexpr size_t WS_WDN = WS_WGU + (size_t)2 * FF * D * 2;
constexpr size_t WS_WEND = WS_WDN + (size_t)D * FF * 2;
static_assert(WS_WEND <= 36 * MiB, "main weights");
constexpr size_t WS_HN = 36 * MiB;
constexpr size_t WS_MIX = 101 * MiB;
constexpr size_t WS_VF = 165 * MiB;
constexpr size_t WS_VV1 = 197 * MiB;
constexpr size_t WS_PROJ = 204 * MiB;
constexpr size_t WS_ZB = 364 * MiB, WS_Y0B = 396 * MiB, WS_PTB = 428 * MiB, WS_QB = 460 * MiB;
constexpr size_t WS_SB = 492 * MiB;
constexpr size_t WS_RKB = 524 * MiB;
constexpr size_t WS_GB = 36 * MiB;
constexpr size_t WS_VMB = 68 * MiB;
constexpr size_t WS_HID = 204 * MiB;
constexpr size_t WS_WMGU = 165 * MiB;
constexpr size_t WS_WMDN = 101 * MiB;
constexpr size_t WS_MHID = 277 * MiB;
constexpr size_t WS_PART = 221 * MiB;
constexpr size_t WS_NEED = 526 * MiB;
static_assert(WS_WMGU + (size_t)NE * 2 * FE * D <= WS_PART && WS_PART + (size_t)32 * 7 * 65536 * 4 <= WS_MHID && WS_WMDN + (size_t)NE * D * FE <= 165 * MiB && WS_MHID + (size_t)2 * MOE_ROWS * FE <= 526 * MiB && WS_RKB + (size_t)M * 8 * 4 <= 526 * MiB, "moe map");
static_assert(WS_HN + (size_t)(M + 1) * D * 2 <= WS_MIX && WS_PROJ + (size_t)M * NIN * 2 <= 364 * MiB && WS_HID + (size_t)M * FF * 2 <= 526 * MiB, "map");
constexpr int CW_LEFT = 8192;
constexpr int CW_BAR = 1024;

constexpr int LDS_BYTES = 163840 - 1024;
constexpr int MISC_OFF = LDS_BYTES - 256;

#define XB_TMO      128
#define XB_XCNT(j)  (256  + 64 * (j))
#define XB_XSUB(j)  (1280 + 64 * (j))
#define XB_XGEN(j)  (2304 + 64 * (j))
#define XB_TOP      3328
#define XB_TOPGEN   3392
#define XCD_BAR_WORDS 3456
#define XB_SPIN_CAP (1u << 22)
DI unsigned xb_ld(unsigned* p)              { return __hip_atomic_load(p, __ATOMIC_RELAXED, __HIP_MEMORY_SCOPE_AGENT); }
DI unsigned xb_add(unsigned* p, unsigned v) { return __hip_atomic_fetch_add(p, v, __ATOMIC_RELAXED, __HIP_MEMORY_SCOPE_AGENT); }
DI unsigned xb_xcc_id() { return (unsigned)__builtin_amdgcn_s_getreg((3 << 11) | 20) & 0xFu; }
#define XB_SPIN(cond, bar) do { unsigned _sp = 0; while (cond) { __builtin_amdgcn_s_sleep(1); \
    if ((++_sp & 255u) == 0u) { if (xb_ld(&(bar)[XB_TMO])) break; if (_sp > XB_SPIN_CAP) { atomicAdd(&(bar)[XB_TMO], 1u); break; } } } } while (0)
struct XcdBarrier { unsigned* bar; unsigned x; volatile LAS unsigned* st; };
DI XcdBarrier xcd_barrier_post(unsigned* bar, volatile LAS unsigned* st) {
    XcdBarrier b; b.bar = bar; b.x = xb_xcc_id(); b.st = st;
    if (threadIdx.x == 0) (void)xb_add(&bar[XB_XCNT(b.x)], 1u);
    return b;
}
DI void xcd_barrier_complete(unsigned* bar, unsigned x, unsigned& nloc, unsigned& nx) {
    const unsigned G = gridDim.x * gridDim.y * gridDim.z;
    unsigned sum, cnt, mine, sp = 0u;
    for (;;) {
        sum = 0u; cnt = 0u; mine = 0u;
#pragma unroll
        for (unsigned j = 0; j < 16; ++j) { const unsigned c = xb_ld(&bar[XB_XCNT(j)]); sum += c; cnt += (c > 0u) ? 1u : 0u; mine = (j == x) ? c : mine; }
        if (sum == G) break;
        __builtin_amdgcn_s_sleep(1);
        if ((++sp & 255u) == 0u) { if (xb_ld(&bar[XB_TMO])) break; if (sp > XB_SPIN_CAP) { atomicAdd(&bar[XB_TMO], 1u); break; } }
    }
    nloc = mine > 0u ? mine : 1u; nx = cnt > 0u ? cnt : 1u;
}
DI void xcd_barrier(const XcdBarrier& b) {
    asm volatile("s_waitcnt vmcnt(0)" ::: "memory");
    __syncthreads();
    if (threadIdx.x == 0) {
        unsigned* bar = b.bar;
        __builtin_amdgcn_s_waitcnt(0);
        unsigned nloc = b.st[0], nx = b.st[1];
        if (nloc == 0u) { xcd_barrier_complete(bar, b.x, nloc, nx); b.st[0] = nloc; b.st[1] = nx; }
        const unsigned old = xb_add(&bar[XB_XSUB(b.x)], 1u);
        const unsigned gen = old / nloc;
        if (old + 1u == (gen + 1u) * nloc) {
            __builtin_amdgcn_fence(__ATOMIC_RELEASE, "agent");
            asm volatile("s_waitcnt vmcnt(0)" ::: "memory");
            const unsigned og = xb_add(&bar[XB_TOP], 1u);
            const unsigned tg = og / nx;
            if (og + 1u == (tg + 1u) * nx) xb_add(&bar[XB_TOPGEN], 1u);
            else XB_SPIN(xb_ld(&bar[XB_TOPGEN]) == tg, bar);
            __builtin_amdgcn_fence(__ATOMIC_ACQUIRE, "agent");
            xb_add(&bar[XB_XGEN(b.x)], 1u);
            asm volatile("s_waitcnt vmcnt(0)" ::: "memory");
        } else {
            XB_SPIN(xb_ld(&bar[XB_XGEN(b.x)]) == gen, bar);
            __builtin_amdgcn_fence(__ATOMIC_ACQUIRE, "agent");
            asm volatile("s_waitcnt vmcnt(0)" ::: "memory");
        }
    }
    __syncthreads();
}

struct Args { const float* in[33]; float* out; unsigned char* ws; int ph_lo, ph_hi; };
struct Frame {
    LAS unsigned char* lds;
    int wave, wg, G;
    const struct Args* A; float* out; unsigned char* ws;
};
enum In { I_X = 0, I_N1G, I_WIN, I_POOLW, I_POOLS, I_CONVW, I_CONVB, I_CLNG, I_CLNB, I_MU, I_W0, I_W2, I_A0, I_A2, I_G2, I_KK, I_KA, I_RK, I_GNG, I_GNB, I_V0, I_V1, I_V2, I_WOUT, I_N2G,
          I_FG, I_FU, I_FD, I_ROUTER, I_MG, I_MU2, I_MD, I_FINALG };

#define LDS_WAIT() asm volatile("s_waitcnt lgkmcnt(0)" ::: "memory")
#define LDS_BAR() do { asm volatile("s_waitcnt lgkmcnt(0)" ::: "memory"); __builtin_amdgcn_s_barrier(); asm volatile("" ::: "memory"); } while (0)
#define PIN_MEM() asm volatile("" ::: "memory")
DI u32x4 ldg16(const bf16* p) { return *(const u32x4*)p; }
struct CvItem { const float* W; bf16* WT; int K, N, k0, n0, drow0; };
DI void cv_load(const CvItem& c, const int lane, f32x4 (&r)[16]) {
#pragma unroll
    for (int i = 0; i < 16; ++i) r[i] = __builtin_nontemporal_load((const f32x4*)(c.W + (size_t)(c.k0 + 4 * i + (lane >> 4)) * c.N + c.n0 + 4 * (lane & 15)));
}
DI bf16x8 cv_trfrag(const LAS unsigned char* img, const int c0, const int kb, const int lane);
template <int F8SC> DI void cv_store(const CvItem& c, const int lane, const f32x4 (&r)[16], LAS unsigned char* img) {
#pragma unroll
    for (int i = 0; i < 16; ++i) { u32x2 w; w.x = pk2(r[i][0], r[i][1]); w.y = pk2(r[i][2], r[i][3]); *(LAS u32x2*)(img + ((4 * i + (lane >> 4)) * 72 + 4 * (lane & 15)) * 2) = w; }
    LDS_WAIT(); asm volatile("" ::: "memory");
#pragma unroll
    for (int nb = 0; nb < 4; ++nb)
#pragma unroll
        for (int kh = 0; kh < 2; ++kh) { const bf16x8 v = cv_trfrag(img, 16 * nb, kh, lane);
            if constexpr (F8SC == 0) *(bf16x8*)(c.WT + (size_t)(c.drow0 + 16 * nb + (lane & 15)) * c.K + c.k0 + 32 * kh + 8 * (lane >> 4)) = v;
            else { float f[8]; unpack8(__builtin_bit_cast(u32x4, v), f); constexpr float sc = (float)F8SC; u32x2 w; w.x = pk4_f8(f[0] * sc, f[1] * sc, f[2] * sc, f[3] * sc); w.y = pk4_f8(f[4] * sc, f[5] * sc, f[6] * sc, f[7] * sc);
                *(u32x2*)((unsigned char*)c.WT + (size_t)(c.drow0 + 16 * nb + (lane & 15)) * c.K + c.k0 + 32 * kh + 8 * (lane >> 4)) = w; } }
    LDS_WAIT(); asm volatile("" ::: "memory");
}
DI CvItem cv_plain(const float* W, int K, int N, bf16* WT, int item) { const int nblk = N / 64, kb = item / nblk, nb = item % nblk; return CvItem{W, WT, K, N, 64 * kb, 64 * nb, 64 * nb}; }
DI CvItem cv_gu(const float* W, int K, int Fh, bf16* WT, int up, int item) { const int nblk = Fh / 64, kb = item / nblk, nb = item % nblk, n0 = 64 * nb; return CvItem{W, WT, K, Fh, 64 * kb, n0, 256 * (n0 / 128) + up * 128 + (n0 % 128)}; }
template <int F8SC, class Desc> DI void cv_run(const Desc& desc, const int nitems, const int first, const int stride, const int lane, LAS float* scr_) {
    if (first >= nitems) return;
    LAS unsigned char* img = (LAS unsigned char*)scr_;
    f32x4 ra[16], rb[16];
    CvItem ca = desc(first), cb = ca;
    cv_load(ca, lane, ra);
    for (int it = first; it < nitems; it += 2 * stride) {
        const bool hb = (it + stride) < nitems;
        if (hb) { cb = desc(it + stride); cv_load(cb, lane, rb); }
        PIN_MEM();
        cv_store<F8SC>(ca, lane, ra, img);
        const bool ha = (it + 2 * stride) < nitems;
        if (ha) { ca = desc(it + 2 * stride); cv_load(ca, lane, ra); }
        PIN_MEM();
        if (hb) cv_store<F8SC>(cb, lane, rb, img);
    }
}

DI void store_row_bf16(bf16* orow, int lane, const f32x4 (&y)[4]) {
    u32x2* o8 = (u32x2*)orow + lane;
#pragma unroll
    for (int j = 0; j < 4; ++j) { u32x2 w; w.x = pk2(y[j].x, y[j].y); w.y = pk2(y[j].z, y[j].w); o8[64 * j] = w; }
}
DI void store_row_f8(unsigned char* orow, int lane, const f32x4 (&y)[4]) {
    unsigned* o4 = (unsigned*)orow + lane;
#pragma unroll
    for (int j = 0; j < 4; ++j) o4[64 * j] = pk4_f8(y[j].x * F8S_X, y[j].y * F8S_X, y[j].z * F8S_X, y[j].w * F8S_X);
}
DI void norm_rows_phase(Frame& F, const float* src, const float* g, bf16* dst) {
    const int lane = (int)threadIdx.x & 63, gw = F.wg * NWAVES + F.wave, NGW = F.G * NWAVES;
    f32x4 cr[2][4], nr[2][4];
#pragma unroll
    for (int q = 0; q < 2; ++q) { const int mq = (gw + q * NGW < M) ? gw + q * NGW : gw;
#pragma unroll
        for (int j = 0; j < 4; ++j) cr[q][j] = ((const f32x4*)(src + (size_t)mq * D) + lane)[64 * j]; }
#pragma unroll 1
    for (int m = gw; m < M; m += 2 * NGW) {
#pragma unroll
        for (int q = 0; q < 2; ++q) { const int mq = (m + (2 + q) * NGW < M) ? m + (2 + q) * NGW : m;
#pragma unroll
            for (int j = 0; j < 4; ++j) nr[q][j] = ((const f32x4*)(src + (size_t)mq * D) + lane)[64 * j]; }
        float ss[2] = {0.f, 0.f};
#pragma unroll
        for (int q = 0; q < 2; ++q)
#pragma unroll
            for (int j = 0; j < 4; ++j) ss[q] += (cr[q][j].x * cr[q][j].x + cr[q][j].y * cr[q][j].y) + (cr[q][j].z * cr[q][j].z + cr[q][j].w * cr[q][j].w);
#pragma unroll
        for (int q = 0; q < 2; ++q) { const float rstd = 1.0f / sqrtf(wave_sum(ss[q]) * (1.f / D) + RMS_EPS); const int mq = m + q * NGW; f32x4 y[4];
#pragma unroll
            for (int j = 0; j < 4; ++j) y[j] = cr[q][j] * rstd * ((const f32x4*)g + lane)[64 * j];
            if (mq < M) store_row_bf16(dst + (size_t)mq * D, lane, y); }
#pragma unroll
        for (int q = 0; q < 2; ++q)
#pragma unroll
            for (int j = 0; j < 4; ++j) cr[q][j] = nr[q][j];
    }
}
template <bool OUT_F32> DI void norm_rows_phase_b(Frame& F, const bf16* src, const float* g, void* dst) {
    const int lane = (int)threadIdx.x & 63, gw = F.wg * NWAVES + F.wave, NGW = F.G * NWAVES;
    f32x4 gg[4];
#pragma unroll
    for (int j = 0; j < 4; ++j) gg[j] = ((const f32x4*)g + lane)[64 * j];
    u32x2 cr[2][4], nr[2][4];
#pragma unroll
    for (int q = 0; q < 2; ++q) { const int mq = (gw + q * NGW < M) ? gw + q * NGW : gw;
#pragma unroll
        for (int j = 0; j < 4; ++j) cr[q][j] = ((const u32x2*)(src + (size_t)mq * D) + lane)[64 * j]; }
#pragma unroll 1
    for (int m = gw; m < M; m += 2 * NGW) {
#pragma unroll
        for (int q = 0; q < 2; ++q) { const int mq = (m + (2 + q) * NGW < M) ? m + (2 + q) * NGW : m;
#pragma unroll
            for (int j = 0; j < 4; ++j) nr[q][j] = ((const u32x2*)(src + (size_t)mq * D) + lane)[64 * j]; }
        f32x4 y[2][4]; float ss[2] = {0.f, 0.f};
#pragma unroll
        for (int q = 0; q < 2; ++q)
#pragma unroll
            for (int j = 0; j < 4; ++j) { const u32x2 v = cr[q][j]; y[q][j] = (f32x4){bflo(v.x), bfhi(v.x), bflo(v.y), bfhi(v.y)}; ss[q] += (y[q][j].x * y[q][j].x + y[q][j].y * y[q][j].y) + (y[q][j].z * y[q][j].z + y[q][j].w * y[q][j].w); }
#pragma unroll
        for (int q = 0; q < 2; ++q) { const float rstd = 1.0f / sqrtf(wave_sum(ss[q]) * (1.f / D) + RMS_EPS); const int mq = m + q * NGW;
#pragma unroll
            for (int j = 0; j < 4; ++j) y[q][j] = y[q][j] * rstd * gg[j];
            if (mq < M) { if constexpr (OUT_F32) { f32x4* o = (f32x4*)((float*)dst + (size_t)mq * D) + lane;
#pragma unroll
                    for (int j = 0; j < 4; ++j) o[64 * j] = y[q][j]; }
                else store_row_bf16((bf16*)dst + (size_t)mq * D, lane, y[q]); } }
#pragma unroll
        for (int q = 0; q < 2; ++q)
#pragma unroll
            for (int j = 0; j < 4; ++j) cr[q][j] = nr[q][j];
    }
}
template <int JOB> DI void convert_main(Frame& F, const int first, const int stride, LAS float* scr) {
    unsigned char* ws = F.ws; const Args* A = F.A;
    constexpr int I_IN = (D / 64) * (NIN / 64), I_OUT = (D / 64) * (D / 64), I_GU = (D / 64) * (FF / 64), I_DN = (FF / 64) * (D / 64);
    if (JOB == 0) {
        auto desc = [=](int it) -> CvItem { return cv_plain(A->in[I_WIN], D, NIN, (bf16*)(ws + WS_WIN), it); };
        cv_run<0>(desc, I_IN, first, stride, ((int)threadIdx.x & 63), scr);
    } else {
        constexpr int NITEMS = I_IN + 2 * I_OUT + 2 * I_GU + I_DN;
        auto desc = [=](int it) -> CvItem {
            int r = it;
            if (r < I_IN) return cv_plain(A->in[I_WIN] + (size_t)D * NIN, D, NIN, (bf16*)(ws + WS_WIN) + (size_t)NIN * D, r); r -= I_IN;
            if (r < 2 * I_OUT) { const int l = r / I_OUT; return cv_plain(A->in[I_WOUT] + (size_t)l * D * D, D, D, (bf16*)(ws + WS_WOUT) + (size_t)l * D * D, r % I_OUT); } r -= 2 * I_OUT;
            if (r < I_GU) return cv_gu(A->in[I_FG], D, FF, (bf16*)(ws + WS_WGU), 0, r); r -= I_GU;
            if (r < I_GU) return cv_gu(A->in[I_FU], D, FF, (bf16*)(ws + WS_WGU), 1, r); r -= I_GU;
            return cv_plain(A->in[I_FD], FF, D, (bf16*)(ws + WS_WDN), r);
        };
        cv_run<0>(desc, NITEMS, first, stride, ((int)threadIdx.x & 63), scr);
    }
}
DI void p0_prologue(Frame& F) {
    LAS float* scr = (LAS float*)(F.lds + F.wave * 16384);
    const int gw = F.wg * NWAVES + F.wave, NGW = F.G * NWAVES;
    unsigned char* ws = F.ws;
    convert_main<0>(F, gw, NGW, scr);
    const int gt = F.wg * NTHR + ((int)threadIdx.x), NGT = F.G * NTHR;
    for (int i = gt; i < 2 * 4 * 64 * 64; i += NGT) { const int c = i & 63, n = (i >> 6) & 63, lg = i >> 12; ((bf16*)(ws + SM_POOLT))[i] = (bf16)(pk2(F.A->in[I_POOLW][(size_t)lg * 4096 + c * 64 + n], 0.f) & 0xffffu); }
    for (int i = gt; i < 2 * 512 * 64; i += NGT) { const int j = i & 63, n = (i >> 6) & 511, l = i >> 15;
        ((bf16*)(ws + SM_W2T))[i] = (bf16)(pk2(F.A->in[I_W2][(size_t)l * 64 * 512 + j * 512 + n], 0.f) & 0xffffu);
        ((bf16*)(ws + SM_A2T))[i] = (bf16)(pk2(F.A->in[I_A2][(size_t)l * 64 * 512 + j * 512 + n], 0.f) & 0xffffu); }
    for (int i = gt; i < 2 * 512 * 128; i += NGT) { const int j = i & 127, n = (i >> 7) & 511, l = i >> 16; ((bf16*)(ws + SM_G2T))[i] = (bf16)(pk2(F.A->in[I_G2][(size_t)l * 128 * 512 + j * 512 + n], 0.f) & 0xffffu); }
    for (int i = gt; i < 32 * 512; i += NGT) { const int c = i & 511, r = i >> 9; ((bf16*)(ws + SM_V1T))[i] = (bf16)(pk2(F.A->in[I_V1][(size_t)c * 32 + r], 0.f) & 0xffffu); }
    for (int i = gt; i < 512 * 32; i += NGT) { const int r = i & 31, n = i >> 5; ((bf16*)(ws + SM_V2T))[i] = (bf16)(pk2(F.A->in[I_V2][(size_t)r * 512 + n], 0.f) & 0xffffu); }
}
template <int JOB> DI void moe_weight_convert(Frame& F, const int first, const int stride, LAS float* scr) {
    constexpr int I_G = (D / 64) * (FE / 64), I_D = (FE / 64) * (D / 64);
    const Args* A = F.A; unsigned char* ws = F.ws;
    if (JOB == 0) {
        auto desc = [=](int it) -> CvItem {
            const int e = it / (2 * I_G); int r = it % (2 * I_G);
            bf16* gu = (bf16*)(ws + WS_WMGU + (size_t)e * 2 * FE * D);
            if (r < I_G) return cv_gu(A->in[I_MG] + (size_t)e * D * FE, D, FE, gu, 0, r);
            return cv_gu(A->in[I_MU2] + (size_t)e * D * FE, D, FE, gu, 1, r - I_G);
        };
        cv_run<(int)F8S_WGU>(desc, NE * 2 * I_G, first, stride, ((int)threadIdx.x & 63), scr);
    } else {
        auto desc = [=](int it) -> CvItem { const int e = it / I_D, r = it % I_D; return cv_plain(A->in[I_MD] + (size_t)e * FE * D, FE, D, (bf16*)(ws + WS_WMDN + (size_t)e * D * FE), r); };
        cv_run<(int)F8S_WDN>(desc, NE * I_D, first, stride, ((int)threadIdx.x & 63), scr);
    }
}

DI void mixc_unit(Frame& F, const int l, const int tile) {
    int tid_ = ((int)threadIdx.x); asm volatile("" : "+v"(tid_));
    const int tid = tid_, lane = tid & 63, wave = __builtin_amdgcn_readfirstlane(tid >> 6);
    const int row0 = tile * 64, tseq = row0 & (T - 1);
    const bf16* proj = (const bf16*)(F.ws + WS_PROJ);
    bf16* mix = (bf16*)(F.ws + WS_MIX);
    u32x4 pv[5]; bool pok[5];
#pragma unroll
    for (int k = 0; k < 5; ++k) { const int idx = tid + k * NTHR, r = idx >> 5, cc = idx & 31; pok[k] = (idx < 79 * 32) && (tseq - 15 + r >= 0); pv[k] = ldg16(proj + (size_t)(pok[k] ? row0 - 15 + r : row0) * NIN + cc * 8); }
    u32x4 ca[6], cb[6]; bool cok[6];
#pragma unroll
    for (int k = 0; k < 6; ++k) { const int idx = tid + k * NTHR, r = idx >> 5, cc = idx & 31; cok[k] = (idx < 94 * 32) && (tseq - 30 + r >= 0); const bf16* p = proj + (size_t)(cok[k] ? row0 - 30 + r : row0) * NIN + cc * 8;
        ca[k] = ldg16(p + C_CONVA); cb[k] = ldg16(p + C_CONVB); }
    const int cch = tid & 255, half = tid >> 8; const float* cw = F.A->in[I_CONVW] + (size_t)l * 31 * 256 + cch; float w[31];
#pragma unroll
    for (int j = 0; j < 31; ++j) w[j] = cw[j * 256];
    const float bias = F.A->in[I_CONVB][l * 256 + cch];
    bf16x8 pfr[4][2]; f32x4 psc[4];
    { const bf16* PT = (const bf16*)(F.ws + SM_POOLT) + (size_t)(l * 4 + (wave >> 1)) * 4096; const float* sc = F.A->in[I_POOLS] + l * 256 + (wave >> 1) * 64;
#pragma unroll
      for (int nt = 0; nt < 4; ++nt) { psc[nt] = *(const f32x4*)(sc + nt * 16 + 4 * (lane >> 4));
#pragma unroll
          for (int ks = 0; ks < 2; ++ks) pfr[nt][ks] = *(const bf16x8*)(PT + (nt * 16 + (lane & 15)) * 64 + ks * 32 + (lane >> 4) * 8); } }
    PIN_MEM();
    LAS bf16* PU = (LAS bf16*)F.lds; LAS bf16* DM = (LAS bf16*)(F.lds + 79 * 264 * 2 + 16);
#pragma unroll
    for (int k = 0; k < 5; ++k) { const int idx = tid + k * NTHR, r = idx >> 5, cc = idx & 31; if (idx < 79 * 32) *(LAS u32x4*)(PU + r * 264 + cc * 8) = pok[k] ? pv[k] : (u32x4){0u, 0u, 0u, 0u}; }
    LDS_BAR();
    {
        const int g = wave >> 1, win = 2 << g, cc = g * 8 + (lane & 7);
#pragma unroll
        for (int it = 0; it < 4; ++it) { const int t = (wave & 1) * 32 + it * 8 + (lane >> 3); const int pos = tseq + t; const int cnt = (pos + 1 < win) ? pos + 1 : win;
            float s[8], u[8];
#pragma unroll
            for (int k = 0; k < 8; ++k) s[k] = 0.f;
            unpack8(*(const LAS u32x4*)(PU + (15 + t) * 264 + cc * 8), u);
            for (int j = 0; j < win; ++j) { float x[8]; unpack8(*(const LAS u32x4*)(PU + (15 + t - j) * 264 + cc * 8), x);
#pragma unroll
                for (int k = 0; k < 8; ++k) s[k] += x[k]; }
            const float inv = 1.0f / (float)cnt;
#pragma unroll
            for (int k = 0; k < 8; ++k) s[k] = s[k] * inv - u[k];
            *(LAS u32x4*)(DM + t * 264 + cc * 8) = pack8(s); }
    }
    LDS_BAR();
    {
        const int g = wave >> 1;
#pragma unroll
        for (int tt2 = 0; tt2 < 2; ++tt2) { const int tt = (wave & 1) * 2 + tt2;
            bf16x8 bfr[2];
#pragma unroll
            for (int ks = 0; ks < 2; ++ks) bfr[ks] = *(const LAS bf16x8*)(DM + (tt * 16 + (lane & 15)) * 264 + g * 64 + ks * 32 + (lane >> 4) * 8);
#pragma unroll
            for (int nt = 0; nt < 4; ++nt) { f32x4 acc = (f32x4){0.f, 0.f, 0.f, 0.f};
#pragma unroll
                for (int ks = 0; ks < 2; ++ks) acc = MFMA16(pfr[nt][ks], bfr[ks], acc);
                const int t = tt * 16 + (lane & 15), col = g * 64 + nt * 16 + 4 * (lane >> 4); const f32x4 s4 = psc[nt];
                u32x2 wv; wv.x = pk2(acc[0] * s4[0], acc[1] * s4[1]); wv.y = pk2(acc[2] * s4[2], acc[3] * s4[3]);
                *(u32x2*)(mix + (size_t)(row0 + t) * D + col) = wv; } }
    }
    LDS_BAR();
    LAS float* U = (LAS float*)F.lds;
#pragma unroll
    for (int k = 0; k < 6; ++k) { const int idx = tid + k * NTHR, r = idx >> 5, cc = idx & 31; float u[8], a[8], b[8]; unpack8(ca[k], a); unpack8(cb[k], b);
#pragma unroll
        for (int e = 0; e < 8; ++e) u[e] = cok[k] ? a[e] * sigmoidf_(b[e]) : 0.f;
        if (idx < 94 * 32) { *(LAS f32x4*)(U + r * 256 + cc * 8) = (f32x4){u[0], u[1], u[2], u[3]}; *(LAS f32x4*)(U + r * 256 + cc * 8 + 4) = (f32x4){u[4], u[5], u[6], u[7]}; } }
    u32x4 vc[8], vp[8];
    if (l == 1) {
#pragma unroll
        for (int k = 0; k < 8; ++k) { const int idx = tid + k * NTHR, t = idx >> 6, cc = idx & 63; const bf16* p = proj + (size_t)(row0 + t) * NIN + C_V + cc * 8; vc[k] = ldg16(p); vp[k] = ldg16(p - ((tseq + t > 0) ? NIN : 0)); }
        PIN_MEM();
    }
    LDS_BAR();
    {
        float y[32];
#pragma unroll
        for (int i = 0; i < 32; ++i) y[i] = bias;
#pragma unroll
        for (int r = 0; r < 62; ++r) { const float val = U[(half * 32 + r) * 256 + cch];
#pragma unroll
            for (int i = 0; i < 32; ++i) { const int j = r - i; if (j >= 0 && j <= 30) y[i] += w[j] * val; } }
        LDS_BAR();
#pragma unroll
        for (int i = 0; i < 32; ++i) U[(half * 32 + i) * 256 + cch] = y[i];
    }
    LDS_BAR();
    {
        const f32x4 lg = *(const f32x4*)(F.A->in[I_CLNG] + l * 256 + lane * 4), lb = *(const f32x4*)(F.A->in[I_CLNB] + l * 256 + lane * 4);
#pragma unroll 2
        for (int i = 0; i < 8; ++i) { const int t = wave * 8 + i; const f32x4 v = *(const LAS f32x4*)(U + t * 256 + lane * 4);
            const float mu = wave_sum((v.x + v.y) + (v.z + v.w)) * (1.f / 256.f); const f32x4 d = v - mu;
            const float var = wave_sum((d.x * d.x + d.y * d.y) + (d.z * d.z + d.w * d.w)) * (1.f / 256.f); const float rstd = 1.0f / sqrtf(var + LN_EPS);
            f32x4 o = d * rstd * lg + lb; u32x2 wv; wv.x = pk2(siluf_(o.x), siluf_(o.y)); wv.y = pk2(siluf_(o.z), siluf_(o.w));
            *(u32x2*)(mix + (size_t)(row0 + t) * D + 256 + lane * 4) = wv; }
    }
    if (l == 1) {
        LDS_BAR();
        LAS bf16* VS = (LAS bf16*)F.lds;
        const float* mu = F.A->in[I_MU] + l * NRC + (C_V - C_R);
#pragma unroll
        for (int k = 0; k < 8; ++k) { const int idx = tid + k * NTHR, t = idx >> 6, cc = idx & 63; float c8[8], p8[8]; unpack8(vc[k], c8); unpack8(vp[k], p8); const bool hp = (tseq + t) > 0;
            const f32x4 m0 = *(const f32x4*)(mu + cc * 8), m1 = *(const f32x4*)(mu + cc * 8 + 4);
#pragma unroll
            for (int e = 0; e < 8; ++e) c8[e] = c8[e] + (e < 4 ? m0[e & 3] : m1[e & 3]) * ((hp ? p8[e] : 0.f) - c8[e]);
            *(LAS u32x4*)(VS + t * 520 + cc * 8) = pack8(c8); }
        LDS_BAR();
        const int tt = wave & 3, rt = wave >> 2; const bf16* V1T = (const bf16*)(F.ws + SM_V1T); f32x4 acc = (f32x4){0.f, 0.f, 0.f, 0.f};
#pragma unroll 4
        for (int ks = 0; ks < 16; ++ks) { const bf16x8 a = *(const bf16x8*)(V1T + (rt * 16 + (lane & 15)) * 512 + ks * 32 + (lane >> 4) * 8);
            const bf16x8 b = *(const LAS bf16x8*)(VS + (tt * 16 + (lane & 15)) * 520 + ks * 32 + (lane >> 4) * 8); acc = MFMA16(a, b, acc); }
        *(f32x4*)((float*)(F.ws + WS_VV1) + (size_t)(row0 + tt * 16 + (lane & 15)) * 32 + rt * 16 + 4 * (lane >> 4)) = acc;
    }
    asm volatile("s_waitcnt vmcnt(0)" ::: "memory");
    LDS_BAR();
}

constexpr int S1_XW = 0, S1_XA = 9216, S1_XG = 18432, S1_XV = 35840;
constexpr int S1_AAB = 40960, S1_AAK = S1_AAB + 9216, S1_ARB = S1_AAK + 9216, S1_ARK = S1_ARB + 9216, S1_MT = S1_ARK + 9216, S1_XT = S1_MT + 9216, S1_TII = S1_XT + 9216;
constexpr int S1_RT = S1_TII + 3072, S1_AT = S1_RT + 9216, S1_BT = S1_AT + 9216, S1_KT = S1_BT + 9216, S1_VN = S1_KT + 9216;
constexpr int S1_WTOT = S1_VN + 9216, S1_NRM = S1_WTOT + 1024, S1_RKX = S1_NRM + 2048, S1_LC = S1_RKX + 2048, S1_MU = S1_LC + 256, S1_END = S1_MU + NRC * 4;
static_assert(S1_XV + 5120 <= S1_AAB && S1_END <= MISC_OFF, "S1 lds map");
#define LD_F8(ptr) (*(const LAS bf16x8*)(ptr))
typedef short s16x4 __attribute__((ext_vector_type(4)));
DI bf16x8 mk8(unsigned a, unsigned b, unsigned c, unsigned d) { u32x4 w = {a, b, c, d}; return __builtin_bit_cast(bf16x8, w); }
DI u32x2 pk4f(const f32x4 v) { u32x2 p; p.x = pk2(v[0], v[1]); p.y = pk2(v[2], v[3]); return p; }
DI f32x4 up4(const u32x2 v) { return (f32x4){bflo(v.x), bfhi(v.x), bflo(v.y), bfhi(v.y)}; }
DI bf16x8 mk8h(const u32x2 p) { return mk8(p.x, p.y, 0u, 0u); }
DI u32x2 tr_read(const LAS unsigned char* p) { return __builtin_bit_cast(u32x2, __builtin_amdgcn_ds_read_tr16_b64_v4i16((LAS s16x4*)p)); }
DI const LAS unsigned char* tr_addr(const LAS unsigned char* img, const int r0, const int c0, const int lane) { return img + ((r0 + ((lane & 15) >> 2)) * 72 + c0 + 4 * (lane & 3)) * 2; }
DI bf16x8 tr_frag(const LAS unsigned char* img, const int c0, const int kb, const int lane) {
    const int r0 = 32 * kb + 8 * (lane >> 4);
    const u32x2 lo = tr_read(tr_addr(img, r0, c0, lane)), hi = tr_read(tr_addr(img, r0 + 4, c0, lane));
    return mk8(lo.x, lo.y, hi.x, hi.y);
}
DI bf16x8 cv_trfrag(const LAS unsigned char* img, const int c0, const int kb, const int lane) { return tr_frag(img, c0, kb, lane); }
DI void shift8(const u32x4 cur, const u32x4 prev, const bool hasprev, const LAS unsigned char* L, const int col, float (&o)[8]) {
    float c8[8], p8[8]; unpack8(cur, c8); unpack8(prev, p8);
    const f32x4 m0 = *(const LAS f32x4*)(L + S1_MU + (col - C_R) * 4), m1 = *(const LAS f32x4*)(L + S1_MU + (col - C_R + 4) * 4);
#pragma unroll
    for (int k = 0; k < 8; ++k) o[k] = c8[k] + (k < 4 ? m0[k & 3] : m1[k & 3]) * ((hasprev ? p8[k] : 0.f) - c8[k]);
}
DI f32x4 shift4(const u32x2 cur, const u32x2 prev, const bool hasprev, const LAS unsigned char* L, const int col) {
    const f32x4 c = up4(cur), p = hasprev ? up4(prev) : (f32x4){0.f, 0.f, 0.f, 0.f}, m = *(const LAS f32x4*)(L + S1_MU + (col - C_R) * 4);
    return c + m * (p - c);
}
DI void s1_stage_mu(Frame& F, const int l) {
    for (int i = ((int)threadIdx.x); i < NRC / 4; i += NTHR) *(LAS f32x4*)(F.lds + S1_MU + i * 16) = *(const f32x4*)(F.A->in[I_MU] + l * NRC + i * 4);
    LDS_BAR();
}
DI void s1_chunk_prep(Frame& F, const int l, const int gchunk) {
    int tid_ = ((int)threadIdx.x); asm volatile("" : "+v"(tid_));
    const int t = tid_ >> 3, n8 = tid_ & 7, row0 = gchunk * 64;
    const bool hasprev = ((row0 & (T - 1)) + t) > 0;
    const bf16* prow = (const bf16*)(F.ws + WS_PROJ) + (size_t)(row0 + t) * NIN; const bf16* pprev = prow - (hasprev ? NIN : 0);
    LAS unsigned char* L = F.lds;
    const u32x4 cxw = ldg16(prow + C_XW + n8 * 8), pxw = ldg16(pprev + C_XW + n8 * 8), cxa = ldg16(prow + C_XA + n8 * 8), pxa = ldg16(pprev + C_XA + n8 * 8);
    const u32x4 cg0 = ldg16(prow + C_XG + n8 * 16), pg0 = ldg16(pprev + C_XG + n8 * 16), cg1 = ldg16(prow + C_XG + n8 * 16 + 8), pg1 = ldg16(pprev + C_XG + n8 * 16 + 8);
    f32x4 vv1 = (f32x4){0.f, 0.f, 0.f, 0.f}; if (l == 1) vv1 = *(const f32x4*)((const float*)(F.ws + WS_VV1) + (size_t)(row0 + t) * 32 + n8 * 4);
    PIN_MEM();
    float x[8];
    shift8(cxw, pxw, hasprev, L, C_XW + n8 * 8, x);
#pragma unroll
    for (int k = 0; k < 8; ++k) { const float e = fast_exp(2.0f * x[k]); x[k] = 1.0f - 2.0f * __builtin_amdgcn_rcpf(e + 1.0f); }
    *(LAS u32x4*)(L + S1_XW + (t * 72 + n8 * 8) * 2) = pack8(x);
    shift8(cxa, pxa, hasprev, L, C_XA + n8 * 8, x);
    *(LAS u32x4*)(L + S1_XA + (t * 72 + n8 * 8) * 2) = pack8(x);
    shift8(cg0, pg0, hasprev, L, C_XG + n8 * 16, x);
#pragma unroll
    for (int k = 0; k < 8; ++k) x[k] = sigmoidf_(x[k]);
    *(LAS u32x4*)(L + S1_XG + (t * 136 + n8 * 16) * 2) = pack8(x);
    shift8(cg1, pg1, hasprev, L, C_XG + n8 * 16 + 8, x);
#pragma unroll
    for (int k = 0; k < 8; ++k) x[k] = sigmoidf_(x[k]);
    *(LAS u32x4*)(L + S1_XG + (t * 136 + n8 * 16 + 8) * 2) = pack8(x);
    if (l == 1) *(LAS u32x2*)(L + S1_XV + (t * 40 + n8 * 4) * 2) = pk4f(vv1);
    LDS_BAR();
}
struct S1Pre { u32x2 cr[2], pr[2], ck[2], pk[2], cv[2], pv[2], vf[2]; };
DI void s1_issue(Frame& F, const int l, const int gchunk, const int h, S1Pre& P) {
    int tid_ = ((int)threadIdx.x); asm volatile("" : "+v"(tid_));
    const int lane = tid_ & 63, wave = tid_ >> 6, t = 16 * (wave & 3) + (lane & 15), row0 = gchunk * 64;
    const bool hasprev = ((row0 & (T - 1)) + t) > 0;
    const bf16* prow = (const bf16*)(F.ws + WS_PROJ) + (size_t)(row0 + t) * NIN; const bf16* pprev = prow - (hasprev ? NIN : 0);
#pragma unroll
    for (int nn = 0; nn < 2; ++nn) { const int c = h * 64 + (2 * (wave >> 2) + nn) * 16 + 4 * (lane >> 4);
        P.cr[nn] = *(const u32x2*)(prow + C_R + c); P.pr[nn] = *(const u32x2*)(pprev + C_R + c); P.ck[nn] = *(const u32x2*)(prow + C_K + c); P.pk[nn] = *(const u32x2*)(pprev + C_K + c);
        P.cv[nn] = *(const u32x2*)(prow + C_V + c); P.pv[nn] = *(const u32x2*)(pprev + C_V + c);
        P.vf[nn] = (l == 1) ? *(const u32x2*)((const bf16*)(F.ws + WS_VF) + (size_t)(row0 + t) * RW + c) : P.cv[nn]; }
    PIN_MEM();
}

DI void s1_unit(Frame& F, const int l, const int gchunk, const int h, const S1Pre& pre, const int hn, S1Pre& nxt) {
    int tid_ = ((int)threadIdx.x); asm volatile("" : "+v"(tid_));
    const int tid = tid_, lane = tid & 63, wave = __builtin_amdgcn_readfirstlane(tid >> 6), fr = lane & 15, fq = lane >> 4;
    const int row0 = gchunk * 64, tseq0 = row0 & (T - 1), unit = gchunk * 8 + h;
    const int tt = wave & 3, nh = wave >> 2, t = 16 * tt + fr;
    const bool hasprev = (tseq0 + t) > 0;
    LAS unsigned char* L = F.lds;
    bf16x8 fw[2][2], fa[2][2], fg[2][4], fv[2];
    f32x4 cw0[2], ca0[2], ckk[2], cka[2], crk[2], cv0[2];
    {
        const bf16* W2T = (const bf16*)(F.ws + SM_W2T) + (size_t)(l * 512 + h * 64) * 64; const bf16* A2T = (const bf16*)(F.ws + SM_A2T) + (size_t)(l * 512 + h * 64) * 64;
        const bf16* G2T = (const bf16*)(F.ws + SM_G2T) + (size_t)(l * 512 + h * 64) * 128; const bf16* V2T = (const bf16*)(F.ws + SM_V2T) + (size_t)(h * 64) * 32;
#pragma unroll
        for (int nn = 0; nn < 2; ++nn) { const int nr = (nh * 2 + nn) * 16 + fr, hc = h * 64 + (nh * 2 + nn) * 16 + 4 * fq;
#pragma unroll
            for (int ks = 0; ks < 2; ++ks) { fw[nn][ks] = *(const bf16x8*)(W2T + nr * 64 + ks * 32 + fq * 8); fa[nn][ks] = *(const bf16x8*)(A2T + nr * 64 + ks * 32 + fq * 8); }
#pragma unroll
            for (int ks = 0; ks < 4; ++ks) fg[nn][ks] = *(const bf16x8*)(G2T + nr * 128 + ks * 32 + fq * 8);
            fv[nn] = (l == 1) ? *(const bf16x8*)(V2T + nr * 32 + fq * 8) : fw[nn][0];
            cw0[nn] = *(const f32x4*)(F.A->in[I_W0] + l * RW + hc); ca0[nn] = *(const f32x4*)(F.A->in[I_A0] + l * RW + hc); ckk[nn] = *(const f32x4*)(F.A->in[I_KK] + l * RW + hc);
            cka[nn] = *(const f32x4*)(F.A->in[I_KA] + l * RW + hc); crk[nn] = *(const f32x4*)(F.A->in[I_RK] + l * RW + hc); cv0[nn] = (l == 1) ? *(const f32x4*)(F.A->in[I_V0] + hc) : cw0[nn]; }
    }
    PIN_MEM();
    f32x4 lw[2], cs[2], av[2], kk[2], km[2], vm[2], r4[2], k4[2], v4[2];
    float nrm = 0.f, rk = 0.f;
#pragma unroll
    for (int nn = 0; nn < 2; ++nn) { const int c0 = h * 64 + (nh * 2 + nn) * 16 + 4 * fq;
        r4[nn] = shift4(pre.cr[nn], pre.pr[nn], hasprev, L, C_R + c0); k4[nn] = shift4(pre.ck[nn], pre.pk[nn], hasprev, L, C_K + c0); v4[nn] = shift4(pre.cv[nn], pre.pv[nn], hasprev, L, C_V + c0); }
#pragma unroll
    for (int nn = 0; nn < 2; ++nn) { const int nt = nh * 2 + nn; f32x4 aw = (f32x4){0.f, 0.f, 0.f, 0.f}, aa = aw, ag = aw, ap = aw;
#pragma unroll
        for (int ks = 0; ks < 2; ++ks) { const int ko = ks * 32 + fq * 8;
            aw = MFMA16(fw[nn][ks], LD_F8(L + S1_XW + (t * 72 + ko) * 2), aw);
            aa = MFMA16(fa[nn][ks], LD_F8(L + S1_XA + (t * 72 + ko) * 2), aa); }
#pragma unroll
        for (int ks = 0; ks < 4; ++ks) ag = MFMA16(fg[nn][ks], LD_F8(L + S1_XG + (t * 136 + ks * 32 + fq * 8) * 2), ag);
        if (l == 1) ap = MFMA16(fv[nn], LD_F8(L + S1_XV + (t * 40 + fq * 8) * 2), ap);
        *(u32x2*)((bf16*)(F.ws + WS_GB) + (size_t)(row0 + t) * RW + h * 64 + nt * 16 + 4 * fq) = pk4f(ag);
        const int c0 = h * 64 + nt * 16 + 4 * fq;
        const f32x4 vf4 = up4(pre.vf[nn]);
#pragma unroll
        for (int j = 0; j < 4; ++j) {
            const float x = -(cw0[nn][j] + aw[j]);
            const float sp = fmaxf(x, 0.f) + __logf(1.0f + __expf(-fabsf(x)));
            lw[nn][j] = -__expf(-sp - 0.5f);
            av[nn][j] = __builtin_amdgcn_rcpf(1.0f + __expf(-(ca0[nn][j] + aa[j])));
            kk[nn][j] = k4[nn][j] * ckk[nn][j]; nrm += kk[nn][j] * kk[nn][j];
            km[nn][j] = k4[nn][j] * (1.0f + (av[nn][j] - 1.0f) * cka[nn][j]);
            rk += r4[nn][j] * km[nn][j] * crk[nn][j];
            vm[nn][j] = (l == 1) ? v4[nn][j] + (vf4[j] - v4[nn][j]) * __builtin_amdgcn_rcpf(1.0f + __expf(-(cv0[nn][j] + ap[j]))) : v4[nn][j];
        }
        cs[nn] = lw[nn];
        *(u32x2*)((bf16*)(F.ws + (l == 0 ? WS_VF : WS_VMB)) + (size_t)(row0 + t) * RW + c0) = pk4f(vm[nn]);
    }
    *(LAS float*)(L + S1_NRM + (t * 8 + nh * 4 + fq) * 4) = nrm; *(LAS float*)(L + S1_RKX + (t * 8 + nh * 4 + fq) * 4) = rk;
#pragma unroll
    for (int nn = 0; nn < 2; ++nn)
#pragma unroll
        for (int j = 0; j < 4; ++j) cs[nn][j] = row_scan16(cs[nn][j]);
    if (fr == 15) {
#pragma unroll
        for (int nn = 0; nn < 2; ++nn) *(LAS f32x4*)(L + S1_WTOT + (tt * 64 + (nh * 2 + nn) * 16 + 4 * fq) * 4) = cs[nn]; }
    LDS_BAR();
    {
        const f32x4 na = *(const LAS f32x4*)(L + S1_NRM + t * 32), nb = *(const LAS f32x4*)(L + S1_NRM + t * 32 + 16);
        const float n2 = ((na[0] + na[1]) + (na[2] + na[3])) + ((nb[0] + nb[1]) + (nb[2] + nb[3]));
        const float inv = __builtin_amdgcn_rsqf(fmaxf(n2, 1e-24f));
        if (nh == 0 && fq == 0) { const f32x4 ra = *(const LAS f32x4*)(L + S1_RKX + t * 32), rb = *(const LAS f32x4*)(L + S1_RKX + t * 32 + 16); ((float*)(F.ws + WS_RKB))[(size_t)(row0 + t) * 8 + h] = ((ra[0] + ra[1]) + (ra[2] + ra[3])) + ((rb[0] + rb[1]) + (rb[2] + rb[3])); }
#pragma unroll
        for (int nn = 0; nn < 2; ++nn) { const int nc = (nh * 2 + nn) * 16 + 4 * fq;
            f32x4 off = (f32x4){0.f, 0.f, 0.f, 0.f}, tot = off;
#pragma unroll
            for (int w = 0; w < 4; ++w) { const f32x4 x = *(const LAS f32x4*)(L + S1_WTOT + (w * 64 + nc) * 4); tot = tot + x; if (w < tt) off = off + x; }
            f32x4 rt, kt, at, bt;
#pragma unroll
            for (int j = 0; j < 4; ++j) { const float Lc = cs[nn][j] + off[j];
                const float eL = __expf(Lc), eN = __expf(-Lc), eP = __expf(Lc - lw[nn][j]); const float kkn = kk[nn][j] * inv;
                rt[j] = r4[nn][j] * eL; kt[j] = km[nn][j] * eN; at[j] = -kkn * eP; bt[j] = kkn * av[nn][j] * eN; }
            if (tt == 0 && fr == 0) *(LAS f32x4*)(L + S1_LC + nc * 4) = tot;
            const int on = (t * 72 + nc) * 2;
            *(LAS u32x2*)(L + S1_RT + on) = pk4f(rt); *(LAS u32x2*)(L + S1_AT + on) = pk4f(at); *(LAS u32x2*)(L + S1_BT + on) = pk4f(bt); *(LAS u32x2*)(L + S1_KT + on) = pk4f(kt); *(LAS u32x2*)(L + S1_VN + on) = pk4f(vm[nn]); }
    }
    LDS_BAR();
    f32x4 rhs[4];
    {
        const int mi = wave >> 1, par = wave & 1;
        const int xo = (mi < 2) ? S1_AT : S1_RT, yo = (mi & 1) ? S1_KT : S1_BT, dst = S1_AAB + mi * 9216;
        int idx = 0;
#pragma unroll
        for (int ti = 0; ti < 4; ++ti)
#pragma unroll
            for (int si = 0; si < 4; ++si, ++idx) {
                if ((idx & 1) != par) continue;
                u32x2 w = {0u, 0u};
                if (si <= ti) {
                    f32x4 acc = (f32x4){0.f, 0.f, 0.f, 0.f};
#pragma unroll
                    for (int ks = 0; ks < 2; ++ks) acc = MFMA16(LD_F8(L + yo + ((si * 16 + fr) * 72 + ks * 32 + fq * 8) * 2), LD_F8(L + xo + ((ti * 16 + fr) * 72 + ks * 32 + fq * 8) * 2), acc);
                    if (si == ti) {
#pragma unroll
                        for (int j = 0; j < 4; ++j) { const int sl = 4 * fq + j; const bool keep = (mi < 2) ? (sl < fr) : (sl <= fr); acc[j] = keep ? acc[j] : 0.f; }
                    }
                    w = pk4f(acc);
                }
                *(LAS u32x2*)(L + dst + ((ti * 16 + fr) * 72 + si * 16 + 4 * fq) * 2) = w;
            }
    }
    if (wave < 4) {
        const f32x4 z4 = (f32x4){0.f, 0.f, 0.f, 0.f};
        f32x4 va = z4, ua = z4;
#pragma unroll
        for (int ks = 0; ks < 2; ++ks) { const bf16x8 fA = LD_F8(L + S1_AT + ((wave * 16 + fr) * 72 + ks * 32 + fq * 8) * 2), fB = LD_F8(L + S1_BT + ((wave * 16 + fr) * 72 + ks * 32 + fq * 8) * 2);
            va = MFMA16(fB, fA, va); ua = MFMA16(fA, fB, ua); }
#pragma unroll
        for (int j = 0; j < 4; ++j) { va[j] = (4 * fq + j < fr) ? va[j] : 0.f; ua[j] = (fr < 4 * fq + j) ? ua[j] : 0.f; }
        const u32x2 v0 = pk4f(va), u0 = pk4f(ua);
        f32x4 w1 = up4(v0);
#pragma unroll
        for (int j = 0; j < 4; ++j) w1[j] += (4 * fq + j == fr) ? 1.0f : 0.0f;
        const u32x2 w1p = pk4f(w1);
        const u32x2 u1 = pk4f(MFMA16(mk8h(v0), mk8h(u0), z4)), v1 = pk4f(MFMA16(mk8h(u0), mk8h(v0), z4));
        const f32x4 w2 = MFMA16(mk8h(u1), mk8h(w1p), w1); const u32x2 w2p = pk4f(w2);
        const u32x2 u2 = pk4f(MFMA16(mk8h(v1), mk8h(u1), z4)), v2 = pk4f(MFMA16(mk8h(u1), mk8h(v1), z4));
        const f32x4 w3 = MFMA16(mk8h(u2), mk8h(w2p), w2); const u32x2 w3p = pk4f(w3);
        const u32x2 u3 = pk4f(MFMA16(mk8h(v2), mk8h(u2), z4));
        const f32x4 w4 = MFMA16(mk8h(u3), mk8h(w3p), w3);
        *(LAS u32x2*)(L + S1_TII + ((wave * 16 + fr) * 24 + 4 * fq) * 2) = pk4f(w4);
#pragma unroll
        for (int i = 0; i < 4; ++i) rhs[i] = up4(tr_read(tr_addr(L + S1_AT, 16 * i + 4 * fq, wave * 16, lane)));
    }
    s1_issue(F, l, gchunk, hn, nxt);
    LDS_BAR();
    {
        if (wave >= 4) {
            bf16x8 vfr2[2];
#pragma unroll
            for (int ks = 0; ks < 2; ++ks) vfr2[ks] = tr_frag(L + S1_VN, (wave - 4) * 16, ks, lane);
#pragma unroll
            for (int i = 0; i < 4; ++i) { f32x4 acc = (f32x4){0.f, 0.f, 0.f, 0.f};
#pragma unroll
                for (int ks = 0; ks < 2; ++ks) acc = MFMA16(LD_F8(L + S1_AAK + ((i * 16 + fr) * 72 + ks * 32 + fq * 8) * 2), vfr2[ks], acc);
                rhs[i] = acc; }
        }
        const f32x4 z4 = (f32x4){0.f, 0.f, 0.f, 0.f};
        u32x2 sp[4];
#define TII_FRAG(i) mk8h(*(const LAS u32x2*)(L + S1_TII + (((i) * 16 + fr) * 24 + 4 * fq) * 2))
#define AAB_P(i, j0) (*(const LAS u32x2*)(L + S1_AAB + (((i) * 16 + fr) * 72 + (j0) * 16 + 4 * fq) * 2))
        const u32x2 z2 = {0u, 0u};
        sp[0] = pk4f(MFMA16(TII_FRAG(0), mk8h(pk4f(rhs[0])), z4));
        { const u32x2 a = AAB_P(1, 0); const f32x4 a1 = MFMA16(mk8(a.x, a.y, 0u, 0u), mk8h(sp[0]), rhs[1]); sp[1] = pk4f(MFMA16(TII_FRAG(1), mk8h(pk4f(a1)), z4)); }
        { const u32x2 a = AAB_P(2, 0), b = AAB_P(2, 1); const f32x4 a2 = MFMA16(mk8(a.x, a.y, b.x, b.y), mk8(sp[0].x, sp[0].y, sp[1].x, sp[1].y), rhs[2]); sp[2] = pk4f(MFMA16(TII_FRAG(2), mk8h(pk4f(a2)), z4)); }
        { const u32x2 a = AAB_P(3, 0), b = AAB_P(3, 1), c = AAB_P(3, 2); f32x4 a3 = MFMA16(mk8(a.x, a.y, b.x, b.y), mk8(sp[0].x, sp[0].y, sp[1].x, sp[1].y), rhs[3]);
          a3 = MFMA16(mk8(c.x, c.y, 0u, 0u), mk8h(sp[2]), a3); sp[3] = pk4f(MFMA16(TII_FRAG(3), mk8h(pk4f(a3)), z4)); }
        (void)z2;
#undef TII_FRAG
#undef AAB_P
        const int dsto = (wave < 4) ? (S1_MT + ((wave * 16 + fr) * 72) * 2) : (S1_XT + (((wave - 4) * 16 + fr) * 72) * 2);
#pragma unroll
        for (int i = 0; i < 4; ++i) *(LAS u32x2*)(L + dsto + (16 * i + 4 * fq) * 2) = sp[i];
    }
    LDS_BAR();
    {
        bf16* ZB = (bf16*)(F.ws + WS_ZB) + (size_t)unit * 4096; bf16* Y0B = (bf16*)(F.ws + WS_Y0B) + (size_t)unit * 4096;
        bf16* PTB = (bf16*)(F.ws + WS_PTB) + (size_t)unit * 4096; bf16* QB = (bf16*)(F.ws + WS_QB) + (size_t)unit * 4096;
        const int ta = wave >> 1;
        const int ra = ((ta * 16 + fr) * 72 + fq * 8) * 2;
        bf16x8 fmt[2], fxt[2], fvn[2], fbt[2], fkt[2];
#pragma unroll
        for (int ks = 0; ks < 2; ++ks) { fmt[ks] = LD_F8(L + S1_MT + ra + ks * 64); fxt[ks] = LD_F8(L + S1_XT + ra + ks * 64); fvn[ks] = tr_frag(L + S1_VN, ta * 16, ks, lane); fbt[ks] = tr_frag(L + S1_BT, ta * 16, ks, lane); fkt[ks] = tr_frag(L + S1_KT, ta * 16, ks, lane); }
        const f32x4 lc = *(const LAS f32x4*)(L + S1_LC + (ta * 16 + 4 * fq) * 4);
#pragma unroll
        for (int ii = 0; ii < 2; ++ii) { const int tb = (wave & 1) * 2 + ii;
            const int rb = ((tb * 16 + fr) * 72 + fq * 8) * 2;
            const int so = (tb * 16 + fr) * 64 + 16 * fq + 4 * ta;
            bf16x8 frb[2], frk[2], fbc[2], fxc[2], fvc[2];
#pragma unroll
            for (int ks = 0; ks < 2; ++ks) { frb[ks] = LD_F8(L + S1_ARB + rb + ks * 64); frk[ks] = LD_F8(L + S1_ARK + rb + ks * 64); fbc[ks] = tr_frag(L + S1_BT, tb * 16, ks, lane); fxc[ks] = LD_F8(L + S1_XT + rb + ks * 64); fvc[ks] = tr_frag(L + S1_VN, tb * 16, ks, lane); }
            {
                f32x4 acc = (f32x4){0.f, 0.f, 0.f, 0.f};
#pragma unroll
                for (int ks = 0; ks < 2; ++ks) acc = MFMA16(fmt[ks], frb[ks], acc);
                acc = acc + up4(*(const LAS u32x2*)(L + S1_RT + ((tb * 16 + fr) * 72 + ta * 16 + 4 * fq) * 2));
                *(u32x2*)(ZB + so) = pk4f(acc); }
            {
                f32x4 acc = (f32x4){0.f, 0.f, 0.f, 0.f};
#pragma unroll
                for (int ks = 0; ks < 2; ++ks) { acc = MFMA16(fxt[ks], frb[ks], acc); acc = MFMA16(fvn[ks], frk[ks], acc); }
                *(u32x2*)(Y0B + so) = pk4f(acc); }
            {
                f32x4 acc = (f32x4){0.f, 0.f, 0.f, 0.f};
#pragma unroll
                for (int ks = 0; ks < 2; ++ks) acc = MFMA16(fmt[ks], fbc[ks], acc);
                const float dn = __expf(*(const LAS float*)(L + S1_LC + (tb * 16 + fr) * 4));
#pragma unroll
                for (int j = 0; j < 4; ++j) acc[j] = (acc[j] + ((ta == tb && 4 * fq + j == fr) ? 1.0f : 0.0f)) * dn;
                *(u32x2*)(PTB + (tb * 16 + fr) * 64 + 32 * (ta >> 1) + 8 * fq + 4 * (ta & 1)) = pk4f(acc); }
            {
                f32x4 acc = (f32x4){0.f, 0.f, 0.f, 0.f};
#pragma unroll
                for (int ks = 0; ks < 2; ++ks) { acc = MFMA16(fbt[ks], fxc[ks], acc); acc = MFMA16(fkt[ks], fvc[ks], acc); }
#pragma unroll
                for (int j = 0; j < 4; ++j) acc[j] *= __expf(lc[j]);
                *(u32x2*)(QB + so) = pk4f(acc); }
        }
    }
}
struct S2Buf { bf16x8 pa[4][2]; u32x4 q0, q1; };
DI void s2_load(S2Buf& B, const bf16* PT, const bf16* Q, const int fr, const int fq, const int vs) {
#pragma unroll
    for (int io = 0; io < 4; ++io)
#pragma unroll
        for (int kb = 0; kb < 2; ++kb) B.pa[io][kb] = *(const bf16x8*)(PT + (16 * io + fr) * 64 + 32 * kb + 8 * fq);
    B.q0 = *(const u32x4*)(Q + (16 * vs + fr) * 64 + 16 * fq); B.q1 = *(const u32x4*)(Q + (16 * vs + fr) * 64 + 16 * fq + 8);
    PIN_MEM();
}
DI void s2_step(const S2Buf& B, f32x4 (&acc)[4], bf16* SBu, const int fr, const int fq, const int vs) {
    u32x4 bw[2];
#pragma unroll
    for (int kb = 0; kb < 2; ++kb) { bw[kb].x = pk2(acc[2 * kb][0], acc[2 * kb][1]); bw[kb].y = pk2(acc[2 * kb][2], acc[2 * kb][3]); bw[kb].z = pk2(acc[2 * kb + 1][0], acc[2 * kb + 1][1]); bw[kb].w = pk2(acc[2 * kb + 1][2], acc[2 * kb + 1][3]);
        *(u32x4*)(SBu + (16 * vs + fr) * 64 + 16 * fq + 8 * kb) = bw[kb]; }
    const unsigned qw[8] = {B.q0.x, B.q0.y, B.q0.z, B.q0.w, B.q1.x, B.q1.y, B.q1.z, B.q1.w};
#pragma unroll
    for (int io = 0; io < 4; ++io) { f32x4 c = (f32x4){bflo(qw[2 * io]), bfhi(qw[2 * io]), bflo(qw[2 * io + 1]), bfhi(qw[2 * io + 1])};
#pragma unroll
        for (int kb = 0; kb < 2; ++kb) c = MFMA16(B.pa[io][kb], __builtin_bit_cast(bf16x8, bw[kb]), c);
        acc[io] = c; }
    PIN_MEM();
}
DI void s2_phase(Frame& F, const int l) {
    if (F.wg >= 128 || F.wave != 0) {
        const int widx = (F.wg < 128) ? F.wg * 7 + (F.wave - 1) : 896 + (F.wg - 128) * 8 + F.wave;
        LAS float* scr = (LAS float*)(F.lds + F.wave * 16384);
        if (l == 0) convert_main<1>(F, widx, 1920, scr); else moe_weight_convert<0>(F, widx, 1920, scr);
        return;
    }
    const int seq = F.wg >> 2, vs = F.wg & 3, b = seq >> 3, h = seq & 7, fr = ((int)threadIdx.x & 63) & 15, fq = ((int)threadIdx.x & 63) >> 4;
    const bf16* PTB = (const bf16*)(F.ws + WS_PTB); const bf16* QB = (const bf16*)(F.ws + WS_QB); bf16* SB = (bf16*)(F.ws + WS_SB);
    f32x4 acc[4];
#pragma unroll
    for (int i = 0; i < 4; ++i) acc[i] = (f32x4){0.f, 0.f, 0.f, 0.f};
    const size_t u0 = ((size_t)b * 128 * 8 + h) * 4096;
    S2Buf B0, B1, B2, B3;
    s2_load(B0, PTB + u0, QB + u0, fr, fq, vs); s2_load(B1, PTB + u0 + 32768, QB + u0 + 32768, fr, fq, vs); s2_load(B2, PTB + u0 + 2 * 32768, QB + u0 + 2 * 32768, fr, fq, vs);
#pragma unroll 1
    for (int c = 0; c < 128; c += 4) {
        const size_t uc = u0 + (size_t)c * 32768;
        const size_t un = (c + 4 < 128) ? uc + 4 * 32768 : uc;
        s2_load(B3, PTB + uc + 3 * 32768, QB + uc + 3 * 32768, fr, fq, vs);
        s2_step(B0, acc, SB + uc, fr, fq, vs);
        s2_load(B0, PTB + un, QB + un, fr, fq, vs);
        s2_step(B1, acc, SB + uc + 32768, fr, fq, vs);
        s2_load(B1, PTB + un + 32768, QB + un + 32768, fr, fq, vs);
        s2_step(B2, acc, SB + uc + 2 * 32768, fr, fq, vs);
        s2_load(B2, PTB + un + 2 * 32768, QB + un + 2 * 32768, fr, fq, vs);
        s2_step(B3, acc, SB + uc + 3 * 32768, fr, fq, vs);
    }
}
DI void s3_phase(Frame& F, const int l) {
    const int fr = ((int)threadIdx.x & 63) & 15, fq = ((int)threadIdx.x & 63) >> 4;
    const bf16* VM = (const bf16*)(F.ws + (l == 0 ? WS_VF : WS_VMB)); const bf16* GB = (const bf16*)(F.ws + WS_GB); const float* RKB = (const float*)(F.ws + WS_RKB);
    bf16* mix = (bf16*)(F.ws + WS_MIX);
    for (int u = F.wg * NWAVES + F.wave; u < (M / 64) * NH; u += F.G * NWAVES) {
        const int gchunk = u >> 3, h = u & 7, row0 = gchunk * 64;
        const bf16* SBu = (const bf16*)(F.ws + WS_SB) + (size_t)u * 4096; const bf16* ZBu = (const bf16*)(F.ws + WS_ZB) + (size_t)u * 4096; const bf16* Y0u = (const bf16*)(F.ws + WS_Y0B) + (size_t)u * 4096;
        bf16x8 sa[4][2], zf[4][2]; u32x4 y0a[4], y0b[4]; float rkv[4];
#pragma unroll
        for (int vt = 0; vt < 4; ++vt)
#pragma unroll
            for (int kb = 0; kb < 2; ++kb) sa[vt][kb] = *(const bf16x8*)(SBu + (16 * vt + fr) * 64 + 16 * fq + 8 * kb);
#pragma unroll
        for (int tt = 0; tt < 4; ++tt) { const int t = 16 * tt + fr; zf[tt][0] = *(const bf16x8*)(ZBu + t * 64 + 16 * fq); zf[tt][1] = *(const bf16x8*)(ZBu + t * 64 + 16 * fq + 8);
            y0a[tt] = *(const u32x4*)(Y0u + t * 64 + 16 * fq); y0b[tt] = *(const u32x4*)(Y0u + t * 64 + 16 * fq + 8); rkv[tt] = RKB[(size_t)(row0 + t) * 8 + h]; }
        f32x4 gg[4], gb[4];
#pragma unroll
        for (int vt = 0; vt < 4; ++vt) { gg[vt] = *(const f32x4*)(F.A->in[I_GNG] + l * RW + h * 64 + 16 * vt + 4 * fq); gb[vt] = *(const f32x4*)(F.A->in[I_GNB] + l * RW + h * 64 + 16 * vt + 4 * fq); }
        PIN_MEM();
#pragma unroll
        for (int tt = 0; tt < 4; ++tt) {
            const int t = 16 * tt + fr;
            u32x2 vmr[4], ggr[4];
#pragma unroll
            for (int vt = 0; vt < 4; ++vt) { const size_t o = (size_t)(row0 + t) * RW + h * 64 + 16 * vt + 4 * fq; vmr[vt] = *(const u32x2*)(VM + o); ggr[vt] = *(const u32x2*)(GB + o); }
            const unsigned yw[8] = {y0a[tt].x, y0a[tt].y, y0a[tt].z, y0a[tt].w, y0b[tt].x, y0b[tt].y, y0b[tt].z, y0b[tt].w};
            f32x4 y[4]; float s = 0.f;
#pragma unroll
            for (int vt = 0; vt < 4; ++vt) { f32x4 c = (f32x4){bflo(yw[2 * vt]), bfhi(yw[2 * vt]), bflo(yw[2 * vt + 1]), bfhi(yw[2 * vt + 1])};
                c = MFMA16(sa[vt][0], zf[tt][0], c); c = MFMA16(sa[vt][1], zf[tt][1], c); y[vt] = c; s += (c[0] + c[1]) + (c[2] + c[3]); }
            s += __shfl_xor(s, 16); s += __shfl_xor(s, 32);
            const float mean = s * (1.f / 64.f); float q = 0.f;
#pragma unroll
            for (int vt = 0; vt < 4; ++vt) { y[vt] = y[vt] - mean; q += (y[vt][0] * y[vt][0] + y[vt][1] * y[vt][1]) + (y[vt][2] * y[vt][2] + y[vt][3] * y[vt][3]); }
            q += __shfl_xor(q, 16); q += __shfl_xor(q, 32);
            const float rstd = 1.0f / sqrtf(q * (1.f / 64.f) + GN_EPS);
            const float rk = rkv[tt];
#pragma unroll
            for (int vt = 0; vt < 4; ++vt) {
                const f32x4 vv = (f32x4){bflo(vmr[vt].x), bfhi(vmr[vt].x), bflo(vmr[vt].y), bfhi(vmr[vt].y)}, gv = (f32x4){bflo(ggr[vt].x), bfhi(ggr[vt].x), bflo(ggr[vt].y), bfhi(ggr[vt].y)};
                const f32x4 ov = (y[vt] * rstd * gg[vt] + gb[vt] + vv * rk) * gv;
                u32x2 w; w.x = pk2(ov[0], ov[1]); w.y = pk2(ov[2], ov[3]);
                *(u32x2*)(mix + (size_t)(row0 + t) * D + 512 + h * 64 + 16 * vt + 4 * fq) = w; }
        }
    }
}

DI void norm2_router_phase(Frame& F, const bf16* hsrc, const float* g, const float* router) {
    LAS float* RT = (LAS float*)F.lds;
    LAS int* E01 = (LAS int*)(F.lds + 131072);
    for (int i = ((int)threadIdx.x); i < 2048; i += NTHR) { const int col = i >> 1, half = i & 1; *(LAS f32x4*)(RT + ((((col >> 8) * 4 + (col & 3)) * 2 + half) * 64 + ((col & 255) >> 2)) * 4) = *(const f32x4*)(router + i * 4); }
    __syncthreads();
    unsigned char* hn = F.ws + WS_HN;
    int* tke = (int*)(F.ws + TB_TKE); float* tkg = (float*)(F.ws + TB_TKG);
    const int lane = (int)threadIdx.x & 63, mb = F.wg * 128 + F.wave * 16;
    f32x4 gg[4];
#pragma unroll
    for (int j = 0; j < 4; ++j) gg[j] = ((const f32x4*)g + lane)[64 * j];
    u32x2 cr[2][4], nr[2][4];
#pragma unroll
    for (int q = 0; q < 2; ++q)
#pragma unroll
        for (int j = 0; j < 4; ++j) cr[q][j] = ((const u32x2*)(hsrc + (size_t)(mb + q) * D) + lane)[64 * j];
#pragma unroll 1
    for (int i = 0; i < 16; i += 2) {
        const int in = (i + 2 < 16) ? i + 2 : i;
#pragma unroll
        for (int q = 0; q < 2; ++q)
#pragma unroll
            for (int j = 0; j < 4; ++j) nr[q][j] = ((const u32x2*)(hsrc + (size_t)(mb + in + q) * D) + lane)[64 * j];
        f32x4 y[2][4]; float ss[2] = {0.f, 0.f};
#pragma unroll
        for (int q = 0; q < 2; ++q)
#pragma unroll
            for (int j = 0; j < 4; ++j) { const u32x2 v = cr[q][j]; y[q][j] = (f32x4){bflo(v.x), bfhi(v.x), bflo(v.y), bfhi(v.y)}; ss[q] += (y[q][j].x * y[q][j].x + y[q][j].y * y[q][j].y) + (y[q][j].z * y[q][j].z + y[q][j].w * y[q][j].w); }
#pragma unroll
        for (int q = 0; q < 2; ++q) { const float rstd = 1.0f / sqrtf(wave_sum(ss[q]) * (1.f / D) + RMS_EPS);
#pragma unroll
            for (int j = 0; j < 4; ++j) y[q][j] = y[q][j] * rstd * gg[j];
            store_row_f8(hn + (size_t)(mb + i + q) * D, lane, y[q]); }
        float lg[2][8];
#pragma unroll
        for (int q = 0; q < 2; ++q)
#pragma unroll
            for (int e = 0; e < 8; ++e) lg[q][e] = 0.f;
#pragma unroll
        for (int j = 0; j < 4; ++j)
#pragma unroll
            for (int k = 0; k < 4; ++k) { const LAS f32x4* rp = (const LAS f32x4*)RT + (j * 4 + k) * 128 + lane; const f32x4 r0 = rp[0], r1 = rp[64];
#pragma unroll
                for (int q = 0; q < 2; ++q) { const float x = y[q][j][k];
                    lg[q][0] += x * r0[0]; lg[q][1] += x * r0[1]; lg[q][2] += x * r0[2]; lg[q][3] += x * r0[3]; lg[q][4] += x * r1[0]; lg[q][5] += x * r1[1]; lg[q][6] += x * r1[2]; lg[q][7] += x * r1[3]; } }
#pragma unroll
        for (int q = 0; q < 2; ++q)
#pragma unroll
            for (int e = 0; e < 8; ++e) lg[q][e] = wave_sum(lg[q][e]);
        if (lane == 0) {
#pragma unroll
            for (int q = 0; q < 2; ++q) { const int lt = F.wave * 16 + i + q, m = mb + i + q;
                int e0 = 0; float v0 = lg[q][0];
#pragma unroll
                for (int e = 1; e < 8; ++e) if (lg[q][e] > v0) { v0 = lg[q][e]; e0 = e; }
                int e1 = -1; float v1 = -3.0e38f;
#pragma unroll
                for (int e = 0; e < 8; ++e) if (e != e0 && lg[q][e] > v1) { v1 = lg[q][e]; e1 = e; }
                const float g0 = 1.0f / (1.0f + __expf(v1 - v0));
                tke[m] = e0; tke[M + m] = e1; tkg[m] = g0; tkg[M + m] = 1.0f - g0;
                E01[lt] = e0; E01[128 + lt] = e1; }
        }
#pragma unroll
        for (int q = 0; q < 2; ++q)
#pragma unroll
            for (int j = 0; j < 4; ++j) cr[q][j] = nr[q][j];
    }
    if (F.wg == 0) for (int i = ((int)threadIdx.x); i < D / 4; i += NTHR) ((unsigned*)(hn + (size_t)M * D))[i] = 0u;
    __syncthreads();
    if (((int)threadIdx.x) < 16) { const int s = ((int)threadIdx.x) >> 3, e = ((int)threadIdx.x) & 7; int c = 0; for (int i = 0; i < 128; ++i) c += (E01[s * 128 + i] == e) ? 1 : 0; ((int*)(F.ws + TB_CNT))[F.wg * 16 + ((int)threadIdx.x)] = c; }
}
DI void moe_dispatch_phase(Frame& F) {
    LAS int* C = (LAS int*)F.lds;
    LAS int* TOT = C + 4096; LAS int* MINE = TOT + 16; LAS int* START = MINE + 16; LAS int* PAD = START + 16; LAS int* EL = PAD + 16;
    const int* cnt = (const int*)(F.ws + TB_CNT);
    { const int k = ((int)threadIdx.x) & 15, part = ((int)threadIdx.x) >> 4; int tot = 0, mine = 0;
#pragma unroll
      for (int j = 0; j < 8; ++j) { const int w = part * 8 + j, c = cnt[w * 16 + k]; tot += c; mine += (w < F.wg) ? c : 0; }
      C[part * 16 + k] = tot; C[512 + part * 16 + k] = mine; }
    __syncthreads();
    if (((int)threadIdx.x) < 16) { int tot = 0, mine = 0; for (int p = 0; p < 32; ++p) { tot += C[p * 16 + ((int)threadIdx.x)]; mine += C[512 + p * 16 + ((int)threadIdx.x)]; } TOT[((int)threadIdx.x)] = tot; MINE[((int)threadIdx.x)] = mine; }
    __syncthreads();
    if (((int)threadIdx.x) == 0) { int acc = 0; for (int k = 0; k < 16; ++k) { START[k] = acc; const int p = (TOT[k] + 255) & ~255; PAD[k] = p; acc += p; } }
    const int* tke = (const int*)(F.ws + TB_TKE); const float* tkg = (const float*)(F.ws + TB_TKG);
    int* rowtok = (int*)(F.ws + TB_ROWTOK); float* rowgate = (float*)(F.ws + TB_ROWGATE);
    if (((int)threadIdx.x) < 256) EL[((int)threadIdx.x)] = tke[(((int)threadIdx.x) >> 7) * M + F.wg * 128 + (((int)threadIdx.x) & 127)];
    __syncthreads();
    if (((int)threadIdx.x) < 256) { const int s = ((int)threadIdx.x) >> 7, i = ((int)threadIdx.x) & 127, e = EL[((int)threadIdx.x)]; int rank = 0; for (int j = 0; j < i; ++j) rank += (EL[s * 128 + j] == e) ? 1 : 0;
        const int dest = START[s * 8 + e] + MINE[s * 8 + e] + rank, tok = F.wg * 128 + i;
        rowtok[dest] = tok; rowgate[dest] = tkg[s * M + tok]; }
    if (F.wg < 16) { const int k = F.wg; for (int r = START[k] + TOT[k] + ((int)threadIdx.x); r < START[k] + PAD[k]; r += NTHR) { rowtok[r] = -1; rowgate[r] = 0.f; } }
    if (F.wg == 0) {
        int* tile_e = (int*)(F.ws + TB_TILEE); int* ntiles = (int*)(F.ws + TB_NTILES);
        if (((int)threadIdx.x) < 2 * MOE_TILES) { const int r = ((int)threadIdx.x) * 256; int e = 0; for (int k = 0; k < 16; ++k) if (r >= START[k]) e = k & 7; tile_e[((int)threadIdx.x)] = e; }
        if (((int)threadIdx.x) == 0) { const int n0 = START[8] >> 8; ntiles[0] = n0; ntiles[1] = ((START[15] + PAD[15]) >> 8) - n0; }
    }
}

__device__ __attribute__((noinline)) void moe_dn_combine(const int wg, const int nM, const int G, float* part, unsigned* cnt, const bf16* hin, bf16* hout, const int* row_tok, const float* row_gate, const float sc) {
    pg8::OrderBase S; S.init(nM, D / 256, G, wg);
    const int main = (S.nwg / S.G) * S.G, left = S.nwg - main;
    if (wg >= pg8::DN_KSPLIT * left) return;
    const int j = wg / pg8::DN_KSPLIT, q = wg % pg8::DN_KSPLIT, tid = (int)threadIdx.x;
    pg8::Unit u; S.map((long)main + j, u);
    asm volatile("s_waitcnt vmcnt(0)" ::: "memory");
    __syncthreads();
    if (tid == 0) { __builtin_amdgcn_fence(__ATOMIC_RELEASE, "agent"); asm volatile("s_waitcnt vmcnt(0)" ::: "memory"); __hip_atomic_fetch_add(cnt + 64 * j, 1u, __ATOMIC_RELAXED, __HIP_MEMORY_SCOPE_AGENT);
        unsigned sp = 0; while (__hip_atomic_load(cnt + 64 * j, __ATOMIC_RELAXED, __HIP_MEMORY_SCOPE_AGENT) < (unsigned)pg8::DN_KSPLIT) { __builtin_amdgcn_s_sleep(2); if (++sp > (1u << 22)) break; }
        __builtin_amdgcn_fence(__ATOMIC_ACQUIRE, "agent"); asm volatile("s_waitcnt vmcnt(0)" ::: "memory"); }
    __syncthreads();
    constexpr int KS = pg8::DN_KSPLIT, RPW = (256 + KS - 1) / KS;
    const float* slab = part + (size_t)j * KS * 65536;
    const int cg = (tid & 31) * 8, r1 = (q * RPW + RPW < 256) ? q * RPW + RPW : 256;
    for (int r = q * RPW + (tid >> 5); r < r1; r += 16) {
        const int row = u.pm * 256 + r; const int tok = row_tok[row]; const float g = row_gate[row] * sc;
        if (tok >= 0) {
            f32x4 a[KS][2];
#pragma unroll
            for (int k = 0; k < KS; ++k) { a[k][0] = *(const f32x4*)(slab + (size_t)k * 65536 + r * 256 + cg); a[k][1] = *(const f32x4*)(slab + (size_t)k * 65536 + r * 256 + cg + 4); }
            float h[8]; unpack8(*(const u32x4*)(hin + (size_t)tok * D + u.pn * 256 + cg), h);
            f32x4 s0 = a[0][0], s1 = a[0][1];
#pragma unroll
            for (int k = 1; k < KS; ++k) { s0 += a[k][0]; s1 += a[k][1]; }
#pragma unroll
            for (int e = 0; e < 4; ++e) { h[e] += g * s0[e]; h[4 + e] += g * s1[e]; }
            *(u32x4*)(hout + (size_t)tok * D + u.pn * 256 + cg) = pack8(h);
        }
    }
}

constexpr int NPHASES = 21;
#if defined(__HIP_DEVICE_COMPILE__)
#define NO_PK_F32 __attribute__((target("no-packed-fp32-ops")))
#else
#define NO_PK_F32
#endif
__global__ void __launch_bounds__(NTHR, 2) NO_PK_F32 fwd(Args args) {
    extern __shared__ __attribute__((aligned(16))) unsigned char lds[];
    Frame F;
    F.lds = (LAS unsigned char*)lds;
    F.wave = __builtin_amdgcn_readfirstlane((int)threadIdx.x >> 6);
    F.G = gridDim.x; F.wg = blockIdx.x;
    F.A = &args; F.out = args.out; F.ws = args.ws;
    volatile LAS unsigned* MISC = (volatile LAS unsigned*)(F.lds + MISC_OFF);
    if (((int)threadIdx.x) < 64) MISC[((int)threadIdx.x)] = 0u;
    __syncthreads();
    const int lo = args.ph_lo, hi = args.ph_hi;
    XcdBarrier bar; bar.bar = (unsigned*)(F.ws + WS_CTL) + CW_BAR; bar.x = 0; bar.st = nullptr;
    if (hi - lo > 1) bar = xcd_barrier_post((unsigned*)(F.ws + WS_CTL) + CW_BAR, MISC + 8);
#ifndef ONLY_PHASE
#define ONLY_PHASE -1
#endif
#define IN(k) ((ONLY_PHASE < 0 || (k) == ONLY_PHASE) && lo <= (k) && (k) < hi)
#define SEAM(k) do { if (IN(k) && IN((k) + 1)) xcd_barrier(bar); } while (0)
    unsigned char* ws = F.ws;
    bf16* HN = (bf16*)(ws + WS_HN); bf16* MIX = (bf16*)(ws + WS_MIX); bf16* PROJ = (bf16*)(ws + WS_PROJ);
    bf16* HB = (bf16*)F.out;

    if (IN(0)) { p0_prologue(F); norm_rows_phase(F, F.A->in[I_X], F.A->in[I_N1G], HN); }
    SEAM(0);
#define LAYER_MIXER(l) do { \
        constexpr int pb = 1 + (l) * 9; \
        if (IN(pb + 0)) { pg8::DenseSched S; S.init(M / 256, NIN / 256, F.G, F.wg); S.A = (const char*)HN; S.Bt = (const char*)(ws + WS_WIN) + (size_t)(l) * NIN * D * 2; S.tstep = (size_t)256 * D * 2; \
            pg8::EpiBf16 E{PROJ, NIN}; pg8::gemm_phase<pg8::EpiBf16, pg8::DenseSched, true, true>(F.lds, D, S, E); } \
        SEAM(pb + 0); \
        if (IN(pb + 1)) { s1_stage_mu(F, (l)); for (int gc = F.wg; gc < M / 64; gc += F.G) { mixc_unit(F, (l), gc); s1_chunk_prep(F, (l), gc); S1Pre pa, pb2; s1_issue(F, (l), gc, 0, pa); for (int h = 0; h < NH; h += 2) { s1_unit(F, (l), gc, h, pa, h + 1, pb2); s1_unit(F, (l), gc, h + 1, pb2, (h + 2 < NH) ? h + 2 : h + 1, pa); } LDS_BAR(); } } \
        SEAM(pb + 1); \
        if (IN(pb + 2)) { s2_phase(F, (l)); } \
        SEAM(pb + 2); \
        if (IN(pb + 3)) { s3_phase(F, (l)); } \
        SEAM(pb + 3); \
        if (IN(pb + 4)) { pg8::DenseSched S; S.init(M / 256, D / 256, F.G, F.wg); S.A = (const char*)MIX; S.Bt = (const char*)(ws + WS_WOUT) + (size_t)(l) * D * D * 2; S.tstep = (size_t)256 * D * 2; \
            if ((l) == 0) { pg8::EpiResid<true> E{(const void*)F.A->in[I_X], HB, D}; pg8::gemm_phase<pg8::EpiResid<true>, pg8::DenseSched, true, true>(F.lds, D, S, E); } \
            else { pg8::EpiResid<false> E{(const void*)HB, HB, D}; pg8::gemm_phase<pg8::EpiResid<false>, pg8::DenseSched, true, true>(F.lds, D, S, E); } } \
        SEAM(pb + 4); } while (0)
    LAYER_MIXER(0);
    {
        if (IN(6)) norm_rows_phase_b<false>(F, HB, F.A->in[I_N2G], HN);
        SEAM(6);
        if (IN(7)) { pg8::DenseSched S; S.init(M / 256, 2 * FF / 256, F.G, F.wg); S.A = (const char*)HN; S.Bt = (const char*)(ws + WS_WGU); S.tstep = (size_t)256 * D * 2;
            pg8::EpiSwiglu E{(bf16*)(ws + WS_HID), FF}; pg8::gemm_phase<pg8::EpiSwiglu, pg8::DenseSched, true, true>(F.lds, D, S, E); }
        SEAM(7);
        if (IN(8)) { pg8::DenseSched S; S.init(M / 256, D / 256, F.G, F.wg); S.A = (const char*)(ws + WS_HID); S.Bt = (const char*)(ws + WS_WDN); S.tstep = (size_t)256 * FF * 2;
            pg8::EpiResid<false> E{(const void*)HB, HB, D}; pg8::gemm_phase<pg8::EpiResid<false>, pg8::DenseSched, true, true>(F.lds, FF, S, E); }
        SEAM(8);
        if (IN(9)) norm_rows_phase_b<false>(F, HB, F.A->in[I_N1G] + D, HN);
        SEAM(9);
    }
    LAYER_MIXER(1);
    if (IN(15)) { norm2_router_phase(F, HB, F.A->in[I_N2G] + D, F.A->in[I_ROUTER]); moe_weight_convert<1>(F, F.wg * NWAVES + F.wave, F.G * NWAVES, (LAS float*)(F.lds + 32768 + F.wave * 9216)); }
    SEAM(15);
    if (IN(16)) moe_dispatch_phase(F);
    SEAM(16);
    {
        const int* rowtok = (const int*)(ws + TB_ROWTOK); const float* rowgate = (const float*)(ws + TB_ROWGATE); const int* tile_e = (const int*)(ws + TB_TILEE);
        if (IN(17)) { const int nt = __builtin_amdgcn_readfirstlane(((const int*)(ws + TB_NTILES))[0] + ((const int*)(ws + TB_NTILES))[1]);
            pg8::MoeGuSched S; S.init(nt, 2 * FE / 256, F.G, F.wg); S.A = (const char*)HN; S.Bt = (const char*)(ws + WS_WMGU); S.row_tok = rowtok; S.tile_e = tile_e;
            pg8::EpiSwigluF8 E{ws + WS_MHID, FE}; pg8::gemm_phase<pg8::EpiSwigluF8, pg8::MoeGuSched, true, true, true>(F.lds, D / 2, S, E); }
        SEAM(17);
#pragma unroll
        for (int s = 0; s < 2; ++s) {
            if (IN(18 + s)) { const int nt0 = __builtin_amdgcn_readfirstlane(((const int*)(ws + TB_NTILES))[0]), nt = s ? __builtin_amdgcn_readfirstlane(((const int*)(ws + TB_NTILES))[1]) : nt0, t0 = s ? nt0 : 0;
                const int* rt = rowtok + t0 * 256; const float* rg = rowgate + t0 * 256; const int* te = tile_e + t0; const char* hid = (const char*)(ws + WS_MHID) + (size_t)t0 * 256 * FE;
                { pg8::MoeDnSched S; S.init(nt, D / 256, F.G, F.wg); S.A = hid; S.Bt = (const char*)(ws + WS_WMDN); S.tile_e = te; S.tstep = (size_t)256 * FE;
                  pg8::EpiMoeDown E{HB, (s == 0) ? HB : HN, rt, rg, F8_DN_INV}; pg8::gemm_phase<pg8::EpiMoeDown, pg8::MoeDnSched, true, true, true>(F.lds, FE / 2, S, E); }
                { pg8::MoeDnLeftSched S; S.init(nt, D / 256, F.G, F.wg); S.A = hid; S.Bt = (const char*)(ws + WS_WMDN); S.tile_e = te; S.tstep = (size_t)256 * FE;
                  float* part = (float*)(ws + WS_PART); unsigned* cnt = (unsigned*)(ws + WS_CTL) + CW_LEFT + s * 32 * 64;
                  pg8::EpiPartTile E{part + (size_t)F.wg * 65536};
                  pg8::gemm_phase<pg8::EpiPartTile, pg8::MoeDnLeftSched, true, true, true>(F.lds, FE / 2, S, E, pg8::DN_KT);
                  moe_dn_combine(F.wg, nt, F.G, part, cnt, HB, (s == 0) ? HB : HN, rt, rg, F8_DN_INV); } }
            SEAM(18 + s);
        }
    }
    if (IN(20)) norm_rows_phase_b<true>(F, HN, F.A->in[I_FINALG], F.out);
#undef IN
#undef SEAM
}

extern "C" void kernel_launch(void* const* d_in, const int* in_sizes, int n_in, void* d_out, int out_size, void* d_ws, size_t ws_size, hipStream_t stream) {
    static int ready = 0;
    if (ready == 0) {
        if (n_in != 33 || out_size != M * D || ws_size < WS_NEED) { fprintf(stderr, "kernel_launch: unexpected shapes (n_in %d, out %d, ws %zu, need %zu)\n", n_in, out_size, ws_size, (size_t)WS_NEED); ready = -1; return; }
        if (hipFuncSetAttribute((const void*)fwd, hipFuncAttributeMaxDynamicSharedMemorySize, LDS_BYTES) != hipSuccess) { fprintf(stderr, "kernel_launch: hipFuncSetAttribute failed\n"); ready = -1; return; }
        int per_cu = 0; (void)hipOccupancyMaxActiveBlocksPerMultiprocessor(&per_cu, (const void*)fwd, NTHR, LDS_BYTES); (void)hipGetLastError();
        if (per_cu < 1) fprintf(stderr, "kernel_launch: occupancy query reports %d\n", per_cu);
        ready = 1;
    }
    if (ready < 0) return;
    (void)hipMemsetAsync((char*)d_ws + WS_CTL, 0, CTL_ZERO_BYTES, stream);
    Args a{};
    for (int i = 0; i < 33; ++i) a.in[i] = (const float*)d_in[i];
    a.out = (float*)d_out; a.ws = (unsigned char*)d_ws;
#if N_LAUNCH_MODE == 1
    a.ph_lo = 0; a.ph_hi = NPHASES;
    hipLaunchKernelGGL(fwd, dim3(GRID), dim3(NTHR), LDS_BYTES, stream, a);
#else
    for (int p = 0; p < NPHASES; ++p) { a.ph_lo = p; a.ph_hi = p + 1; const int reps = ((PROBE_PHASES >> p) & 1u) ? 2 : 1;
        for (int r = 0; r < reps; ++r) hipLaunchKernelGGL(fwd, dim3(GRID), dim3(NTHR), LDS_BYTES, stream, a); }
#endif
    (void)in_sizes;
}
```

```cpp
#include <hip/hip_runtime.h>
#include <cstdio>
#include <cstdint>

#define DI __device__ __forceinline__
#define LAS __attribute__((address_space(3)))
typedef unsigned short bf16;
typedef short bf16x8 __attribute__((ext_vector_type(8)));
typedef float f32x4 __attribute__((ext_vector_type(4)));
typedef float f32x2 __attribute__((ext_vector_type(2)));
typedef unsigned u32x4 __attribute__((ext_vector_type(4)));
typedef unsigned u32x2 __attribute__((ext_vector_type(2)));
typedef __bf16 bf2_t __attribute__((ext_vector_type(2)));

#ifndef PROBE_PHASES
#define PROBE_PHASES 0x0u
#endif
#ifndef N_LAUNCH_MODE
#define N_LAUNCH_MODE 1
#endif

constexpr int BATCH = 4, T = 8192, D = 1024, M = BATCH * T;
constexpr int NIN = 2560, RW = 512, NH = 8;
constexpr int C_CONVA = 256, C_CONVB = 512, C_R = 768, C_K = 1280, C_V = 1792, C_XW = 2304, C_XA = 2368, C_XG = 2432;
constexpr int NRC = 1792;
constexpr int FF = 2816, FE = 3584, NE = 8;
constexpr int MOE_ROWS = M + NE * 256;
constexpr int MOE_TILES = MOE_ROWS / 256;
constexpr float RMS_EPS = 1e-6f, LN_EPS = 1e-5f, GN_EPS = 64e-5f;
constexpr int NWAVES = 8, NTHR = 512, GRID = 256;

DI unsigned pk2(float lo, float hi) { f32x2 v = {lo, hi}; return __builtin_bit_cast(unsigned, __builtin_convertvector(v, bf2_t)); }
DI float bflo(unsigned u) { return __uint_as_float(u << 16); }
DI float bfhi(unsigned u) { return __uint_as_float(u & 0xffff0000u); }
DI float fast_exp(float x) { return __builtin_amdgcn_exp2f(x * 1.44269504088896f); }
DI float sigmoidf_(float x) { return __builtin_amdgcn_rcpf(1.0f + fast_exp(-x)); }
DI float siluf_(float x) { return x * sigmoidf_(x); }
template <int D> DI float row_shr(float x) { return __builtin_bit_cast(float, __builtin_amdgcn_update_dpp(0, __builtin_bit_cast(int, x), 0x110 + D, 0xf, 0xf, false)); }
DI float row_scan16(float x) { x += row_shr<1>(x); x += row_shr<2>(x); x += row_shr<4>(x); x += row_shr<8>(x); return x; }
DI float wave_sum(float v) {
    v = row_scan16(v);
    const int iv = __builtin_bit_cast(int, v);
    const float a = __builtin_bit_cast(float, __builtin_amdgcn_readlane(iv, 15)), b = __builtin_bit_cast(float, __builtin_amdgcn_readlane(iv, 31));
    const float c = __builtin_bit_cast(float, __builtin_amdgcn_readlane(iv, 47)), d = __builtin_bit_cast(float, __builtin_amdgcn_readlane(iv, 63));
    return (a + b) + (c + d);
}
DI void unpack8(const u32x4 w, float (&f)[8]) { f[0] = bflo(w.x); f[1] = bfhi(w.x); f[2] = bflo(w.y); f[3] = bfhi(w.y); f[4] = bflo(w.z); f[5] = bfhi(w.z); f[6] = bflo(w.w); f[7] = bfhi(w.w); }
DI u32x4 pack8(const float (&f)[8]) { u32x4 w; w.x = pk2(f[0], f[1]); w.y = pk2(f[2], f[3]); w.z = pk2(f[4], f[5]); w.w = pk2(f[6], f[7]); return w; }
#define MFMA16(a, b, c) __builtin_amdgcn_mfma_f32_16x16x32_bf16((a), (b), (c), 0, 0, 0)
typedef int i32x8 __attribute__((ext_vector_type(8)));
typedef int i32x4 __attribute__((ext_vector_type(4)));
constexpr float F8S_X = 4.f, F8S_WGU = 64.f, F8S_H = 8.f, F8S_WDN = 128.f;
constexpr float F8_GU_INV = 1.f / (F8S_X * F8S_WGU), F8_DN_INV = 1.f / (F8S_H * F8S_WDN);
DI float f8clamp(float x) { return __builtin_amdgcn_fmed3f(x, -448.f, 448.f); }
DI unsigned pk4_f8(float a, float b, float c, float d) { int p = __builtin_amdgcn_cvt_pk_fp8_f32(f8clamp(a), f8clamp(b), 0, false); p = __builtin_amdgcn_cvt_pk_fp8_f32(f8clamp(c), f8clamp(d), p, true); return (unsigned)p; }
DI i32x8 cat8(const bf16x8 a, const bf16x8 b) { return __builtin_shufflevector(__builtin_bit_cast(i32x4, a), __builtin_bit_cast(i32x4, b), 0, 1, 2, 3, 4, 5, 6, 7); }

namespace pg8 {
constexpr int BM = 256, BK = 64, HALF = 128, HTB = HALF * BK * 2, STAGE_BYTES = 8 * HTB, NXCD = 8, WGM = 8;
DI int lds_byte(int r, int c) { const int st = (r >> 4) * 2 + (c >> 5), rr = r & 15, cc = c & 31, ob = rr * 64 + cc * 2; return st * 1024 + (ob ^ (((ob >> 9) & 1) << 5)); }
DI void stage_rc(int b, int& R, int& C) { const int st = b / 1024, sb = b % 1024, swz = sb ^ (((sb >> 9) & 1) << 5); R = (st >> 1) * 16 + swz / 64; C = (st & 1) * 32 + (swz % 64) / 2; }
DI int perm32(int rho) { const int n = rho >> 4, i = rho & 15; return 8 * (i >> 2) + 4 * n + (i & 3); }
struct Unit { int pm, pn; };
struct OrderBase {
    int nM, nN, nwg, G, c, wgm;
    DI void init(int nM_, int nN_, int G_, int c_) { nM = nM_; nN = nN_; nwg = nM * nN; G = G_; c = c_; wgm = WGM; }
    DI void map(const long L, Unit& u) const {
        int wgid = (int)L; { const int q = nwg / NXCD, r = nwg % NXCD, xcd = wgid % NXCD, off = wgid / NXCD; wgid = (xcd < r ? xcd * (q + 1) : r * (q + 1) + (xcd - r) * q) + off; }
        const int nig = wgm * nN, gid = wgid / nig, fm = gid * wgm, gsz = (nM - fm) < wgm ? (nM - fm) : wgm;
        u.pm = fm + ((wgid % nig) % gsz); u.pn = (wgid % nig) / gsz;
    }
    DI bool next(int i, Unit& u) const { const long L = (long)i * G + c; if (L >= nwg) return false; map(L, u); return true; }
};
struct DenseSched : OrderBase {
    static constexpr bool GATHER = false;
    const char* A; const char* Bt; size_t tstep;
    DI const char* a_base(const Unit& u) const { return A + (size_t)u.pm * tstep; }
    DI const char* b_base(const Unit& u) const { return Bt + (size_t)u.pn * tstep; }
    DI void a_offs(const Unit&, const int (&)[2], const int (&)[2], unsigned (&)[2][2]) const {}
};
struct MoeGuSched : OrderBase {
    static constexpr bool GATHER = true;
    const char* A; const char* Bt; const int* row_tok; const int* tile_e;
    DI const char* a_base(const Unit&) const { return A; }
    DI const char* b_base(const Unit& u) const { const int e = __builtin_amdgcn_readfirstlane(tile_e[u.pm]); return Bt + ((size_t)e * (2 * FE) + (size_t)u.pn * 256) * (size_t)D; }
    DI void a_offs(const Unit& u, const int (&R)[2], const int (&C)[2], unsigned (&o)[2][2]) const {
#pragma unroll
        for (int h = 0; h < 2; ++h)
#pragma unroll
            for (int i = 0; i < 2; ++i) { int tok = row_tok[u.pm * 256 + h * 128 + R[i]]; tok = tok < 0 ? M : tok; o[h][i] = (unsigned)tok * (unsigned)D + (unsigned)(C[i] * 2); }
    }
};
struct MoeDnSched : OrderBase {
    static constexpr bool GATHER = false;
    const char* A; const char* Bt; const int* tile_e; size_t tstep;
    DI bool next(int i, Unit& u) const { if (i >= nwg / G) return false; map((long)i * G + c, u); return true; }
    DI const char* a_base(const Unit& u) const { return A + (size_t)u.pm * tstep; }
    DI const char* b_base(const Unit& u) const { const int e = __builtin_amdgcn_readfirstlane(tile_e[u.pm]); return Bt + ((size_t)e * D + (size_t)u.pn * 256) * (size_t)FE; }
    DI void a_offs(const Unit&, const int (&)[2], const int (&)[2], unsigned (&)[2][2]) const {}
};
constexpr int DN_KSPLIT = 7, DN_KT = FE / 128 / DN_KSPLIT;
struct MoeDnLeftSched : OrderBase {
    static constexpr bool GATHER = false;
    const char* A; const char* Bt; const int* tile_e; size_t tstep;
    DI bool next(int i, Unit& u) const { const int main = (nwg / G) * G, left = nwg - main; if (i > 0 || c >= DN_KSPLIT * left) return false; map((long)main + (c / DN_KSPLIT), u); return true; }
    DI const char* a_base(const Unit& u) const { return A + (size_t)u.pm * tstep + (size_t)(c % DN_KSPLIT) * (DN_KT * 128); }
    DI const char* b_base(const Unit& u) const { const int e = __builtin_amdgcn_readfirstlane(tile_e[u.pm]); return Bt + ((size_t)e * D + (size_t)u.pn * 256) * (size_t)FE + (size_t)(c % DN_KSPLIT) * (DN_KT * 128); }
    DI void a_offs(const Unit&, const int (&)[2], const int (&)[2], unsigned (&)[2][2]) const {}
};

struct EpiBf16 {
    static constexpr bool PERM = true;
    bf16* O; int ldc;
    DI void operator()(const f32x4 (&acc)[2][2][4][2], const Unit& u, int wr, int wc, int fr, int fq) const {
        const int row0 = u.pm * BM + wr * 64 + fr, col0 = u.pn * BM + wc * 32 + 8 * fq;
#pragma unroll
        for (int ai = 0; ai < 2; ++ai)
#pragma unroll
            for (int m = 0; m < 4; ++m) { bf16* rowp = O + (size_t)(row0 + ai * HALF + m * 16) * ldc + col0;
#pragma unroll
                for (int bj = 0; bj < 2; ++bj) { const f32x4 v0 = acc[ai][bj][m][0], v1 = acc[ai][bj][m][1];
                    u32x4 w; w.x = pk2(v0[0], v0[1]); w.y = pk2(v0[2], v0[3]); w.z = pk2(v1[0], v1[1]); w.w = pk2(v1[2], v1[3]);
                    *(u32x4*)(rowp + bj * HALF) = w; } }
    }
};
struct EpiSwiglu {
    static constexpr bool PERM = true;
    bf16* O; int ldc;
    DI void operator()(const f32x4 (&acc)[2][2][4][2], const Unit& u, int wr, int wc, int fr, int fq) const {
        const int row0 = u.pm * BM + wr * 64 + fr, col0 = u.pn * HALF + wc * 32 + 8 * fq;
#pragma unroll
        for (int ai = 0; ai < 2; ++ai)
#pragma unroll
            for (int m = 0; m < 4; ++m) { bf16* rowp = O + (size_t)(row0 + ai * HALF + m * 16) * ldc + col0;
                float h[8];
#pragma unroll
                for (int n = 0; n < 2; ++n)
#pragma unroll
                    for (int j = 0; j < 4; ++j) { const float g = acc[ai][0][m][n][j], up = acc[ai][1][m][n][j]; h[n * 4 + j] = siluf_(g) * up; }
                *(u32x4*)rowp = pack8(h); }
    }
};
struct EpiSwigluF8 {
    static constexpr bool PERM = true;
    unsigned char* O; int ldc;
    DI void operator()(const f32x4 (&acc)[2][2][4][2], const Unit& u, int wr, int wc, int fr, int fq) const {
        const int row0 = u.pm * BM + wr * 64 + fr, col0 = u.pn * HALF + wc * 32 + 8 * fq;
#pragma unroll
        for (int ai = 0; ai < 2; ++ai)
#pragma unroll
            for (int m = 0; m < 4; ++m) { unsigned char* rowp = O + (size_t)(row0 + ai * HALF + m * 16) * ldc + col0;
                float h[8];
#pragma unroll
                for (int n = 0; n < 2; ++n)
#pragma unroll
                    for (int j = 0; j < 4; ++j) { const float ag = acc[ai][0][m][n][j], au = acc[ai][1][m][n][j];
                        constexpr float KK = 1.f / (F8S_H * F8_GU_INV * F8_GU_INV), LK = 13.f; static_assert(KK == 8192.f, "log2 of K");
                        h[n * 4 + j] = (ag * au) * __builtin_amdgcn_rcpf(KK + __builtin_amdgcn_exp2f(__builtin_fmaf(ag, -1.44269504088896f * F8_GU_INV, LK))); }
                u32x2 w; w.x = pk4_f8(h[0], h[1], h[2], h[3]); w.y = pk4_f8(h[4], h[5], h[6], h[7]);
                *(u32x2*)rowp = w; }
    }
};
template <bool BASE_F32> struct EpiResid {
    static constexpr bool PERM = true;
    const void* base; bf16* out; int ldc;
    DI void operator()(const f32x4 (&acc)[2][2][4][2], const Unit& u, int wr, int wc, int fr, int fq) const {
        const int row0 = u.pm * BM + wr * 64 + fr, col0 = u.pn * BM + wc * 32 + 8 * fq;
        u32x4 bball[BASE_F32 ? 1 : 2][4][2];
        if constexpr (!BASE_F32) {
#pragma unroll
            for (int ai = 0; ai < 2; ++ai)
#pragma unroll
                for (int m = 0; m < 4; ++m)
#pragma unroll
                    for (int bj = 0; bj < 2; ++bj) bball[ai][m][bj] = *(const u32x4*)((const bf16*)base + (size_t)(row0 + ai * HALF + m * 16) * ldc + col0 + bj * HALF);
            asm volatile("" ::: "memory");
        }
#pragma unroll
        for (int ai = 0; ai < 2; ++ai) {
            f32x4 bf[BASE_F32 ? 4 : 1][2][2]; u32x4 bb[4][2];
#pragma unroll
            for (int m = 0; m < 4; ++m) { const size_t off = (size_t)(row0 + ai * HALF + m * 16) * ldc + col0;
#pragma unroll
                for (int bj = 0; bj < 2; ++bj) { if (BASE_F32) { bf[BASE_F32 ? m : 0][bj][0] = *(const f32x4*)((const float*)base + off + bj * HALF); bf[BASE_F32 ? m : 0][bj][1] = *(const f32x4*)((const float*)base + off + bj * HALF + 4); }
                                                 else bb[m][bj] = bball[BASE_F32 ? 0 : ai][m][bj]; } }
            asm volatile("" ::: "memory");
#pragma unroll
            for (int m = 0; m < 4; ++m) { const size_t off = (size_t)(row0 + ai * HALF + m * 16) * ldc + col0;
#pragma unroll
                for (int bj = 0; bj < 2; ++bj) { float h[8];
                    if (BASE_F32) {
#pragma unroll
                        for (int j = 0; j < 4; ++j) { h[j] = bf[BASE_F32 ? m : 0][bj][0][j]; h[4 + j] = bf[BASE_F32 ? m : 0][bj][1][j]; } }
                    else unpack8(bb[m][bj], h);
#pragma unroll
                    for (int j = 0; j < 4; ++j) { h[j] += acc[ai][bj][m][0][j]; h[4 + j] += acc[ai][bj][m][1][j]; }
                    *(u32x4*)(out + off + bj * HALF) = pack8(h); } }
            asm volatile("" ::: "memory");
        }
    }
};
struct EpiMoeDown {
    static constexpr bool PERM = true;
    const bf16* hin; bf16* hout; const int* row_tok; const float* row_gate; float sc;
    DI void operator()(const f32x4 (&acc)[2][2][4][2], const Unit& u, int wr, int wc, int fr, int fq) const {
        const int row0 = u.pm * BM + wr * 64 + fr, col0 = u.pn * BM + wc * 32 + 8 * fq;
        int tok[2][4]; float g[2][4];
#pragma unroll
        for (int ai = 0; ai < 2; ++ai)
#pragma unroll
            for (int m = 0; m < 4; ++m) { const int r = row0 + ai * HALF + m * 16; tok[ai][m] = row_tok[r]; g[ai][m] = row_gate[r] * sc; }
        u32x4 bball[2][4][2];
#pragma unroll
        for (int ai = 0; ai < 2; ++ai)
#pragma unroll
            for (int m = 0; m < 4; ++m) { const int tk = tok[ai][m]; const bf16* hp = hin + (size_t)(tk < 0 ? 0 : tk) * D + col0;
#pragma unroll
                for (int bj = 0; bj < 2; ++bj) bball[ai][m][bj] = *(const u32x4*)(hp + bj * HALF); }
        asm volatile("" ::: "memory");
#pragma unroll
        for (int ai = 0; ai < 2; ++ai) {
            u32x4 bb[4][2];
#pragma unroll
            for (int m = 0; m < 4; ++m)
#pragma unroll
                for (int bj = 0; bj < 2; ++bj) bb[m][bj] = bball[ai][m][bj];
#pragma unroll
            for (int m = 0; m < 4; ++m) { const int tk = tok[ai][m]; if (tk >= 0) { bf16* hp = hout + (size_t)tk * D + col0; const float gg = g[ai][m];
#pragma unroll
                for (int bj = 0; bj < 2; ++bj) { float h[8]; unpack8(bb[m][bj], h);
#pragma unroll
                    for (int j = 0; j < 4; ++j) { h[j] += acc[ai][bj][m][0][j] * gg; h[4 + j] += acc[ai][bj][m][1][j] * gg; }
                    *(u32x4*)(hp + bj * HALF) = pack8(h); } } }
            asm volatile("" ::: "memory");
        }
    }
};

struct EpiPartTile {
    static constexpr bool PERM = true;
    float* slab;
    DI void operator()(const f32x4 (&acc)[2][2][4][2], const Unit&, int wr, int wc, int fr, int fq) const {
        float* base = slab + (size_t)(wr * 64 + fr) * 256 + wc * 32 + 8 * fq;
#pragma unroll
        for (int ai = 0; ai < 2; ++ai)
#pragma unroll
            for (int m = 0; m < 4; ++m)
#pragma unroll
                for (int bj = 0; bj < 2; ++bj) { float* p = base + (size_t)(ai * HALF + m * 16) * 256 + bj * HALF; *(f32x4*)p = acc[ai][bj][m][0]; *(f32x4*)(p + 4) = acc[ai][bj][m][1]; }
    }
};

template <class Epi, class Sched, bool ALIGN_EPI, bool SP2, bool F8 = false>
DI void gemm_phase(LAS unsigned char* lds, const int K, const Sched& S, const Epi& E, const int ktiles = 0) {
    const int tid = threadIdx.x, wid = __builtin_amdgcn_readfirstlane(tid >> 6), lane = tid & 63, wr = wid >> 2, wc = wid & 3, fr = lane & 15, fq = lane >> 4;
    const int nt = ktiles ? ktiles : K / BK;
    unsigned voffA[2], voffB[2]; int RA[2], CA[2];
#pragma unroll
    for (int i = 0; i < 2; ++i) { int R, C; stage_rc(tid * 16 + i * 8192, R, C); const int Rb = Epi::PERM ? ((R & ~31) + perm32(R & 31)) : R;
        RA[i] = R; CA[i] = C; voffA[i] = (unsigned)(R * K + C) * 2u; voffB[i] = (unsigned)(Rb * K + C) * 2u; }
    unsigned gc[2][2] = {{0u, 0u}, {0u, 0u}}, gn[2][2] = {{0u, 0u}, {0u, 0u}};
    const size_t kstep = (size_t)(BK * 2);
    const size_t hstep = (size_t)HALF * K * 2;
    const unsigned ldsw = (unsigned)wid * 1024u;
    const int aoff = lds_byte(wr * 64 + fr, fq * 8), boff = lds_byte(wc * 32 + fr, fq * 8);
#define PG8_SA(b, h) (((b) * 2 + (h)) * HTB)
#define PG8_SB(b, h) ((4 + (b) * 2 + (h)) * HTB)
#define PG8_STAGE(bufoff, gbase, voff) do { _Pragma("unroll") for (int _i = 0; _i < 2; ++_i) \
        __builtin_amdgcn_global_load_lds((const unsigned*)((const char*)(gbase) + (voff)[_i]), (LAS unsigned*)(lds + (bufoff) + ldsw + _i * 8192), 16, 0, 0); } while (0)
#define PG8_STAGE_A(bufoff, kbase, h, go) do { if constexpr (Sched::GATHER) { PG8_STAGE(bufoff, kbase, (go)[h]); } else { PG8_STAGE(bufoff, (kbase) + (h) * hstep, voffA); } } while (0)
#define PG8_LDA(dst, b, h) do { _Pragma("unroll") for (int m = 0; m < 4; ++m) { if constexpr (F8) dst##8[m] = __builtin_shufflevector(*(const LAS i32x4*)(lds + PG8_SA(b, h) + aoff + m * 2048), *(const LAS i32x4*)(lds + PG8_SA(b, h) + aoff + m * 2048 + 1024), 0, 1, 2, 3, 4, 5, 6, 7); \
        else { _Pragma("unroll") for (int k = 0; k < 2; ++k) dst[m][k] = *(const LAS bf16x8*)(lds + PG8_SA(b, h) + aoff + m * 2048 + k * 1024); } } } while (0)
#define PG8_LDB(dst, b, h) do { _Pragma("unroll") for (int n = 0; n < 2; ++n) { if constexpr (F8) dst##8[n] = __builtin_shufflevector(*(const LAS i32x4*)(lds + PG8_SB(b, h) + boff + n * 2048), *(const LAS i32x4*)(lds + PG8_SB(b, h) + boff + n * 2048 + 1024), 0, 1, 2, 3, 4, 5, 6, 7); \
        else { _Pragma("unroll") for (int k = 0; k < 2; ++k) dst[n][k] = *(const LAS bf16x8*)(lds + PG8_SB(b, h) + boff + n * 2048 + k * 1024); } } } while (0)
#define PG8_MMA(ai, bj, At, Bt) do { __builtin_amdgcn_s_setprio(1); _Pragma("unroll") for (int m = 0; m < 4; ++m) _Pragma("unroll") for (int n = 0; n < 2; ++n) { \
        if constexpr (F8) asm volatile("v_mfma_f32_16x16x128_f8f6f4 %0, %1, %2, %0" : "+v"(acc[ai][bj][m][n]) : "v"(Bt##8[n]), "v"(At##8[m])); \
        else { _Pragma("unroll") for (int k = 0; k < 2; ++k) acc[ai][bj][m][n] = __builtin_amdgcn_mfma_f32_16x16x32_bf16(Bt[n][k], At[m][k], acc[ai][bj][m][n], 0, 0, 0); } } __builtin_amdgcn_s_setprio(0); } while (0)
#define PG8_WAIT_V(n) asm volatile("s_waitcnt vmcnt(" #n ")" ::: "memory")
#define PG8_WAIT_L(n) asm volatile("s_waitcnt lgkmcnt(" #n ")" ::: "memory")
#define PG8_BAR __builtin_amdgcn_s_barrier()
#define PG8_SCHED __builtin_amdgcn_sched_barrier(0)
    Unit cur, nxt; int ui = 0;
    if (!S.next(0, cur)) return;
    f32x4 acc[2][2][4][2];
#pragma unroll
    for (int a = 0; a < 2; ++a)
#pragma unroll
        for (int b = 0; b < 2; ++b)
#pragma unroll
            for (int m = 0; m < 4; ++m)
#pragma unroll
                for (int n = 0; n < 2; ++n) acc[a][b][m][n] = (f32x4){0.f, 0.f, 0.f, 0.f};
    bf16x8 At[4][2], B0[2][2], B1[2][2];
    i32x8 At8[4], B08[2], B18[2];
    const char* cA = S.a_base(cur); const char* cB = S.b_base(cur);
    if constexpr (Sched::GATHER) { S.a_offs(cur, RA, CA, gc); asm volatile("" : "+v"(gc[0][0]), "+v"(gc[0][1]), "+v"(gc[1][0]), "+v"(gc[1][1])); }
    if constexpr (SP2) {
        PG8_STAGE(PG8_SB(0, 0), cB, voffB); PG8_STAGE(PG8_SB(0, 1), cB + hstep, voffB); PG8_STAGE_A(PG8_SA(0, 0), cA, 0, gc); PG8_STAGE_A(PG8_SA(0, 1), cA, 1, gc);
        if (wr == 1) PG8_BAR;
        PG8_WAIT_V(2); PG8_BAR;
        PG8_STAGE(PG8_SB(1, 0), cB + kstep, voffB); PG8_STAGE_A(PG8_SA(1, 0), cA + kstep, 0, gc); PG8_STAGE(PG8_SB(1, 1), cB + hstep + kstep, voffB);
        PG8_WAIT_V(6); PG8_BAR;
    } else {
        PG8_STAGE(PG8_SB(0, 0), cB, voffB); PG8_STAGE_A(PG8_SA(0, 0), cA, 0, gc); PG8_STAGE(PG8_SB(0, 1), cB + hstep, voffB); PG8_STAGE_A(PG8_SA(0, 1), cA, 1, gc);
        if (wr == 1) PG8_BAR;
        PG8_WAIT_V(4); PG8_BAR;
        PG8_STAGE(PG8_SB(1, 0), cB + kstep, voffB); PG8_STAGE_A(PG8_SA(1, 0), cA + kstep, 0, gc); PG8_STAGE(PG8_SB(1, 1), cB + hstep + kstep, voffB);
        PG8_WAIT_V(6); PG8_BAR;
    }
    for (;;) {
        const bool has_next = S.next(ui + 1, nxt);
        const char* nA = has_next ? S.a_base(nxt) : cA; const char* nB = has_next ? S.b_base(nxt) : cB;
        if constexpr (Sched::GATHER) {
            if (has_next) { S.a_offs(nxt, RA, CA, gn); asm volatile("" : "+v"(gn[0][0]), "+v"(gn[0][1]), "+v"(gn[1][0]), "+v"(gn[1][1])); }
            else { gn[0][0] = gc[0][0]; gn[0][1] = gc[0][1]; gn[1][0] = gc[1][0]; gn[1][1] = gc[1][1]; }
        }
#pragma unroll 1
        for (int t = 0; t < nt; t += 2) {
            const bool last = (t == nt - 2);
            const char* a1 = cA + (size_t)(t + 1) * kstep;
            const char* a2 = last ? nA : cA + (size_t)(t + 2) * kstep; const char* b2 = last ? nB : cB + (size_t)(t + 2) * kstep;
            const char* a3 = a2 + kstep; const char* b3 = b2 + kstep;
            unsigned g2[2][2];
            if constexpr (Sched::GATHER) {
#pragma unroll
                for (int h = 0; h < 2; ++h)
#pragma unroll
                    for (int i = 0; i < 2; ++i) g2[h][i] = last ? gn[h][i] : gc[h][i];
            }
            if constexpr (SP2) {
            PG8_LDB(B0, 0, 0); PG8_LDB(B1, 0, 1); PG8_SCHED; PG8_LDA(At, 0, 0); PG8_STAGE_A(PG8_SA(1, 1), a1, 1, gc);
            PG8_WAIT_V(8); PG8_WAIT_L(0); PG8_BAR; PG8_MMA(0, 0, At, B0); PG8_MMA(0, 1, At, B1); PG8_BAR; PG8_SCHED;
            PG8_LDA(At, 0, 1); PG8_STAGE(PG8_SB(0, 0), b2, voffB); PG8_STAGE(PG8_SB(0, 1), b2 + hstep, voffB); PG8_STAGE_A(PG8_SA(0, 0), a2, 0, g2);
            PG8_WAIT_V(8); PG8_WAIT_L(0); PG8_BAR; PG8_MMA(1, 0, At, B0); PG8_MMA(1, 1, At, B1); PG8_BAR; PG8_SCHED;
            PG8_LDB(B0, 1, 0); PG8_LDB(B1, 1, 1); PG8_SCHED; PG8_LDA(At, 1, 0); PG8_STAGE_A(PG8_SA(0, 1), a2, 1, g2);
            PG8_WAIT_V(8); PG8_WAIT_L(0); PG8_BAR; PG8_MMA(0, 0, At, B0); PG8_MMA(0, 1, At, B1); PG8_BAR; PG8_SCHED;
            PG8_LDA(At, 1, 1); PG8_STAGE(PG8_SB(1, 0), b3, voffB); PG8_STAGE(PG8_SB(1, 1), b3 + hstep, voffB); PG8_STAGE_A(PG8_SA(1, 0), a3, 0, g2);
            PG8_WAIT_V(8); PG8_WAIT_L(0); PG8_BAR; PG8_MMA(1, 0, At, B0); PG8_MMA(1, 1, At, B1); PG8_BAR; PG8_SCHED;
            } else {
            PG8_LDB(B0, 0, 0); PG8_SCHED; PG8_LDA(At, 0, 0); PG8_STAGE_A(PG8_SA(1, 1), a1, 1, gc);
            PG8_WAIT_L(8); PG8_BAR; PG8_WAIT_L(0); PG8_MMA(0, 0, At, B0); PG8_BAR; PG8_SCHED;
            PG8_LDB(B1, 0, 1); PG8_STAGE(PG8_SB(0, 0), b2, voffB);
            PG8_BAR; PG8_WAIT_L(0); PG8_MMA(0, 1, At, B1); PG8_BAR;
            PG8_LDA(At, 0, 1); PG8_STAGE_A(PG8_SA(0, 0), a2, 0, g2);
            PG8_BAR; PG8_WAIT_L(0); PG8_MMA(1, 0, At, B0); PG8_BAR; PG8_SCHED;
            PG8_STAGE(PG8_SB(0, 1), b2 + hstep, voffB);
            PG8_WAIT_V(6); PG8_BAR; PG8_MMA(1, 1, At, B1); PG8_BAR;
            PG8_LDB(B0, 1, 0); PG8_SCHED; PG8_LDA(At, 1, 0); PG8_STAGE_A(PG8_SA(0, 1), a2, 1, g2);
            PG8_WAIT_L(8); PG8_BAR; PG8_WAIT_L(0); PG8_MMA(0, 0, At, B0); PG8_BAR; PG8_SCHED;
            PG8_LDB(B1, 1, 1); PG8_STAGE(PG8_SB(1, 0), b3, voffB);
            PG8_BAR; PG8_WAIT_L(0); PG8_MMA(0, 1, At, B1); PG8_BAR;
            PG8_LDA(At, 1, 1); PG8_STAGE_A(PG8_SA(1, 0), a3, 0, g2);
            PG8_BAR; PG8_WAIT_L(0); PG8_MMA(1, 0, At, B0); PG8_BAR; PG8_SCHED;
            PG8_STAGE(PG8_SB(1, 1), b3 + hstep, voffB);
            PG8_WAIT_V(6); PG8_BAR; PG8_MMA(1, 1, At, B1); PG8_BAR;
            }
        }
        if constexpr (ALIGN_EPI) { if (wr == 0) PG8_BAR; }
        if constexpr (F8) {
            asm volatile("s_nop 15\n\ts_nop 15" : "+v"(acc[0][0][0][0]), "+v"(acc[0][0][0][1]), "+v"(acc[0][0][1][0]), "+v"(acc[0][0][1][1]), "+v"(acc[0][0][2][0]), "+v"(acc[0][0][2][1]), "+v"(acc[0][0][3][0]), "+v"(acc[0][0][3][1]) :: "memory");
            asm volatile("" : "+v"(acc[0][1][0][0]), "+v"(acc[0][1][0][1]), "+v"(acc[0][1][1][0]), "+v"(acc[0][1][1][1]), "+v"(acc[0][1][2][0]), "+v"(acc[0][1][2][1]), "+v"(acc[0][1][3][0]), "+v"(acc[0][1][3][1]));
            asm volatile("" : "+v"(acc[1][0][0][0]), "+v"(acc[1][0][0][1]), "+v"(acc[1][0][1][0]), "+v"(acc[1][0][1][1]), "+v"(acc[1][0][2][0]), "+v"(acc[1][0][2][1]), "+v"(acc[1][0][3][0]), "+v"(acc[1][0][3][1]));
            asm volatile("" : "+v"(acc[1][1][0][0]), "+v"(acc[1][1][0][1]), "+v"(acc[1][1][1][0]), "+v"(acc[1][1][1][1]), "+v"(acc[1][1][2][0]), "+v"(acc[1][1][2][1]), "+v"(acc[1][1][3][0]), "+v"(acc[1][1][3][1]));
        }
        E(acc, cur, wr, wc, fr, fq);
        if (!has_next) break;
#pragma unroll
        for (int a = 0; a < 2; ++a)
#pragma unroll
            for (int b = 0; b < 2; ++b)
#pragma unroll
                for (int m = 0; m < 4; ++m)
#pragma unroll
                    for (int n = 0; n < 2; ++n) acc[a][b][m][n] = (f32x4){0.f, 0.f, 0.f, 0.f};
        cur = nxt; cA = nA; cB = nB; ++ui;
        if constexpr (Sched::GATHER) { gc[0][0] = gn[0][0]; gc[0][1] = gn[0][1]; gc[1][0] = gn[1][0]; gc[1][1] = gn[1][1]; }
        if constexpr (ALIGN_EPI) { if (wr == 1) PG8_BAR; }
    }
    PG8_WAIT_V(0);
    if constexpr (!ALIGN_EPI) { if (wr == 0) PG8_BAR; }
    PG8_BAR;
#undef PG8_SA
#undef PG8_SB
#undef PG8_STAGE
#undef PG8_STAGE_A
#undef PG8_LDA
#undef PG8_LDB
#undef PG8_MMA
#undef PG8_WAIT_V
#undef PG8_WAIT_L
#undef PG8_BAR
#undef PG8_SCHED
}
}

constexpr size_t MiB = 1u << 20;
constexpr size_t WS_CTL = 0, CTL_ZERO_BYTES = 64 * 1024;
constexpr size_t WS_SMALL = 1 * MiB;
constexpr size_t SM_POOLT = WS_SMALL;
constexpr size_t SM_W2T = SM_POOLT + 2 * 4 * 64 * 64 * 2;
constexpr size_t SM_A2T = SM_W2T + 2 * 512 * 64 * 2;
constexpr size_t SM_G2T = SM_A2T + 2 * 512 * 64 * 2;
constexpr size_t SM_V1T = SM_G2T + 2 * 512 * 128 * 2;
constexpr size_t SM_V2T = SM_V1T + 32 * 512 * 2;
constexpr size_t SM_END = SM_V2T + 512 * 32 * 2;
constexpr size_t TB_TKE = 2 * MiB;
constexpr size_t TB_TKG = TB_TKE + 2 * M * 4;
constexpr size_t TB_CNT = TB_TKG + 2 * M * 4;
constexpr size_t TB_ROWTOK = TB_CNT + 256 * 16 * 4;
constexpr size_t TB_ROWGATE = TB_ROWTOK + 2 * MOE_ROWS * 4;
constexpr size_t TB_TILEE = TB_ROWGATE + 2 * MOE_ROWS * 4;
constexpr size_t TB_NTILES = TB_TILEE + 2 * MOE_TILES * 4;
constexpr size_t TB_END = TB_NTILES + 64;
static_assert(SM_END <= TB_TKE && TB_END <= 4 * MiB, "small region");
constexpr size_t WS_WIN = 4 * MiB;
constexpr size_t WS_WOUT = WS_WIN + (size_t)2 * NIN * D * 2;
constexpr size_t WS_WGU = WS_WOUT + (size_t)2 * D * D * 2;
constexpr size_t WS_WDN = WS_WGU + (size_t)2 * FF * D * 2;
constexpr size_t WS_WEND = WS_WDN + (size_t)D * FF * 2;
static_assert(WS_WEND <= 36 * MiB, "main weights");
constexpr size_t WS_HN = 36 * MiB;
constexpr size_t WS_MIX = 101 * MiB;
constexpr size_t WS_VF = 165 * MiB;
constexpr size_t WS_VV1 = 197 * MiB;
constexpr size_t WS_PROJ = 204 * MiB;
constexpr size_t WS_ZB = 364 * MiB, WS_Y0B = 396 * MiB, WS_PTB = 428 * MiB, WS_QB = 460 * MiB;
constexpr size_t WS_SB = 492 * MiB;
constexpr size_t WS_RKB = 524 * MiB;
constexpr size_t WS_GB = 36 * MiB;
constexpr size_t WS_VMB = 68 * MiB;
constexpr size_t WS_HID = 204 * MiB;
constexpr size_t WS_WMGU = 165 * MiB;
constexpr size_t WS_WMDN = 101 * MiB;
constexpr size_t WS_MHID = 277 * MiB;
constexpr size_t WS_PART = 221 * MiB;
constexpr size_t WS_NEED = 526 * MiB;
static_assert(WS_WMGU + (size_t)NE * 2 * FE * D <= WS_PART && WS_PART + (size_t)32 * 7 * 65536 * 4 <= WS_MHID && WS_WMDN + (size_t)NE * D * FE <= 165 * MiB && WS_MHID + (size_t)2 * MOE_ROWS * FE <= 526 * MiB && WS_RKB + (size_t)M * 8 * 4 <= 526 * MiB, "moe map");
static_assert(WS_HN + (size_t)(M + 1) * D * 2 <= WS_MIX && WS_PROJ + (size_t)M * NIN * 2 <= 364 * MiB && WS_HID + (size_t)M * FF * 2 <= 526 * MiB, "map");
constexpr int CW_LEFT = 8192;
constexpr int CW_BAR = 1024;

constexpr int LDS_BYTES = 163840 - 1024;
constexpr int MISC_OFF = LDS_BYTES - 256;

#define XB_TMO      128
#define XB_XCNT(j)  (256  + 64 * (j))
#define XB_XSUB(j)  (1280 + 64 * (j))
#define XB_XGEN(j)  (2304 + 64 * (j))
#define XB_TOP      3328
#define XB_TOPGEN   3392
#define XCD_BAR_WORDS 3456
#define XB_SPIN_CAP (1u << 22)
DI unsigned xb_ld(unsigned* p)              { return __hip_atomic_load(p, __ATOMIC_RELAXED, __HIP_MEMORY_SCOPE_AGENT); }
DI unsigned xb_add(unsigned* p, unsigned v) { return __hip_atomic_fetch_add(p, v, __ATOMIC_RELAXED, __HIP_MEMORY_SCOPE_AGENT); }
DI unsigned xb_xcc_id() { return (unsigned)__builtin_amdgcn_s_getreg((3 << 11) | 20) & 0xFu; }
#define XB_SPIN(cond, bar) do { unsigned _sp = 0; while (cond) { __builtin_amdgcn_s_sleep(1); \
    if ((++_sp & 255u) == 0u) { if (xb_ld(&(bar)[XB_TMO])) break; if (_sp > XB_SPIN_CAP) { atomicAdd(&(bar)[XB_TMO], 1u); break; } } } } while (0)
struct XcdBarrier { unsigned* bar; unsigned x; volatile LAS unsigned* st; };
DI XcdBarrier xcd_barrier_post(unsigned* bar, volatile LAS unsigned* st) {
    XcdBarrier b; b.bar = bar; b.x = xb_xcc_id(); b.st = st;
    if (threadIdx.x == 0) (void)xb_add(&bar[XB_XCNT(b.x)], 1u);
    return b;
}
DI void xcd_barrier_complete(unsigned* bar, unsigned x, unsigned& nloc, unsigned& nx) {
    const unsigned G = gridDim.x * gridDim.y * gridDim.z;
    unsigned sum, cnt, mine, sp = 0u;
    for (;;) {
        sum = 0u; cnt = 0u; mine = 0u;
#pragma unroll
        for (unsigned j = 0; j < 16; ++j) { const unsigned c = xb_ld(&bar[XB_XCNT(j)]); sum += c; cnt += (c > 0u) ? 1u : 0u; mine = (j == x) ? c : mine; }
        if (sum == G) break;
        __builtin_amdgcn_s_sleep(1);
        if ((++sp & 255u) == 0u) { if (xb_ld(&bar[XB_TMO])) break; if (sp > XB_SPIN_CAP) { atomicAdd(&bar[XB_TMO], 1u); break; } }
    }
    nloc = mine > 0u ? mine : 1u; nx = cnt > 0u ? cnt : 1u;
}
DI void xcd_barrier(const XcdBarrier& b) {
    asm volatile("s_waitcnt vmcnt(0)" ::: "memory");
    __syncthreads();
    if (threadIdx.x == 0) {
        unsigned* bar = b.bar;
        __builtin_amdgcn_s_waitcnt(0);
        unsigned nloc = b.st[0], nx = b.st[1];
        if (nloc == 0u) { xcd_barrier_complete(bar, b.x, nloc, nx); b.st[0] = nloc; b.st[1] = nx; }
        const unsigned old = xb_add(&bar[XB_XSUB(b.x)], 1u);
        const unsigned gen = old / nloc;
        if (old + 1u == (gen + 1u) * nloc) {
            __builtin_amdgcn_fence(__ATOMIC_RELEASE, "agent");
            asm volatile("s_waitcnt vmcnt(0)" ::: "memory");
            const unsigned og = xb_add(&bar[XB_TOP], 1u);
            const unsigned tg = og / nx;
            if (og + 1u == (tg + 1u) * nx) xb_add(&bar[XB_TOPGEN], 1u);
            else XB_SPIN(xb_ld(&bar[XB_TOPGEN]) == tg, bar);
            __builtin_amdgcn_fence(__ATOMIC_ACQUIRE, "agent");
            xb_add(&bar[XB_XGEN(b.x)], 1u);
            asm volatile("s_waitcnt vmcnt(0)" ::: "memory");
        } else {
            XB_SPIN(xb_ld(&bar[XB_XGEN(b.x)]) == gen, bar);
            __builtin_amdgcn_fence(__ATOMIC_ACQUIRE, "agent");
            asm volatile("s_waitcnt vmcnt(0)" ::: "memory");
        }
    }
    __syncthreads();
}

struct Args { const float* in[33]; float* out; unsigned char* ws; int ph_lo, ph_hi; };
struct Frame {
    LAS unsigned char* lds;
    int wave, wg, G;
    const struct Args* A; float* out; unsigned char* ws;
};
enum In { I_X = 0, I_N1G, I_WIN, I_POOLW, I_POOLS, I_CONVW, I_CONVB, I_CLNG, I_CLNB, I_MU, I_W0, I_W2, I_A0, I_A2, I_G2, I_KK, I_KA, I_RK, I_GNG, I_GNB, I_V0, I_V1, I_V2, I_WOUT, I_N2G,
          I_FG, I_FU, I_FD, I_ROUTER, I_MG, I_MU2, I_MD, I_FINALG };

#define LDS_WAIT() asm volatile("s_waitcnt lgkmcnt(0)" ::: "memory")
#define LDS_BAR() do { asm volatile("s_waitcnt lgkmcnt(0)" ::: "memory"); __builtin_amdgcn_s_barrier(); asm volatile("" ::: "memory"); } while (0)
#define PIN_MEM() asm volatile("" ::: "memory")
DI u32x4 ldg16(const bf16* p) { return *(const u32x4*)p; }
struct CvItem { const float* W; bf16* WT; int K, N, k0, n0, drow0; };
DI void cv_load(const CvItem& c, const int lane, f32x4 (&r)[16]) {
#pragma unroll
    for (int i = 0; i < 16; ++i) r[i] = __builtin_nontemporal_load((const f32x4*)(c.W + (size_t)(c.k0 + 4 * i + (lane >> 4)) * c.N + c.n0 + 4 * (lane & 15)));
}
DI bf16x8 cv_trfrag(const LAS unsigned char* img, const int c0, const int kb, const int lane);
template <int F8SC> DI void cv_store(const CvItem& c, const int lane, const f32x4 (&r)[16], LAS unsigned char* img) {
#pragma unroll
    for (int i = 0; i < 16; ++i) { u32x2 w; w.x = pk2(r[i][0], r[i][1]); w.y = pk2(r[i][2], r[i][3]); *(LAS u32x2*)(img + ((4 * i + (lane >> 4)) * 72 + 4 * (lane & 15)) * 2) = w; }
    LDS_WAIT(); asm volatile("" ::: "memory");
#pragma unroll
    for (int nb = 0; nb < 4; ++nb)
#pragma unroll
        for (int kh = 0; kh < 2; ++kh) { const bf16x8 v = cv_trfrag(img, 16 * nb, kh, lane);
            if constexpr (F8SC == 0) *(bf16x8*)(c.WT + (size_t)(c.drow0 + 16 * nb + (lane & 15)) * c.K + c.k0 + 32 * kh + 8 * (lane >> 4)) = v;
            else { float f[8]; unpack8(__builtin_bit_cast(u32x4, v), f); constexpr float sc = (float)F8SC; u32x2 w; w.x = pk4_f8(f[0] * sc, f[1] * sc, f[2] * sc, f[3] * sc); w.y = pk4_f8(f[4] * sc, f[5] * sc, f[6] * sc, f[7] * sc);
                *(u32x2*)((unsigned char*)c.WT + (size_t)(c.drow0 + 16 * nb + (lane & 15)) * c.K + c.k0 + 32 * kh + 8 * (lane >> 4)) = w; } }
    LDS_WAIT(); asm volatile("" ::: "memory");
}
DI CvItem cv_plain(const float* W, int K, int N, bf16* WT, int item) { const int nblk = N / 64, kb = item / nblk, nb = item % nblk; return CvItem{W, WT, K, N, 64 * kb, 64 * nb, 64 * nb}; }
DI CvItem cv_gu(const float* W, int K, int Fh, bf16* WT, int up, int item) { const int nblk = Fh / 64, kb = item / nblk, nb = item % nblk, n0 = 64 * nb; return CvItem{W, WT, K, Fh, 64 * kb, n0, 256 * (n0 / 128) + up * 128 + (n0 % 128)}; }
template <int F8SC, class Desc> DI void cv_run(const Desc& desc, const int nitems, const int first, const int stride, const int lane, LAS float* scr_) {
    if (first >= nitems) return;
    LAS unsigned char* img = (LAS unsigned char*)scr_;
    f32x4 ra[16], rb[16];
    CvItem ca = desc(first), cb = ca;
    cv_load(ca, lane, ra);
    for (int it = first; it < nitems; it += 2 * stride) {
        const bool hb = (it + stride) < nitems;
        if (hb) { cb = desc(it + stride); cv_load(cb, lane, rb); }
        PIN_MEM();
        cv_store<F8SC>(ca, lane, ra, img);
        const bool ha = (it + 2 * stride) < nitems;
        if (ha) { ca = desc(it + 2 * stride); cv_load(ca, lane, ra); }
        PIN_MEM();
        if (hb) cv_store<F8SC>(cb, lane, rb, img);
    }
}

DI void store_row_bf16(bf16* orow, int lane, const f32x4 (&y)[4]) {
    u32x2* o8 = (u32x2*)orow + lane;
#pragma unroll
    for (int j = 0; j < 4; ++j) { u32x2 w; w.x = pk2(y[j].x, y[j].y); w.y = pk2(y[j].z, y[j].w); o8[64 * j] = w; }
}
DI void store_row_f8(unsigned char* orow, int lane, const f32x4 (&y)[4]) {
    unsigned* o4 = (unsigned*)orow + lane;
#pragma unroll
    for (int j = 0; j < 4; ++j) o4[64 * j] = pk4_f8(y[j].x * F8S_X, y[j].y * F8S_X, y[j].z * F8S_X, y[j].w * F8S_X);
}
DI void norm_rows_phase(Frame& F, const float* src, const float* g, bf16* dst) {
    const int lane = (int)threadIdx.x & 63, gw = F.wg * NWAVES + F.wave, NGW = F.G * NWAVES;
    f32x4 cr[2][4], nr[2][4];
#pragma unroll
    for (int q = 0; q < 2; ++q) { const int mq = (gw + q * NGW < M) ? gw + q * NGW : gw;
#pragma unroll
        for (int j = 0; j < 4; ++j) cr[q][j] = ((const f32x4*)(src + (size_t)mq * D) + lane)[64 * j]; }
#pragma unroll 1
    for (int m = gw; m < M; m += 2 * NGW) {
#pragma unroll
        for (int q = 0; q < 2; ++q) { const int mq = (m + (2 + q) * NGW < M) ? m + (2 + q) * NGW : m;
#pragma unroll
            for (int j = 0; j < 4; ++j) nr[q][j] = ((const f32x4*)(src + (size_t)mq * D) + lane)[64 * j]; }
        float ss[2] = {0.f, 0.f};
#pragma unroll
        for (int q = 0; q < 2; ++q)
#pragma unroll
            for (int j = 0; j < 4; ++j) ss[q] += (cr[q][j].x * cr[q][j].x + cr[q][j].y * cr[q][j].y) + (cr[q][j].z * cr[q][j].z + cr[q][j].w * cr[q][j].w);
#pragma unroll
        for (int q = 0; q < 2; ++q) { const float rstd = 1.0f / sqrtf(wave_sum(ss[q]) * (1.f / D) + RMS_EPS); const int mq = m + q * NGW; f32x4 y[4];
#pragma unroll
            for (int j = 0; j < 4; ++j) y[j] = cr[q][j] * rstd * ((const f32x4*)g + lane)[64 * j];
            if (mq < M) store_row_bf16(dst + (size_t)mq * D, lane, y); }
#pragma unroll
        for (int q = 0; q < 2; ++q)
#pragma unroll
            for (int j = 0; j < 4; ++j) cr[q][j] = nr[q][j];
    }
}
template <bool OUT_F32> DI void norm_rows_phase_b(Frame& F, const bf16* src, const float* g, void* dst) {
    const int lane = (int)threadIdx.x & 63, gw = F.wg * NWAVES + F.wave, NGW = F.G * NWAVES;
    f32x4 gg[4];
#pragma unroll
    for (int j = 0; j < 4; ++j) gg[j] = ((const f32x4*)g + lane)[64 * j];
    u32x2 cr[2][4], nr[2][4];
#pragma unroll
    for (int q = 0; q < 2; ++q) { const int mq = (gw + q * NGW < M) ? gw + q * NGW : gw;
#pragma unroll
        for (int j = 0; j < 4; ++j) cr[q][j] = ((const u32x2*)(src + (size_t)mq * D) + lane)[64 * j]; }
#pragma unroll 1
    for (int m = gw; m < M; m += 2 * NGW) {
#pragma unroll
        for (int q = 0; q < 2; ++q) { const int mq = (m + (2 + q) * NGW < M) ? m + (2 + q) * NGW : m;
#pragma unroll
            for (int j = 0; j < 4; ++j) nr[q][j] = ((const u32x2*)(src + (size_t)mq * D) + lane)[64 * j]; }
        f32x4 y[2][4]; float ss[2] = {0.f, 0.f};
#pragma unroll
        for (int q = 0; q < 2; ++q)
#pragma unroll
            for (int j = 0; j < 4; ++j) { const u32x2 v = cr[q][j]; y[q][j] = (f32x4){bflo(v.x), bfhi(v.x), bflo(v.y), bfhi(v.y)}; ss[q] += (y[q][j].x * y[q][j].x + y[q][j].y * y[q][j].y) + (y[q][j].z * y[q][j].z + y[q][j].w * y[q][j].w); }
#pragma unroll
        for (int q = 0; q < 2; ++q) { const float rstd = 1.0f / sqrtf(wave_sum(ss[q]) * (1.f / D) + RMS_EPS); const int mq = m + q * NGW;
#pragma unroll
            for (int j = 0; j < 4; ++j) y[q][j] = y[q][j] * rstd * gg[j];
            if (mq < M) { if constexpr (OUT_F32) { f32x4* o = (f32x4*)((float*)dst + (size_t)mq * D) + lane;
#pragma unroll
                    for (int j = 0; j < 4; ++j) o[64 * j] = y[q][j]; }
                else store_row_bf16((bf16*)dst + (size_t)mq * D, lane, y[q]); } }
#pragma unroll
        for (int q = 0; q < 2; ++q)
#pragma unroll
            for (int j = 0; j < 4; ++j) cr[q][j] = nr[q][j];
    }
}
template <int JOB> DI void convert_main(Frame& F, const int first, const int stride, LAS float* scr) {
    unsigned char* ws = F.ws; const Args* A = F.A;
    constexpr int I_IN = (D / 64) * (NIN / 64), I_OUT = (D / 64) * (D / 64), I_GU = (D / 64) * (FF / 64), I_DN = (FF / 64) * (D / 64);
    if (JOB == 0) {
        auto desc = [=](int it) -> CvItem { return cv_plain(A->in[I_WIN], D, NIN, (bf16*)(ws + WS_WIN), it); };
        cv_run<0>(desc, I_IN, first, stride, ((int)threadIdx.x & 63), scr);
    } else {
        constexpr int NITEMS = I_IN + 2 * I_OUT + 2 * I_GU + I_DN;
        auto desc = [=](int it) -> CvItem {
            int r = it;
            if (r < I_IN) return cv_plain(A->in[I_WIN] + (size_t)D * NIN, D, NIN, (bf16*)(ws + WS_WIN) + (size_t)NIN * D, r); r -= I_IN;
            if (r < 2 * I_OUT) { const int l = r / I_OUT; return cv_plain(A->in[I_WOUT] + (size_t)l * D * D, D, D, (bf16*)(ws + WS_WOUT) + (size_t)l * D * D, r % I_OUT); } r -= 2 * I_OUT;
            if (r < I_GU) return cv_gu(A->in[I_FG], D, FF, (bf16*)(ws + WS_WGU), 0, r); r -= I_GU;
            if (r < I_GU) return cv_gu(A->in[I_FU], D, FF, (bf16*)(ws + WS_WGU), 1, r); r -= I_GU;
            return cv_plain(A->in[I_FD], FF, D, (bf16*)(ws + WS_WDN), r);
        };
        cv_run<0>(desc, NITEMS, first, stride, ((int)threadIdx.x & 63), scr);
    }
}
DI void p0_prologue(Frame& F) {
    LAS float* scr = (LAS float*)(F.lds + F.wave * 16384);
    const int gw = F.wg * NWAVES + F.wave, NGW = F.G * NWAVES;
    unsigned char* ws = F.ws;
    convert_main<0>(F, gw, NGW, scr);
    const int gt = F.wg * NTHR + ((int)threadIdx.x), NGT = F.G * NTHR;
    for (int i = gt; i < 2 * 4 * 64 * 64; i += NGT) { const int c = i & 63, n = (i >> 6) & 63, lg = i >> 12; ((bf16*)(ws + SM_POOLT))[i] = (bf16)(pk2(F.A->in[I_POOLW][(size_t)lg * 4096 + c * 64 + n], 0.f) & 0xffffu); }
    for (int i = gt; i < 2 * 512 * 64; i += NGT) { const int j = i & 63, n = (i >> 6) & 511, l = i >> 15;
        ((bf16*)(ws + SM_W2T))[i] = (bf16)(pk2(F.A->in[I_W2][(size_t)l * 64 * 512 + j * 512 + n], 0.f) & 0xffffu);
        ((bf16*)(ws + SM_A2T))[i] = (bf16)(pk2(F.A->in[I_A2][(size_t)l * 64 * 512 + j * 512 + n], 0.f) & 0xffffu); }
    for (int i = gt; i < 2 * 512 * 128; i += NGT) { const int j = i & 127, n = (i >> 7) & 511, l = i >> 16; ((bf16*)(ws + SM_G2T))[i] = (bf16)(pk2(F.A->in[I_G2][(size_t)l * 128 * 512 + j * 512 + n], 0.f) & 0xffffu); }
    for (int i = gt; i < 32 * 512; i += NGT) { const int c = i & 511, r = i >> 9; ((bf16*)(ws + SM_V1T))[i] = (bf16)(pk2(F.A->in[I_V1][(size_t)c * 32 + r], 0.f) & 0xffffu); }
    for (int i = gt; i < 512 * 32; i += NGT) { const int r = i & 31, n = i >> 5; ((bf16*)(ws + SM_V2T))[i] = (bf16)(pk2(F.A->in[I_V2][(size_t)r * 512 + n], 0.f) & 0xffffu); }
}
template <int JOB> DI void moe_weight_convert(Frame& F, const int first, const int stride, LAS float* scr) {
    constexpr int I_G = (D / 64) * (FE / 64), I_D = (FE / 64) * (D / 64);
    const Args* A = F.A; unsigned char* ws = F.ws;
    if (JOB == 0) {
        auto desc = [=](int it) -> CvItem {
            const int e = it / (2 * I_G); int r = it % (2 * I_G);
            bf16* gu = (bf16*)(ws + WS_WMGU + (size_t)e * 2 * FE * D);
            if (r < I_G) return cv_gu(A->in[I_MG] + (size_t)e * D * FE, D, FE, gu, 0, r);
            return cv_gu(A->in[I_MU2] + (size_t)e * D * FE, D, FE, gu, 1, r - I_G);
        };
        cv_run<(int)F8S_WGU>(desc, NE * 2 * I_G, first, stride, ((int)threadIdx.x & 63), scr);
    } else {
        auto desc = [=](int it) -> CvItem { const int e = it / I_D, r = it % I_D; return cv_plain(A->in[I_MD] + (size_t)e * FE * D, FE, D, (bf16*)(ws + WS_WMDN + (size_t)e * D * FE), r); };
        cv_run<(int)F8S_WDN>(desc, NE * I_D, first, stride, ((int)threadIdx.x & 63), scr);
    }
}

DI void mixc_unit(Frame& F, const int l, const int tile) {
    int tid_ = ((int)threadIdx.x); asm volatile("" : "+v"(tid_));
    const int tid = tid_, lane = tid & 63, wave = __builtin_amdgcn_readfirstlane(tid >> 6);
    const int row0 = tile * 64, tseq = row0 & (T - 1);
    const bf16* proj = (const bf16*)(F.ws + WS_PROJ);
    bf16* mix = (bf16*)(F.ws + WS_MIX);
    u32x4 pv[5]; bool pok[5];
#pragma unroll
    for (int k = 0; k < 5; ++k) { const int idx = tid + k * NTHR, r = idx >> 5, cc = idx & 31; pok[k] = (idx < 79 * 32) && (tseq - 15 + r >= 0); pv[k] = ldg16(proj + (size_t)(pok[k] ? row0 - 15 + r : row0) * NIN + cc * 8); }
    u32x4 ca[6], cb[6]; bool cok[6];
#pragma unroll
    for (int k = 0; k < 6; ++k) { const int idx = tid + k * NTHR, r = idx >> 5, cc = idx & 31; cok[k] = (idx < 94 * 32) && (tseq - 30 + r >= 0); const bf16* p = proj + (size_t)(cok[k] ? row0 - 30 + r : row0) * NIN + cc * 8;
        ca[k] = ldg16(p + C_CONVA); cb[k] = ldg16(p + C_CONVB); }
    const int cch = tid & 255, half = tid >> 8; const float* cw = F.A->in[I_CONVW] + (size_t)l * 31 * 256 + cch; float w[31];
#pragma unroll
    for (int j = 0; j < 31; ++j) w[j] = cw[j * 256];
    const float bias = F.A->in[I_CONVB][l * 256 + cch];
    bf16x8 pfr[4][2]; f32x4 psc[4];
    { const bf16* PT = (const bf16*)(F.ws + SM_POOLT) + (size_t)(l * 4 + (wave >> 1)) * 4096; const float* sc = F.A->in[I_POOLS] + l * 256 + (wave >> 1) * 64;
#pragma unroll
      for (int nt = 0; nt < 4; ++nt) { psc[nt] = *(const f32x4*)(sc + nt * 16 + 4 * (lane >> 4));
#pragma unroll
          for (int ks = 0; ks < 2; ++ks) pfr[nt][ks] = *(const bf16x8*)(PT + (nt * 16 + (lane & 15)) * 64 + ks * 32 + (lane >> 4) * 8); } }
    PIN_MEM();
    LAS bf16* PU = (LAS bf16*)F.lds; LAS bf16* DM = (LAS bf16*)(F.lds + 79 * 264 * 2 + 16);
#pragma unroll
    for (int k = 0; k < 5; ++k) { const int idx = tid + k * NTHR, r = idx >> 5, cc = idx & 31; if (idx < 79 * 32) *(LAS u32x4*)(PU + r * 264 + cc * 8) = pok[k] ? pv[k] : (u32x4){0u, 0u, 0u, 0u}; }
    LDS_BAR();
    {
        const int g = wave >> 1, win = 2 << g, cc = g * 8 + (lane & 7);
#pragma unroll
        for (int it = 0; it < 4; ++it) { const int t = (wave & 1) * 32 + it * 8 + (lane >> 3); const int pos = tseq + t; const int cnt = (pos + 1 < win) ? pos + 1 : win;
            float s[8], u[8];
#pragma unroll
            for (int k = 0; k < 8; ++k) s[k] = 0.f;
            unpack8(*(const LAS u32x4*)(PU + (15 + t) * 264 + cc * 8), u);
            for (int j = 0; j < win; ++j) { float x[8]; unpack8(*(const LAS u32x4*)(PU + (15 + t - j) * 264 + cc * 8), x);
#pragma unroll
                for (int k = 0; k < 8; ++k) s[k] += x[k]; }
            const float inv = 1.0f / (float)cnt;
#pragma unroll
            for (int k = 0; k < 8; ++k) s[k] = s[k] * inv - u[k];
            *(LAS u32x4*)(DM + t * 264 + cc * 8) = pack8(s); }
    }
    LDS_BAR();
    {
        const int g = wave >> 1;
#pragma unroll
        for (int tt2 = 0; tt2 < 2; ++tt2) { const int tt = (wave & 1) * 2 + tt2;
            bf16x8 bfr[2];
#pragma unroll
            for (int ks = 0; ks < 2; ++ks) bfr[ks] = *(const LAS bf16x8*)(DM + (tt * 16 + (lane & 15)) * 264 + g * 64 + ks * 32 + (lane >> 4) * 8);
#pragma unroll
            for (int nt = 0; nt < 4; ++nt) { f32x4 acc = (f32x4){0.f, 0.f, 0.f, 0.f};
#pragma unroll
                for (int ks = 0; ks < 2; ++ks) acc = MFMA16(pfr[nt][ks], bfr[ks], acc);
                const int t = tt * 16 + (lane & 15), col = g * 64 + nt * 16 + 4 * (lane >> 4); const f32x4 s4 = psc[nt];
                u32x2 wv; wv.x = pk2(acc[0] * s4[0], acc[1] * s4[1]); wv.y = pk2(acc[2] * s4[2], acc[3] * s4[3]);
                *(LAS u32x2*)(F.lds + 102400 + t * 528 + col * 2) = wv; } }
    }
    LDS_BAR();
    {
        const int rr = tid >> 3, pc = tid & 7;
#pragma unroll
        for (int k = 0; k < 4; ++k) { const u32x4 v = *(const LAS u32x4*)(F.lds + 102400 + rr * 528 + k * 128 + pc * 16);
            *(u32x4*)(mix + (size_t)(row0 + rr) * D + k * 64 + pc * 8) = v; }
    }
    LAS float* U = (LAS float*)F.lds;
#pragma unroll
    for (int k = 0; k < 6; ++k) { const int idx = tid + k * NTHR, r = idx >> 5, cc = idx & 31; float u[8], a[8], b[8]; unpack8(ca[k], a); unpack8(cb[k], b);
#pragma unroll
        for (int e = 0; e < 8; ++e) u[e] = cok[k] ? a[e] * sigmoidf_(b[e]) : 0.f;
        if (idx < 94 * 32) { *(LAS f32x4*)(U + r * 256 + cc * 8) = (f32x4){u[0], u[1], u[2], u[3]}; *(LAS f32x4*)(U + r * 256 + cc * 8 + 4) = (f32x4){u[4], u[5], u[6], u[7]}; } }
    u32x4 vc[8], vp[8];
    if (l == 1) {
#pragma unroll
        for (int k = 0; k < 8; ++k) { const int idx = tid + k * NTHR, t = idx >> 6, cc = idx & 63; const bf16* p = proj + (size_t)(row0 + t) * NIN + C_V + cc * 8; vc[k] = ldg16(p); vp[k] = ldg16(p - ((tseq + t > 0) ? NIN : 0)); }
        PIN_MEM();
    }
    LDS_BAR();
    {
        float y[32];
#pragma unroll
        for (int i = 0; i < 32; ++i) y[i] = bias;
#pragma unroll
        for (int r = 0; r < 62; ++r) { const float val = U[(half * 32 + r) * 256 + cch];
#pragma unroll
            for (int i = 0; i < 32; ++i) { const int j = r - i; if (j >= 0 && j <= 30) y[i] += w[j] * val; } }
        LDS_BAR();
#pragma unroll
        for (int i = 0; i < 32; ++i) U[(half * 32 + i) * 256 + cch] = y[i];
    }
    LDS_BAR();
    {
        const f32x4 lg = *(const f32x4*)(F.A->in[I_CLNG] + l * 256 + lane * 4), lb = *(const f32x4*)(F.A->in[I_CLNB] + l * 256 + lane * 4);
#pragma unroll 2
        for (int i = 0; i < 8; ++i) { const int t = wave * 8 + i; const f32x4 v = *(const LAS f32x4*)(U + t * 256 + lane * 4);
            const float mu = wave_sum((v.x + v.y) + (v.z + v.w)) * (1.f / 256.f); const f32x4 d = v - mu;
            const float var = wave_sum((d.x * d.x + d.y * d.y) + (d.z * d.z + d.w * d.w)) * (1.f / 256.f); const float rstd = 1.0f / sqrtf(var + LN_EPS);
            f32x4 o = d * rstd * lg + lb; u32x2 wv; wv.x = pk2(siluf_(o.x), siluf_(o.y)); wv.y = pk2(siluf_(o.z), siluf_(o.w));
            *(u32x2*)(mix + (size_t)(row0 + t) * D + 256 + lane * 4) = wv; }
    }
    if (l == 1) {
        LDS_BAR();
        LAS bf16* VS = (LAS bf16*)F.lds;
        const float* mu = F.A->in[I_MU] + l * NRC + (C_V - C_R);
#pragma unroll
        for (int k = 0; k < 8; ++k) { const int idx = tid + k * NTHR, t = idx >> 6, cc = idx & 63; float c8[8], p8[8]; unpack8(vc[k], c8); unpack8(vp[k], p8); const bool hp = (tseq + t) > 0;
            const f32x4 m0 = *(const f32x4*)(mu + cc * 8), m1 = *(const f32x4*)(mu + cc * 8 + 4);
#pragma unroll
            for (int e = 0; e < 8; ++e) c8[e] = c8[e] + (e < 4 ? m0[e & 3] : m1[e & 3]) * ((hp ? p8[e] : 0.f) - c8[e]);
            *(LAS u32x4*)(VS + t * 520 + cc * 8) = pack8(c8); }
        LDS_BAR();
        const int tt = wave & 3, rt = wave >> 2; const bf16* V1T = (const bf16*)(F.ws + SM_V1T); f32x4 acc = (f32x4){0.f, 0.f, 0.f, 0.f};
#pragma unroll 4
        for (int ks = 0; ks < 16; ++ks) { const bf16x8 a = *(const bf16x8*)(V1T + (rt * 16 + (lane & 15)) * 512 + ks * 32 + (lane >> 4) * 8);
            const bf16x8 b = *(const LAS bf16x8*)(VS + (tt * 16 + (lane & 15)) * 520 + ks * 32 + (lane >> 4) * 8); acc = MFMA16(a, b, acc); }
        *(f32x4*)((float*)(F.ws + WS_VV1) + (size_t)(row0 + tt * 16 + (lane & 15)) * 32 + rt * 16 + 4 * (lane >> 4)) = acc;
    }
    asm volatile("s_waitcnt vmcnt(0)" ::: "memory");
    LDS_BAR();
}

constexpr int S1_XW = 0, S1_XA = 9216, S1_XG = 18432, S1_XV = 35840;
constexpr int S1_AAB = 40960, S1_AAK = S1_AAB + 9216, S1_ARB = S1_AAK + 9216, S1_ARK = S1_ARB + 9216, S1_MT = S1_ARK + 9216, S1_XT = S1_MT + 9216, S1_TII = S1_XT + 9216;
constexpr int S1_RT = S1_TII + 3072, S1_AT = S1_RT + 9216, S1_BT = S1_AT + 9216, S1_KT = S1_BT + 9216, S1_VN = S1_KT + 9216;
constexpr int S1_WTOT = S1_VN + 9216, S1_NRM = S1_WTOT + 1024, S1_RKX = S1_NRM + 2048, S1_LC = S1_RKX + 2048, S1_MU = S1_LC + 256, S1_END = S1_MU + NRC * 4;
constexpr int S1_CV = S1_END;
static_assert(S1_XV + 5120 <= S1_AAB && S1_CV + 2 * 6 * 64 * 4 <= MISC_OFF, "S1 lds map");
#define LD_F8(ptr) (*(const LAS bf16x8*)(ptr))
typedef short s16x4 __attribute__((ext_vector_type(4)));
DI bf16x8 mk8(unsigned a, unsigned b, unsigned c, unsigned d) { u32x4 w = {a, b, c, d}; return __builtin_bit_cast(bf16x8, w); }
DI u32x2 pk4f(const f32x4 v) { u32x2 p; p.x = pk2(v[0], v[1]); p.y = pk2(v[2], v[3]); return p; }
DI f32x4 up4(const u32x2 v) { return (f32x4){bflo(v.x), bfhi(v.x), bflo(v.y), bfhi(v.y)}; }
DI bf16x8 mk8h(const u32x2 p) { return mk8(p.x, p.y, 0u, 0u); }
DI u32x2 tr_read(const LAS unsigned char* p) { return __builtin_bit_cast(u32x2, __builtin_amdgcn_ds_read_tr16_b64_v4i16((LAS s16x4*)p)); }
DI const LAS unsigned char* tr_addr(const LAS unsigned char* img, const int r0, const int c0, const int lane) { return img + ((r0 + ((lane & 15) >> 2)) * 72 + c0 + 4 * (lane & 3)) * 2; }
DI bf16x8 tr_frag(const LAS unsigned char* img, const int c0, const int kb, const int lane) {
    const int r0 = 32 * kb + 8 * (lane >> 4);
    const u32x2 lo = tr_read(tr_addr(img, r0, c0, lane)), hi = tr_read(tr_addr(img, r0 + 4, c0, lane));
    return mk8(lo.x, lo.y, hi.x, hi.y);
}
DI bf16x8 cv_trfrag(const LAS unsigned char* img, const int c0, const int kb, const int lane) { return tr_frag(img, c0, kb, lane); }
DI void shift8(const u32x4 cur, const u32x4 prev, const bool hasprev, const LAS unsigned char* L, const int col, float (&o)[8]) {
    float c8[8], p8[8]; unpack8(cur, c8); unpack8(prev, p8);
    const f32x4 m0 = *(const LAS f32x4*)(L + S1_MU + (col - C_R) * 4), m1 = *(const LAS f32x4*)(L + S1_MU + (col - C_R + 4) * 4);
#pragma unroll
    for (int k = 0; k < 8; ++k) o[k] = c8[k] + (k < 4 ? m0[k & 3] : m1[k & 3]) * ((hasprev ? p8[k] : 0.f) - c8[k]);
}
DI f32x4 shift4(const u32x2 cur, const u32x2 prev, const bool hasprev, const LAS unsigned char* L, const int col) {
    const f32x4 c = up4(cur), p = hasprev ? up4(prev) : (f32x4){0.f, 0.f, 0.f, 0.f}, m = *(const LAS f32x4*)(L + S1_MU + (col - C_R) * 4);
    return c + m * (p - c);
}
DI void s1_stage_mu(Frame& F, const int l) {
    for (int i = ((int)threadIdx.x); i < NRC / 4; i += NTHR) *(LAS f32x4*)(F.lds + S1_MU + i * 16) = *(const f32x4*)(F.A->in[I_MU] + l * NRC + i * 4);
    LDS_BAR();
}
DI float s1_cvec_load(Frame& F, const int l, const int h, const int tid) {
    const int v = __builtin_amdgcn_readfirstlane(tid >> 6), c = tid & 63;
    const int idx = (v == 0) ? I_W0 : (v == 1) ? I_A0 : (v == 2) ? I_KK : (v == 3) ? I_KA : (v == 4) ? I_RK : I_V0;
    if (v > 5 || (v == 5 && l == 0)) return 0.f;
    return F.A->in[idx][((v == 5) ? 0 : l * RW) + h * 64 + c];
}
DI void s1_chunk_prep(Frame& F, const int l, const int gchunk) {
    int tid_ = ((int)threadIdx.x); asm volatile("" : "+v"(tid_));
    const int t = tid_ >> 3, n8 = tid_ & 7, row0 = gchunk * 64;
    const bool hasprev = ((row0 & (T - 1)) + t) > 0;
    const bf16* prow = (const bf16*)(F.ws + WS_PROJ) + (size_t)(row0 + t) * NIN; const bf16* pprev = prow - (hasprev ? NIN : 0);
    LAS unsigned char* L = F.lds;
    const u32x4 cxw = ldg16(prow + C_XW + n8 * 8), pxw = ldg16(pprev + C_XW + n8 * 8), cxa = ldg16(prow + C_XA + n8 * 8), pxa = ldg16(pprev + C_XA + n8 * 8);
    const u32x4 cg0 = ldg16(prow + C_XG + n8 * 16), pg0 = ldg16(pprev + C_XG + n8 * 16), cg1 = ldg16(prow + C_XG + n8 * 16 + 8), pg1 = ldg16(pprev + C_XG + n8 * 16 + 8);
    f32x4 vv1 = (f32x4){0.f, 0.f, 0.f, 0.f}; if (l == 1) vv1 = *(const f32x4*)((const float*)(F.ws + WS_VV1) + (size_t)(row0 + t) * 32 + n8 * 4);
    const float cv0h = s1_cvec_load(F, l, 0, tid_);
    PIN_MEM();
    float x[8];
    shift8(cxw, pxw, hasprev, L, C_XW + n8 * 8, x);
#pragma unroll
    for (int k = 0; k < 8; ++k) { const float e = fast_exp(2.0f * x[k]); x[k] = 1.0f - 2.0f * __builtin_amdgcn_rcpf(e + 1.0f); }
    *(LAS u32x4*)(L + S1_XW + (t * 72 + n8 * 8) * 2) = pack8(x);
    shift8(cxa, pxa, hasprev, L, C_XA + n8 * 8, x);
    *(LAS u32x4*)(L + S1_XA + (t * 72 + n8 * 8) * 2) = pack8(x);
    shift8(cg0, pg0, hasprev, L, C_XG + n8 * 16, x);
#pragma unroll
    for (int k = 0; k < 8; ++k) x[k] = sigmoidf_(x[k]);
    *(LAS u32x4*)(L + S1_XG + (t * 136 + n8 * 16) * 2) = pack8(x);
    shift8(cg1, pg1, hasprev, L, C_XG + n8 * 16 + 8, x);
#pragma unroll
    for (int k = 0; k < 8; ++k) x[k] = sigmoidf_(x[k]);
    *(LAS u32x4*)(L + S1_XG + (t * 136 + n8 * 16 + 8) * 2) = pack8(x);
    if (l == 1) *(LAS u32x2*)(L + S1_XV + (t * 40 + n8 * 4) * 2) = pk4f(vv1);
    if (tid_ < 384) *(LAS float*)(L + S1_CV + tid_ * 4) = cv0h;
    LDS_BAR();
}
struct S1Pre { u32x2 cr[2], pr[2], ck[2], pk[2], cv[2], pv[2], vf[2]; };
DI void s1_issue(Frame& F, const int l, const int gchunk, const int h, S1Pre& P) {
    int tid_ = ((int)threadIdx.x); asm volatile("" : "+v"(tid_));
    const int lane = tid_ & 63, wave = tid_ >> 6, row0 = gchunk * 64;
    const int c = h * 64 + (wave & 3) * 16 + 4 * (lane >> 4);
#pragma unroll
    for (int i = 0; i < 2; ++i) { const int t = 16 * (2 * (wave >> 2) + i) + (lane & 15);
        const bool hasprev = ((row0 & (T - 1)) + t) > 0;
        const bf16* prow = (const bf16*)(F.ws + WS_PROJ) + (size_t)(row0 + t) * NIN; const bf16* pprev = prow - (hasprev ? NIN : 0);
        P.cr[i] = *(const u32x2*)(prow + C_R + c); P.pr[i] = *(const u32x2*)(pprev + C_R + c); P.ck[i] = *(const u32x2*)(prow + C_K + c); P.pk[i] = *(const u32x2*)(pprev + C_K + c);
        P.cv[i] = *(const u32x2*)(prow + C_V + c); P.pv[i] = *(const u32x2*)(pprev + C_V + c);
        P.vf[i] = (l == 1) ? *(const u32x2*)((const bf16*)(F.ws + WS_VF) + (size_t)(gchunk * 8 + h) * 4096 + (((wave & 3) * 4 + 2 * (wave >> 2) + i) * 64 + lane) * 4) : P.cv[i]; }
    PIN_MEM();
}

DI void s1_unit(Frame& F, const int l, const int gchunk, const int h, const S1Pre& pre, const int hn, S1Pre& nxt) {
    int tid_ = ((int)threadIdx.x); asm volatile("" : "+v"(tid_));
    const int tid = tid_, lane = tid & 63, wave = __builtin_amdgcn_readfirstlane(tid >> 6), fr = lane & 15, fq = lane >> 4;
    const int row0 = gchunk * 64, tseq0 = row0 & (T - 1), unit = gchunk * 8 + h;
    const int nt = wave & 3, th = wave >> 2;
    LAS unsigned char* L = F.lds;
    bf16x8 fw[2], fa[2], fg[4], fv;
    f32x4 cw0, ca0, ckk, cka, crk, cv0;
    {
        const bf16* W2T = (const bf16*)(F.ws + SM_W2T) + (size_t)(l * 512 + h * 64) * 64; const bf16* A2T = (const bf16*)(F.ws + SM_A2T) + (size_t)(l * 512 + h * 64) * 64;
        const bf16* G2T = (const bf16*)(F.ws + SM_G2T) + (size_t)(l * 512 + h * 64) * 128; const bf16* V2T = (const bf16*)(F.ws + SM_V2T) + (size_t)(h * 64) * 32;
        const int nr = nt * 16 + fr;
#pragma unroll
        for (int ks = 0; ks < 2; ++ks) { fw[ks] = *(const bf16x8*)(W2T + nr * 64 + ks * 32 + fq * 8); fa[ks] = *(const bf16x8*)(A2T + nr * 64 + ks * 32 + fq * 8); }
#pragma unroll
        for (int ks = 0; ks < 4; ++ks) fg[ks] = *(const bf16x8*)(G2T + nr * 128 + ks * 32 + fq * 8);
        fv = (l == 1) ? *(const bf16x8*)(V2T + nr * 32 + fq * 8) : fw[0];
        const LAS float* CV = (const LAS float*)(L + S1_CV) + (h & 1) * 384 + nt * 16 + 4 * fq;
        cw0 = *(const LAS f32x4*)(CV); ca0 = *(const LAS f32x4*)(CV + 64); ckk = *(const LAS f32x4*)(CV + 128);
        cka = *(const LAS f32x4*)(CV + 192); crk = *(const LAS f32x4*)(CV + 256); cv0 = (l == 1) ? *(const LAS f32x4*)(CV + 320) : cw0;
    }
    const float cvn = s1_cvec_load(F, l, hn, tid);
    PIN_MEM();
    f32x4 lw[2], cs[2], av[2], kk[2], km[2], vm[2], r4[2], k4[2], v4[2];
    float nrm[2] = {0.f, 0.f}, rk[2] = {0.f, 0.f};
    const int c0 = h * 64 + nt * 16 + 4 * fq;
#pragma unroll
    for (int i = 0; i < 2; ++i) { const bool hasprev = (tseq0 + 16 * (2 * th + i) + fr) > 0;
        r4[i] = shift4(pre.cr[i], pre.pr[i], hasprev, L, C_R + c0); k4[i] = shift4(pre.ck[i], pre.pk[i], hasprev, L, C_K + c0); v4[i] = shift4(pre.cv[i], pre.pv[i], hasprev, L, C_V + c0); }
#pragma unroll
    for (int i = 0; i < 2; ++i) { const int t = 16 * (2 * th + i) + fr; f32x4 aw = (f32x4){0.f, 0.f, 0.f, 0.f}, aa = aw, ag = aw, ap = aw;
#pragma unroll
        for (int ks = 0; ks < 2; ++ks) { const int ko = ks * 32 + fq * 8;
            aw = MFMA16(fw[ks], LD_F8(L + S1_XW + (t * 72 + ko) * 2), aw);
            aa = MFMA16(fa[ks], LD_F8(L + S1_XA + (t * 72 + ko) * 2), aa); }
#pragma unroll
        for (int ks = 0; ks < 4; ++ks) ag = MFMA16(fg[ks], LD_F8(L + S1_XG + (t * 136 + ks * 32 + fq * 8) * 2), ag);
        if (l == 1) ap = MFMA16(fv, LD_F8(L + S1_XV + (t * 40 + fq * 8) * 2), ap);
        const size_t bo = (size_t)unit * 4096 + ((nt * 4 + 2 * th + i) * 64 + lane) * 4;
        *(u32x2*)((bf16*)(F.ws + WS_GB) + bo) = pk4f(ag);
        const f32x4 vf4 = up4(pre.vf[i]);
#pragma unroll
        for (int j = 0; j < 4; ++j) {
            lw[i][j] = (-0.60653065971263342f * 1.44269504088896f) * __builtin_amdgcn_rcpf(1.0f + __expf(-(cw0[j] + aw[j])));
            av[i][j] = __builtin_amdgcn_rcpf(1.0f + __expf(-(ca0[j] + aa[j])));
            kk[i][j] = k4[i][j] * ckk[j]; nrm[i] += kk[i][j] * kk[i][j];
            km[i][j] = k4[i][j] * (1.0f + (av[i][j] - 1.0f) * cka[j]);
            rk[i] += r4[i][j] * km[i][j] * crk[j];
            vm[i][j] = (l == 1) ? v4[i][j] + (vf4[j] - v4[i][j]) * __builtin_amdgcn_rcpf(1.0f + __expf(-(cv0[j] + ap[j]))) : v4[i][j];
        }
        cs[i] = lw[i];
        *(u32x2*)((bf16*)(F.ws + (l == 0 ? WS_VF : WS_VMB)) + bo) = pk4f(vm[i]);
    }
#pragma unroll
    for (int i = 0; i < 2; ++i) {
        nrm[i] += __shfl_xor(nrm[i], 16); nrm[i] += __shfl_xor(nrm[i], 32); rk[i] += __shfl_xor(rk[i], 16); rk[i] += __shfl_xor(rk[i], 32);
        if (fq == 0) { const int t = 16 * (2 * th + i) + fr; *(LAS float*)(L + S1_NRM + (t * 4 + nt) * 4) = nrm[i]; *(LAS float*)(L + S1_RKX + (t * 4 + nt) * 4) = rk[i]; } }
#pragma unroll
    for (int i = 0; i < 2; ++i)
#pragma unroll
        for (int j = 0; j < 4; ++j) cs[i][j] = row_scan16(cs[i][j]);
    if (fr == 15) {
#pragma unroll
        for (int i = 0; i < 2; ++i) *(LAS f32x4*)(L + S1_WTOT + ((2 * th + i) * 64 + nt * 16 + 4 * fq) * 4) = cs[i]; }
    LDS_BAR();
    {
        const int nc = nt * 16 + 4 * fq;
        f32x4 wt[4];
#pragma unroll
        for (int w = 0; w < 4; ++w) wt[w] = *(const LAS f32x4*)(L + S1_WTOT + (w * 64 + nc) * 4);
        const f32x4 tot = ((wt[0] + wt[1]) + wt[2]) + wt[3];
        if (th == 0 && fr == 0) *(LAS f32x4*)(L + S1_LC + nc * 4) = tot;
#pragma unroll
        for (int i = 0; i < 2; ++i) { const int tti = 2 * th + i, t = 16 * tti + fr;
            const f32x4 na = *(const LAS f32x4*)(L + S1_NRM + t * 16);
            const float n2 = (na[0] + na[1]) + (na[2] + na[3]);
            const float inv = __builtin_amdgcn_rsqf(fmaxf(n2, 1e-24f));
            if (nt == 0 && fq == 0) { const f32x4 ra = *(const LAS f32x4*)(L + S1_RKX + t * 16); ((float*)(F.ws + WS_RKB))[(size_t)(row0 + t) * 8 + h] = (ra[0] + ra[1]) + (ra[2] + ra[3]); }
            f32x4 off = (f32x4){0.f, 0.f, 0.f, 0.f};
#pragma unroll
            for (int w = 0; w < 3; ++w) if (w < tti) off = off + wt[w];
            f32x4 rt, kt, at, bt;
#pragma unroll
            for (int j = 0; j < 4; ++j) { const float Lc = cs[i][j] + off[j];
                const float eL = __builtin_amdgcn_exp2f(Lc), eN = __builtin_amdgcn_exp2f(-Lc), eP = __builtin_amdgcn_exp2f(Lc - lw[i][j]); const float kkn = kk[i][j] * inv;
                rt[j] = r4[i][j] * eL; kt[j] = km[i][j] * eN; at[j] = -kkn * eP; bt[j] = kkn * av[i][j] * eN; }
            const int on = (t * 72 + nc) * 2;
            *(LAS u32x2*)(L + S1_RT + on) = pk4f(rt); *(LAS u32x2*)(L + S1_AT + on) = pk4f(at); *(LAS u32x2*)(L + S1_BT + on) = pk4f(bt); *(LAS u32x2*)(L + S1_KT + on) = pk4f(kt); *(LAS u32x2*)(L + S1_VN + on) = pk4f(vm[i]); }
    }
    LDS_BAR();
    f32x4 rhs[4];
    {
        const int mi = wave >> 1, par = wave & 1;
        const int xo = (mi < 2) ? S1_AT : S1_RT, yo = (mi & 1) ? S1_KT : S1_BT, dst = S1_AAB + mi * 9216;
        int idx = 0;
#pragma unroll
        for (int ti = 0; ti < 4; ++ti)
#pragma unroll
            for (int si = 0; si < 4; ++si, ++idx) {
                if ((idx & 1) != par) continue;
                u32x2 w = {0u, 0u};
                if (si <= ti) {
                    f32x4 acc = (f32x4){0.f, 0.f, 0.f, 0.f};
#pragma unroll
                    for (int ks = 0; ks < 2; ++ks) acc = MFMA16(LD_F8(L + yo + ((si * 16 + fr) * 72 + ks * 32 + fq * 8) * 2), LD_F8(L + xo + ((ti * 16 + fr) * 72 + ks * 32 + fq * 8) * 2), acc);
                    if (si == ti) {
#pragma unroll
                        for (int j = 0; j < 4; ++j) { const int sl = 4 * fq + j; const bool keep = (mi < 2) ? (sl < fr) : (sl <= fr); acc[j] = keep ? acc[j] : 0.f; }
                    }
                    w = pk4f(acc);
                }
                *(LAS u32x2*)(L + dst + ((ti * 16 + fr) * 72 + si * 16 + 4 * fq) * 2) = w;
            }
    }
    if (wave < 4) {
        const f32x4 z4 = (f32x4){0.f, 0.f, 0.f, 0.f};
        f32x4 va = z4, ua = z4;
#pragma unroll
        for (int ks = 0; ks < 2; ++ks) { const bf16x8 fA = LD_F8(L + S1_AT + ((wave * 16 + fr) * 72 + ks * 32 + fq * 8) * 2), fB = LD_F8(L + S1_BT + ((wave * 16 + fr) * 72 + ks * 32 + fq * 8) * 2);
            va = MFMA16(fB, fA, va); ua = MFMA16(fA, fB, ua); }
#pragma unroll
        for (int j = 0; j < 4; ++j) { va[j] = (4 * fq + j < fr) ? va[j] : 0.f; ua[j] = (fr < 4 * fq + j) ? ua[j] : 0.f; }
        const u32x2 v0 = pk4f(va), u0 = pk4f(ua);
        f32x4 w1 = up4(v0);
#pragma unroll
        for (int j = 0; j < 4; ++j) w1[j] += (4 * fq + j == fr) ? 1.0f : 0.0f;
        const u32x2 w1p = pk4f(w1);
        const u32x2 u1 = pk4f(MFMA16(mk8h(v0), mk8h(u0), z4)), v1 = pk4f(MFMA16(mk8h(u0), mk8h(v0), z4));
        const f32x4 w2 = MFMA16(mk8h(u1), mk8h(w1p), w1); const u32x2 w2p = pk4f(w2);
        const u32x2 u2 = pk4f(MFMA16(mk8h(v1), mk8h(u1), z4)), v2 = pk4f(MFMA16(mk8h(u1), mk8h(v1), z4));
        const f32x4 w3 = MFMA16(mk8h(u2), mk8h(w2p), w2); const u32x2 w3p = pk4f(w3);
        const u32x2 u3 = pk4f(MFMA16(mk8h(v2), mk8h(u2), z4));
        const f32x4 w4 = MFMA16(mk8h(u3), mk8h(w3p), w3);
        *(LAS u32x2*)(L + S1_TII + ((wave * 16 + fr) * 24 + 4 * fq) * 2) = pk4f(w4);
#pragma unroll
        for (int i = 0; i < 4; ++i) rhs[i] = up4(tr_read(tr_addr(L + S1_AT, 16 * i + 4 * fq, wave * 16, lane)));
    }
    if (tid < 384) *(LAS float*)(L + S1_CV + ((hn & 1) * 384 + tid) * 4) = cvn;
    s1_issue(F, l, gchunk, hn, nxt);
    LDS_BAR();
    {
        if (wave >= 4) {
            bf16x8 vfr2[2];
#pragma unroll
            for (int ks = 0; ks < 2; ++ks) vfr2[ks] = tr_frag(L + S1_VN, (wave - 4) * 16, ks, lane);
#pragma unroll
            for (int i = 0; i < 4; ++i) { f32x4 acc = (f32x4){0.f, 0.f, 0.f, 0.f};
#pragma unroll
                for (int ks = 0; ks < 2; ++ks) acc = MFMA16(LD_F8(L + S1_AAK + ((i * 16 + fr) * 72 + ks * 32 + fq * 8) * 2), vfr2[ks], acc);
                rhs[i] = acc; }
        }
        const f32x4 z4 = (f32x4){0.f, 0.f, 0.f, 0.f};
        u32x2 sp[4];
#define TII_FRAG(i) mk8h(*(const LAS u32x2*)(L + S1_TII + (((i) * 16 + fr) * 24 + 4 * fq) * 2))
#define AAB_P(i, j0) (*(const LAS u32x2*)(L + S1_AAB + (((i) * 16 + fr) * 72 + (j0) * 16 + 4 * fq) * 2))
        const u32x2 z2 = {0u, 0u};
        sp[0] = pk4f(MFMA16(TII_FRAG(0), mk8h(pk4f(rhs[0])), z4));
        { const u32x2 a = AAB_P(1, 0); const f32x4 a1 = MFMA16(mk8(a.x, a.y, 0u, 0u), mk8h(sp[0]), rhs[1]); sp[1] = pk4f(MFMA16(TII_FRAG(1), mk8h(pk4f(a1)), z4)); }
        { const u32x2 a = AAB_P(2, 0), b = AAB_P(2, 1); const f32x4 a2 = MFMA16(mk8(a.x, a.y, b.x, b.y), mk8(sp[0].x, sp[0].y, sp[1].x, sp[1].y), rhs[2]); sp[2] = pk4f(MFMA16(TII_FRAG(2), mk8h(pk4f(a2)), z4)); }
        { const u32x2 a = AAB_P(3, 0), b = AAB_P(3, 1), c = AAB_P(3, 2); f32x4 a3 = MFMA16(mk8(a.x, a.y, b.x, b.y), mk8(sp[0].x, sp[0].y, sp[1].x, sp[1].y), rhs[3]);
          a3 = MFMA16(mk8(c.x, c.y, 0u, 0u), mk8h(sp[2]), a3); sp[3] = pk4f(MFMA16(TII_FRAG(3), mk8h(pk4f(a3)), z4)); }
        (void)z2;
#undef TII_FRAG
#undef AAB_P
        const int dsto = (wave < 4) ? (S1_MT + ((wave * 16 + fr) * 72) * 2) : (S1_XT + (((wave - 4) * 16 + fr) * 72) * 2);
#pragma unroll
        for (int i = 0; i < 4; ++i) *(LAS u32x2*)(L + dsto + (16 * i + 4 * fq) * 2) = sp[i];
    }
    LDS_BAR();
    {
        bf16* ZB = (bf16*)(F.ws + WS_ZB) + (size_t)unit * 4096; bf16* Y0B = (bf16*)(F.ws + WS_Y0B) + (size_t)unit * 4096;
        bf16* PTB = (bf16*)(F.ws + WS_PTB) + (size_t)unit * 4096; bf16* QB = (bf16*)(F.ws + WS_QB) + (size_t)unit * 4096;
        const int ta = wave >> 1;
        const int ra = ((ta * 16 + fr) * 72 + fq * 8) * 2;
        bf16x8 fmt[2], fxt[2], fvn[2], fbt[2], fkt[2];
#pragma unroll
        for (int ks = 0; ks < 2; ++ks) { fmt[ks] = LD_F8(L + S1_MT + ra + ks * 64); fxt[ks] = LD_F8(L + S1_XT + ra + ks * 64); fvn[ks] = tr_frag(L + S1_VN, ta * 16, ks, lane); fbt[ks] = tr_frag(L + S1_BT, ta * 16, ks, lane); fkt[ks] = tr_frag(L + S1_KT, ta * 16, ks, lane); }
        const f32x4 lc = *(const LAS f32x4*)(L + S1_LC + (ta * 16 + 4 * fq) * 4);
#pragma unroll
        for (int ii = 0; ii < 2; ++ii) { const int tb = (wave & 1) * 2 + ii;
            const int rb = ((tb * 16 + fr) * 72 + fq * 8) * 2;
            const int so = ((ta * 4 + tb) * 64 + lane) * 4;
            bf16x8 frb[2], frk[2], fbc[2], fxc[2], fvc[2];
#pragma unroll
            for (int ks = 0; ks < 2; ++ks) { frb[ks] = LD_F8(L + S1_ARB + rb + ks * 64); frk[ks] = LD_F8(L + S1_ARK + rb + ks * 64); fbc[ks] = tr_frag(L + S1_BT, tb * 16, ks, lane); fxc[ks] = LD_F8(L + S1_XT + rb + ks * 64); fvc[ks] = tr_frag(L + S1_VN, tb * 16, ks, lane); }
            {
                f32x4 acc = (f32x4){0.f, 0.f, 0.f, 0.f};
#pragma unroll
                for (int ks = 0; ks < 2; ++ks) acc = MFMA16(fmt[ks], frb[ks], acc);
                acc = acc + up4(*(const LAS u32x2*)(L + S1_RT + ((tb * 16 + fr) * 72 + ta * 16 + 4 * fq) * 2));
                *(u32x2*)(ZB + so) = pk4f(acc); }
            {
                f32x4 acc = (f32x4){0.f, 0.f, 0.f, 0.f};
#pragma unroll
                for (int ks = 0; ks < 2; ++ks) { acc = MFMA16(fxt[ks], frb[ks], acc); acc = MFMA16(fvn[ks], frk[ks], acc); }
                *(u32x2*)(Y0B + so) = pk4f(acc); }
            {
                f32x4 acc = (f32x4){0.f, 0.f, 0.f, 0.f};
#pragma unroll
                for (int ks = 0; ks < 2; ++ks) acc = MFMA16(fmt[ks], fbc[ks], acc);
                const float dn = __builtin_amdgcn_exp2f(*(const LAS float*)(L + S1_LC + (tb * 16 + fr) * 4));
#pragma unroll
                for (int j = 0; j < 4; ++j) acc[j] = (acc[j] + ((ta == tb && 4 * fq + j == fr) ? 1.0f : 0.0f)) * dn;
                *(u32x2*)(PTB + so) = pk4f(acc); }
            {
                f32x4 acc = (f32x4){0.f, 0.f, 0.f, 0.f};
#pragma unroll
                for (int ks = 0; ks < 2; ++ks) { acc = MFMA16(fbt[ks], fxc[ks], acc); acc = MFMA16(fkt[ks], fvc[ks], acc); }
#pragma unroll
                for (int j = 0; j < 4; ++j) acc[j] *= __builtin_amdgcn_exp2f(lc[j]);
                *(u32x2*)(QB + so) = pk4f(acc); }
        }
    }
}
struct S2Buf { bf16x8 pa[4][2]; u32x4 q0, q1; };
DI void s2_load(S2Buf& B, const bf16* PT, const bf16* Q, const int fr, const int fq, const int vs) {
#pragma unroll
    for (int io = 0; io < 4; ++io)
#pragma unroll
        for (int kb = 0; kb < 2; ++kb) { const u32x2 lo = *(const u32x2*)(PT + (((2 * kb) * 4 + io) * 64 + fr + 16 * fq) * 4), hi = *(const u32x2*)(PT + (((2 * kb + 1) * 4 + io) * 64 + fr + 16 * fq) * 4);
            B.pa[io][kb] = mk8(lo.x, lo.y, hi.x, hi.y); }
    { const u32x2 a = *(const u32x2*)(Q + ((0 * 4 + vs) * 64 + fr + 16 * fq) * 4), b = *(const u32x2*)(Q + ((1 * 4 + vs) * 64 + fr + 16 * fq) * 4), c = *(const u32x2*)(Q + ((2 * 4 + vs) * 64 + fr + 16 * fq) * 4), d = *(const u32x2*)(Q + ((3 * 4 + vs) * 64 + fr + 16 * fq) * 4);
      B.q0 = (u32x4){a.x, a.y, b.x, b.y}; B.q1 = (u32x4){c.x, c.y, d.x, d.y}; }
    PIN_MEM();
}
DI void s2_step(const S2Buf& B, f32x4 (&acc)[4], bf16* SBu, const int fr, const int fq, const int vs) {
    u32x4 bw[2];
#pragma unroll
    for (int kb = 0; kb < 2; ++kb) { bw[kb].x = pk2(acc[2 * kb][0], acc[2 * kb][1]); bw[kb].y = pk2(acc[2 * kb][2], acc[2 * kb][3]); bw[kb].z = pk2(acc[2 * kb + 1][0], acc[2 * kb + 1][1]); bw[kb].w = pk2(acc[2 * kb + 1][2], acc[2 * kb + 1][3]);
        *(u32x4*)(SBu + ((vs * 2 + kb) * 64 + fr + 16 * fq) * 8) = bw[kb]; }
    const unsigned qw[8] = {B.q0.x, B.q0.y, B.q0.z, B.q0.w, B.q1.x, B.q1.y, B.q1.z, B.q1.w};
#pragma unroll
    for (int io = 0; io < 4; ++io) { f32x4 c = (f32x4){bflo(qw[2 * io]), bfhi(qw[2 * io]), bflo(qw[2 * io + 1]), bfhi(qw[2 * io + 1])};
#pragma unroll
        for (int kb = 0; kb < 2; ++kb) c = MFMA16(B.pa[io][kb], __builtin_bit_cast(bf16x8, bw[kb]), c);
        acc[io] = c; }
    PIN_MEM();
}
constexpr int S2_RING = 8, S2_SLOT = 12288, S2_FLAGS = S2_RING * S2_SLOT, S2_CVSCR = S2_FLAGS + 1024;
static_assert(S2_CVSCR + 5 * 9216 <= MISC_OFF, "S2 lds map");
struct S2Ring { bf16x8 pa[4][2]; f32x4 qf[4]; };
DI void s2_put(const S2Buf& B, const int c, LAS unsigned char* lds, const int lane) {
    volatile LAS int* fl = (volatile LAS int*)(lds + S2_FLAGS);
    unsigned sp = 0; while (c - fl[1] >= S2_RING) { __builtin_amdgcn_s_sleep(1); if (++sp > (1u << 22)) break; }
    asm volatile("" ::: "memory");
    LAS unsigned char* slot = lds + (c & (S2_RING - 1)) * S2_SLOT + lane * 16;
#pragma unroll
    for (int io = 0; io < 4; ++io)
#pragma unroll
        for (int kb = 0; kb < 2; ++kb) *(LAS bf16x8*)(slot + (io * 2 + kb) * 1024) = B.pa[io][kb];
    const unsigned qw[8] = {B.q0.x, B.q0.y, B.q0.z, B.q0.w, B.q1.x, B.q1.y, B.q1.z, B.q1.w};
#pragma unroll
    for (int io = 0; io < 4; ++io) *(LAS f32x4*)(slot + (8 + io) * 1024) = (f32x4){bflo(qw[2 * io]), bfhi(qw[2 * io]), bflo(qw[2 * io + 1]), bfhi(qw[2 * io + 1])};
    LDS_WAIT(); asm volatile("" ::: "memory");
    sp = 0; while (fl[0] != c) { __builtin_amdgcn_s_sleep(1); if (++sp > (1u << 22)) break; }
    if (lane == 0) fl[0] = c + 1;
}
DI void s2_get_issue(S2Ring& R, const int c, int& avail, LAS unsigned char* lds, const int lane) {
    volatile LAS int* fl = (volatile LAS int*)(lds + S2_FLAGS);
    if (avail <= c) { unsigned sp = 0; while ((avail = fl[0]) <= c) { __builtin_amdgcn_s_sleep(1); if (++sp > (1u << 22)) break; } }
    asm volatile("" ::: "memory");
    const LAS unsigned char* slot = lds + (c & (S2_RING - 1)) * S2_SLOT + lane * 16;
#pragma unroll
    for (int io = 0; io < 4; ++io)
#pragma unroll
        for (int kb = 0; kb < 2; ++kb) R.pa[io][kb] = *(const LAS bf16x8*)(slot + (io * 2 + kb) * 1024);
#pragma unroll
    for (int io = 0; io < 4; ++io) R.qf[io] = *(const LAS f32x4*)(slot + (8 + io) * 1024);
}
DI void s2_step_r(const S2Ring& R, f32x4 (&acc)[4], bf16* SBu, const int fr, const int fq, const int vs) {
    u32x4 bw[2];
#pragma unroll
    for (int kb = 0; kb < 2; ++kb) { bw[kb].x = pk2(acc[2 * kb][0], acc[2 * kb][1]); bw[kb].y = pk2(acc[2 * kb][2], acc[2 * kb][3]); bw[kb].z = pk2(acc[2 * kb + 1][0], acc[2 * kb + 1][1]); bw[kb].w = pk2(acc[2 * kb + 1][2], acc[2 * kb + 1][3]);
        *(u32x4*)(SBu + ((vs * 2 + kb) * 64 + fr + 16 * fq) * 8) = bw[kb]; }
#pragma unroll
    for (int io = 0; io < 4; ++io) { f32x4 c = R.qf[io];
#pragma unroll
        for (int kb = 0; kb < 2; ++kb) c = MFMA16(R.pa[io][kb], __builtin_bit_cast(bf16x8, bw[kb]), c);
        acc[io] = c; }
}
DI void s2_phase(Frame& F, const int l) {
    if (F.wg < 128 && threadIdx.x == 0) { volatile LAS int* fl = (volatile LAS int*)(F.lds + S2_FLAGS); fl[0] = 0; fl[1] = 0; }
    LDS_BAR();
    if (F.wg >= 128 || F.wave >= 3) {
        const int widx = (F.wg < 128) ? F.wg * 5 + (F.wave - 3) : 640 + (F.wg - 128) * 8 + F.wave;
        LAS float* scr = (F.wg < 128) ? (LAS float*)(F.lds + S2_CVSCR + (F.wave - 3) * 9216) : (LAS float*)(F.lds + F.wave * 16384);
        if (l == 0) convert_main<1>(F, widx, 1664, scr); else moe_weight_convert<0>(F, widx, 1664, scr);
        return;
    }
    const int seq = F.wg >> 2, vs = F.wg & 3, b = seq >> 3, h = seq & 7, lane = (int)threadIdx.x & 63, fr = lane & 15, fq = lane >> 4;
    const bf16* PTB = (const bf16*)(F.ws + WS_PTB); const bf16* QB = (const bf16*)(F.ws + WS_QB); bf16* SB = (bf16*)(F.ws + WS_SB);
    const size_t u0 = ((size_t)b * 128 * 8 + h) * 4096;
    if (F.wave >= 1) {
        const size_t uj = u0 + (size_t)(F.wave - 1) * 32768;
        S2Buf B0, B1, B2, B3;
        s2_load(B0, PTB + uj, QB + uj, fr, fq, vs); s2_load(B1, PTB + uj + 2 * 32768, QB + uj + 2 * 32768, fr, fq, vs); s2_load(B2, PTB + uj + 4 * 32768, QB + uj + 4 * 32768, fr, fq, vs);
        s2_load(B3, PTB + uj + 6 * 32768, QB + uj + 6 * 32768, fr, fq, vs);
#pragma unroll 1
        for (int c = F.wave - 1; c < 128; c += 8) {
            const size_t un = u0 + (size_t)((c + 8 < 128) ? c + 8 : c) * 32768;
            s2_put(B0, c, F.lds, lane); s2_load(B0, PTB + un, QB + un, fr, fq, vs);
            s2_put(B1, c + 2, F.lds, lane); s2_load(B1, PTB + un + 2 * 32768, QB + un + 2 * 32768, fr, fq, vs);
            s2_put(B2, c + 4, F.lds, lane); s2_load(B2, PTB + un + 4 * 32768, QB + un + 4 * 32768, fr, fq, vs);
            s2_put(B3, c + 6, F.lds, lane); s2_load(B3, PTB + un + 6 * 32768, QB + un + 6 * 32768, fr, fq, vs);
        }
        return;
    }
    f32x4 acc[4];
#pragma unroll
    for (int i = 0; i < 4; ++i) acc[i] = (f32x4){0.f, 0.f, 0.f, 0.f};
    volatile LAS int* fl = (volatile LAS int*)(F.lds + S2_FLAGS);
    S2Ring Ra, Rb; int avail = 0;
    s2_get_issue(Ra, 0, avail, F.lds, lane);
#pragma unroll 1
    for (int c = 0; c < 128; c += 2) {
        const size_t uc = u0 + (size_t)c * 32768;
        LDS_WAIT();
        s2_get_issue(Rb, c + 1, avail, F.lds, lane);
        s2_step_r(Ra, acc, SB + uc, fr, fq, vs);
        LDS_WAIT();
        if (lane == 0) fl[1] = c + 1;
        if (c + 2 < 128) s2_get_issue(Ra, c + 2, avail, F.lds, lane);
        s2_step_r(Rb, acc, SB + uc + 32768, fr, fq, vs);
        if (lane == 0) fl[1] = c + 2;
    }
}
DI void s3_phase(Frame& F, const int l) {
    const int fr = ((int)threadIdx.x & 63) & 15, fq = ((int)threadIdx.x & 63) >> 4;
    const bf16* VM = (const bf16*)(F.ws + (l == 0 ? WS_VF : WS_VMB)); const bf16* GB = (const bf16*)(F.ws + WS_GB); const float* RKB = (const float*)(F.ws + WS_RKB);
    bf16* mix = (bf16*)(F.ws + WS_MIX);
    LAS unsigned char* otile = F.lds + F.wave * 9216;
    for (int u = F.wg * NWAVES + F.wave; u < (M / 64) * NH; u += F.G * NWAVES) {
        const int gchunk = u >> 3, h = u & 7, row0 = gchunk * 64;
        const bf16* SBu = (const bf16*)(F.ws + WS_SB) + (size_t)u * 4096; const bf16* ZBu = (const bf16*)(F.ws + WS_ZB) + (size_t)u * 4096; const bf16* Y0u = (const bf16*)(F.ws + WS_Y0B) + (size_t)u * 4096;
        bf16x8 sa[4][2], zf[4][2]; u32x4 y0a[4], y0b[4]; float rkv[4];
#pragma unroll
        for (int vt = 0; vt < 4; ++vt)
#pragma unroll
            for (int kb = 0; kb < 2; ++kb) sa[vt][kb] = *(const bf16x8*)(SBu + ((vt * 2 + kb) * 64 + fr + 16 * fq) * 8);
#pragma unroll
        for (int tt = 0; tt < 4; ++tt) { const int t = 16 * tt + fr, lo_ = (tt * 64 + fr + 16 * fq) * 4;
            const u32x2 z0 = *(const u32x2*)(ZBu + lo_), z1 = *(const u32x2*)(ZBu + lo_ + 1024), z2 = *(const u32x2*)(ZBu + lo_ + 2048), z3 = *(const u32x2*)(ZBu + lo_ + 3072);
            zf[tt][0] = mk8(z0.x, z0.y, z1.x, z1.y); zf[tt][1] = mk8(z2.x, z2.y, z3.x, z3.y);
            const u32x2 w0 = *(const u32x2*)(Y0u + lo_), w1 = *(const u32x2*)(Y0u + lo_ + 1024), w2 = *(const u32x2*)(Y0u + lo_ + 2048), w3 = *(const u32x2*)(Y0u + lo_ + 3072);
            y0a[tt] = (u32x4){w0.x, w0.y, w1.x, w1.y}; y0b[tt] = (u32x4){w2.x, w2.y, w3.x, w3.y}; rkv[tt] = RKB[(size_t)(row0 + t) * 8 + h]; }
        f32x4 gg[4], gb[4];
#pragma unroll
        for (int vt = 0; vt < 4; ++vt) { gg[vt] = *(const f32x4*)(F.A->in[I_GNG] + l * RW + h * 64 + 16 * vt + 4 * fq); gb[vt] = *(const f32x4*)(F.A->in[I_GNB] + l * RW + h * 64 + 16 * vt + 4 * fq); }
        PIN_MEM();
#pragma unroll
        for (int tt = 0; tt < 4; ++tt) {
            const int t = 16 * tt + fr;
            u32x2 vmr[4], ggr[4];
#pragma unroll
            for (int vt = 0; vt < 4; ++vt) { const size_t o = (size_t)u * 4096 + ((vt * 4 + tt) * 64 + fr + 16 * fq) * 4; vmr[vt] = *(const u32x2*)(VM + o); ggr[vt] = *(const u32x2*)(GB + o); }
            const unsigned yw[8] = {y0a[tt].x, y0a[tt].y, y0a[tt].z, y0a[tt].w, y0b[tt].x, y0b[tt].y, y0b[tt].z, y0b[tt].w};
            f32x4 y[4]; float s = 0.f;
#pragma unroll
            for (int vt = 0; vt < 4; ++vt) { f32x4 c = (f32x4){bflo(yw[2 * vt]), bfhi(yw[2 * vt]), bflo(yw[2 * vt + 1]), bfhi(yw[2 * vt + 1])};
                c = MFMA16(sa[vt][0], zf[tt][0], c); c = MFMA16(sa[vt][1], zf[tt][1], c); y[vt] = c; s += (c[0] + c[1]) + (c[2] + c[3]); }
            s += __shfl_xor(s, 16); s += __shfl_xor(s, 32);
            const float mean = s * (1.f / 64.f); float q = 0.f;
#pragma unroll
            for (int vt = 0; vt < 4; ++vt) { y[vt] = y[vt] - mean; q += (y[vt][0] * y[vt][0] + y[vt][1] * y[vt][1]) + (y[vt][2] * y[vt][2] + y[vt][3] * y[vt][3]); }
            q += __shfl_xor(q, 16); q += __shfl_xor(q, 32);
            const float rstd = 1.0f / sqrtf(q * (1.f / 64.f) + GN_EPS);
            const float rk = rkv[tt];
#pragma unroll
            for (int vt = 0; vt < 4; ++vt) {
                const f32x4 vv = (f32x4){bflo(vmr[vt].x), bfhi(vmr[vt].x), bflo(vmr[vt].y), bfhi(vmr[vt].y)}, gv = (f32x4){bflo(ggr[vt].x), bfhi(ggr[vt].x), bflo(ggr[vt].y), bfhi(ggr[vt].y)};
                const f32x4 ov = (y[vt] * rstd * gg[vt] + gb[vt] + vv * rk) * gv;
                u32x2 w; w.x = pk2(ov[0], ov[1]); w.y = pk2(ov[2], ov[3]);
                *(LAS u32x2*)(otile + t * 144 + (16 * vt + 4 * fq) * 2) = w; }
        }
        LDS_WAIT(); asm volatile("" ::: "memory");
#pragma unroll
        for (int p = 0; p < 8; ++p) { const int rr = p * 8 + (((int)threadIdx.x & 63) >> 3), pc = ((int)threadIdx.x & 63) & 7;
            const u32x4 v = *(const LAS u32x4*)(otile + rr * 144 + pc * 16);
            *(u32x4*)(mix + (size_t)(row0 + rr) * D + 512 + h * 64 + pc * 8) = v; }
        LDS_WAIT(); asm volatile("" ::: "memory");
    }
}

DI void norm2_router_phase(Frame& F, const bf16* hsrc, const float* g, const float* router) {
    LAS float* RT = (LAS float*)F.lds;
    LAS int* E01 = (LAS int*)(F.lds + 131072);
    for (int i = ((int)threadIdx.x); i < 2048; i += NTHR) { const int col = i >> 1, half = i & 1; *(LAS f32x4*)(RT + ((((col >> 8) * 4 + (col & 3)) * 2 + half) * 64 + ((col & 255) >> 2)) * 4) = *(const f32x4*)(router + i * 4); }
    __syncthreads();
    unsigned char* hn = F.ws + WS_HN;
    int* tke = (int*)(F.ws + TB_TKE); float* tkg = (float*)(F.ws + TB_TKG);
    const int lane = (int)threadIdx.x & 63, mb = F.wg * 128 + F.wave * 16;
    f32x4 gg[4];
#pragma unroll
    for (int j = 0; j < 4; ++j) gg[j] = ((const f32x4*)g + lane)[64 * j];
    u32x2 cr[2][4], nr[2][4];
#pragma unroll
    for (int q = 0; q < 2; ++q)
#pragma unroll
        for (int j = 0; j < 4; ++j) cr[q][j] = ((const u32x2*)(hsrc + (size_t)(mb + q) * D) + lane)[64 * j];
#pragma unroll 1
    for (int i = 0; i < 16; i += 2) {
        const int in = (i + 2 < 16) ? i + 2 : i;
#pragma unroll
        for (int q = 0; q < 2; ++q)
#pragma unroll
            for (int j = 0; j < 4; ++j) nr[q][j] = ((const u32x2*)(hsrc + (size_t)(mb + in + q) * D) + lane)[64 * j];
        f32x4 y[2][4]; float ss[2] = {0.f, 0.f};
#pragma unroll
        for (int q = 0; q < 2; ++q)
#pragma unroll
            for (int j = 0; j < 4; ++j) { const u32x2 v = cr[q][j]; y[q][j] = (f32x4){bflo(v.x), bfhi(v.x), bflo(v.y), bfhi(v.y)}; ss[q] += (y[q][j].x * y[q][j].x + y[q][j].y * y[q][j].y) + (y[q][j].z * y[q][j].z + y[q][j].w * y[q][j].w); }
#pragma unroll
        for (int q = 0; q < 2; ++q) { const float rstd = 1.0f / sqrtf(wave_sum(ss[q]) * (1.f / D) + RMS_EPS);
#pragma unroll
            for (int j = 0; j < 4; ++j) y[q][j] = y[q][j] * rstd * gg[j];
            store_row_f8(hn + (size_t)(mb + i + q) * D, lane, y[q]); }
        float lg[2][8];
#pragma unroll
        for (int q = 0; q < 2; ++q)
#pragma unroll
            for (int e = 0; e < 8; ++e) lg[q][e] = 0.f;
#pragma unroll
        for (int j = 0; j < 4; ++j)
#pragma unroll
            for (int k = 0; k < 4; ++k) { const LAS f32x4* rp = (const LAS f32x4*)RT + (j * 4 + k) * 128 + lane; const f32x4 r0 = rp[0], r1 = rp[64];
#pragma unroll
                for (int q = 0; q < 2; ++q) { const float x = y[q][j][k];
                    lg[q][0] += x * r0[0]; lg[q][1] += x * r0[1]; lg[q][2] += x * r0[2]; lg[q][3] += x * r0[3]; lg[q][4] += x * r1[0]; lg[q][5] += x * r1[1]; lg[q][6] += x * r1[2]; lg[q][7] += x * r1[3]; } }
#pragma unroll
        for (int q = 0; q < 2; ++q)
#pragma unroll
            for (int e = 0; e < 8; ++e) lg[q][e] = wave_sum(lg[q][e]);
        if (lane == 0) {
#pragma unroll
            for (int q = 0; q < 2; ++q) { const int lt = F.wave * 16 + i + q, m = mb + i + q;
                int e0 = 0; float v0 = lg[q][0];
#pragma unroll
                for (int e = 1; e < 8; ++e) if (lg[q][e] > v0) { v0 = lg[q][e]; e0 = e; }
                int e1 = -1; float v1 = -3.0e38f;
#pragma unroll
                for (int e = 0; e < 8; ++e) if (e != e0 && lg[q][e] > v1) { v1 = lg[q][e]; e1 = e; }
                const float g0 = 1.0f / (1.0f + __expf(v1 - v0));
                tke[m] = e0; tke[M + m] = e1; tkg[m] = g0; tkg[M + m] = 1.0f - g0;
                E01[lt] = e0; E01[128 + lt] = e1; }
        }
#pragma unroll
        for (int q = 0; q < 2; ++q)
#pragma unroll
            for (int j = 0; j < 4; ++j) cr[q][j] = nr[q][j];
    }
    if (F.wg == 0) for (int i = ((int)threadIdx.x); i < D / 4; i += NTHR) ((unsigned*)(hn + (size_t)M * D))[i] = 0u;
    __syncthreads();
    if (((int)threadIdx.x) < 16) { const int s = ((int)threadIdx.x) >> 3, e = ((int)threadIdx.x) & 7; int c = 0; for (int i = 0; i < 128; ++i) c += (E01[s * 128 + i] == e) ? 1 : 0; ((int*)(F.ws + TB_CNT))[F.wg * 16 + ((int)threadIdx.x)] = c; }
}
DI void moe_dispatch_phase(Frame& F) {
    LAS int* C = (LAS int*)F.lds;
    LAS int* TOT = C + 4096; LAS int* MINE = TOT + 16; LAS int* START = MINE + 16; LAS int* PAD = START + 16; LAS int* EL = PAD + 16;
    const int* cnt = (const int*)(F.ws + TB_CNT);
    { const int k = ((int)threadIdx.x) & 15, part = ((int)threadIdx.x) >> 4; int tot = 0, mine = 0;
#pragma unroll
      for (int j = 0; j < 8; ++j) { const int w = part * 8 + j, c = cnt[w * 16 + k]; tot += c; mine += (w < F.wg) ? c : 0; }
      C[part * 16 + k] = tot; C[512 + part * 16 + k] = mine; }
    __syncthreads();
    if (((int)threadIdx.x) < 16) { int tot = 0, mine = 0; for (int p = 0; p < 32; ++p) { tot += C[p * 16 + ((int)threadIdx.x)]; mine += C[512 + p * 16 + ((int)threadIdx.x)]; } TOT[((int)threadIdx.x)] = tot; MINE[((int)threadIdx.x)] = mine; }
    __syncthreads();
    if (((int)threadIdx.x) == 0) { int acc = 0; for (int k = 0; k < 16; ++k) { START[k] = acc; const int p = (TOT[k] + 255) & ~255; PAD[k] = p; acc += p; } }
    const int* tke = (const int*)(F.ws + TB_TKE); const float* tkg = (const float*)(F.ws + TB_TKG);
    int* rowtok = (int*)(F.ws + TB_ROWTOK); float* rowgate = (float*)(F.ws + TB_ROWGATE);
    if (((int)threadIdx.x) < 256) EL[((int)threadIdx.x)] = tke[(((int)threadIdx.x) >> 7) * M + F.wg * 128 + (((int)threadIdx.x) & 127)];
    __syncthreads();
    if (((int)threadIdx.x) < 256) { const int s = ((int)threadIdx.x) >> 7, i = ((int)threadIdx.x) & 127, e = EL[((int)threadIdx.x)]; int rank = 0; for (int j = 0; j < i; ++j) rank += (EL[s * 128 + j] == e) ? 1 : 0;
        const int dest = START[s * 8 + e] + MINE[s * 8 + e] + rank, tok = F.wg * 128 + i;
        rowtok[dest] = tok; rowgate[dest] = tkg[s * M + tok]; }
    if (F.wg < 16) { const int k = F.wg; for (int r = START[k] + TOT[k] + ((int)threadIdx.x); r < START[k] + PAD[k]; r += NTHR) { rowtok[r] = -1; rowgate[r] = 0.f; } }
    if (F.wg == 0) {
        int* tile_e = (int*)(F.ws + TB_TILEE); int* ntiles = (int*)(F.ws + TB_NTILES);
        if (((int)threadIdx.x) < 2 * MOE_TILES) { const int r = ((int)threadIdx.x) * 256; int e = 0; for (int k = 0; k < 16; ++k) if (r >= START[k]) e = k & 7; tile_e[((int)threadIdx.x)] = e; }
        if (((int)threadIdx.x) == 0) { const int n0 = START[8] >> 8; ntiles[0] = n0; ntiles[1] = ((START[15] + PAD[15]) >> 8) - n0; }
    }
}

__device__ __attribute__((noinline)) void moe_dn_combine(const int wg, const int nM, const int G, float* part, unsigned* cnt, const bf16* hin, bf16* hout, const int* row_tok, const float* row_gate, const float sc) {
    pg8::OrderBase S; S.init(nM, D / 256, G, wg);
    const int main = (S.nwg / S.G) * S.G, left = S.nwg - main;
    if (wg >= pg8::DN_KSPLIT * left) return;
    const int j = wg / pg8::DN_KSPLIT, q = wg % pg8::DN_KSPLIT, tid = (int)threadIdx.x;
    pg8::Unit u; S.map((long)main + j, u);
    asm volatile("s_waitcnt vmcnt(0)" ::: "memory");
    __syncthreads();
    if (tid == 0) { __builtin_amdgcn_fence(__ATOMIC_RELEASE, "agent"); asm volatile("s_waitcnt vmcnt(0)" ::: "memory"); __hip_atomic_fetch_add(cnt + 64 * j, 1u, __ATOMIC_RELAXED, __HIP_MEMORY_SCOPE_AGENT);
        unsigned sp = 0; while (__hip_atomic_load(cnt + 64 * j, __ATOMIC_RELAXED, __HIP_MEMORY_SCOPE_AGENT) < (unsigned)pg8::DN_KSPLIT) { __builtin_amdgcn_s_sleep(2); if (++sp > (1u << 22)) break; }
        __builtin_amdgcn_fence(__ATOMIC_ACQUIRE, "agent"); asm volatile("s_waitcnt vmcnt(0)" ::: "memory"); }
    __syncthreads();
    constexpr int KS = pg8::DN_KSPLIT, RPW = (256 + KS - 1) / KS;
    const float* slab = part + (size_t)j * KS * 65536;
    const int cg = (tid & 31) * 8, r1 = (q * RPW + RPW < 256) ? q * RPW + RPW : 256;
    for (int r = q * RPW + (tid >> 5); r < r1; r += 16) {
        const int row = u.pm * 256 + r; const int tok = row_tok[row]; const float g = row_gate[row] * sc;
        if (tok >= 0) {
            f32x4 a[KS][2];
#pragma unroll
            for (int k = 0; k < KS; ++k) { a[k][0] = *(const f32x4*)(slab + (size_t)k * 65536 + r * 256 + cg); a[k][1] = *(const f32x4*)(slab + (size_t)k * 65536 + r * 256 + cg + 4); }
            float h[8]; unpack8(*(const u32x4*)(hin + (size_t)tok * D + u.pn * 256 + cg), h);
            f32x4 s0 = a[0][0], s1 = a[0][1];
#pragma unroll
            for (int k = 1; k < KS; ++k) { s0 += a[k][0]; s1 += a[k][1]; }
#pragma unroll
            for (int e = 0; e < 4; ++e) { h[e] += g * s0[e]; h[4 + e] += g * s1[e]; }
            *(u32x4*)(hout + (size_t)tok * D + u.pn * 256 + cg) = pack8(h);
        }
    }
}

#ifndef MOE_GU_WGM
#define MOE_GU_WGM 4
#endif
constexpr int NPHASES = 21;
__global__ void __launch_bounds__(NTHR, 2) fwd(Args args) {
    extern __shared__ __attribute__((aligned(16))) unsigned char lds[];
    Frame F;
    F.lds = (LAS unsigned char*)lds;
    F.wave = __builtin_amdgcn_readfirstlane((int)threadIdx.x >> 6);
    F.G = gridDim.x; F.wg = blockIdx.x;
    F.A = &args; F.out = args.out; F.ws = args.ws;
    volatile LAS unsigned* MISC = (volatile LAS unsigned*)(F.lds + MISC_OFF);
    if (((int)threadIdx.x) < 64) MISC[((int)threadIdx.x)] = 0u;
    __syncthreads();
    const int lo = args.ph_lo, hi = args.ph_hi;
    XcdBarrier bar; bar.bar = (unsigned*)(F.ws + WS_CTL) + CW_BAR; bar.x = 0; bar.st = nullptr;
    if (hi - lo > 1) bar = xcd_barrier_post((unsigned*)(F.ws + WS_CTL) + CW_BAR, MISC + 8);
#ifndef ONLY_PHASE
#define ONLY_PHASE -1
#endif
#define IN(k) ((ONLY_PHASE < 0 || (k) == ONLY_PHASE) && lo <= (k) && (k) < hi)
#define SEAM(k) do { if (IN(k) && IN((k) + 1)) xcd_barrier(bar); } while (0)
    unsigned char* ws = F.ws;
    bf16* HN = (bf16*)(ws + WS_HN); bf16* MIX = (bf16*)(ws + WS_MIX); bf16* PROJ = (bf16*)(ws + WS_PROJ);
    bf16* HB = (bf16*)F.out;

    if (IN(0)) { p0_prologue(F); norm_rows_phase(F, F.A->in[I_X], F.A->in[I_N1G], HN); }
    SEAM(0);
#define LAYER_MIXER(l) do { \
        constexpr int pb = 1 + (l) * 9; \
        if (IN(pb + 0)) { pg8::DenseSched S; S.init(M / 256, NIN / 256, F.G, F.wg); S.A = (const char*)HN; S.Bt = (const char*)(ws + WS_WIN) + (size_t)(l) * NIN * D * 2; S.tstep = (size_t)256 * D * 2; \
            pg8::EpiBf16 E{PROJ, NIN}; pg8::gemm_phase<pg8::EpiBf16, pg8::DenseSched, true, true>(F.lds, D, S, E); } \
        SEAM(pb + 0); \
        if (IN(pb + 1)) { s1_stage_mu(F, (l)); for (int gc = F.wg; gc < M / 64; gc += F.G) { mixc_unit(F, (l), gc); s1_chunk_prep(F, (l), gc); S1Pre pa, pb2; s1_issue(F, (l), gc, 0, pa); for (int h = 0; h < NH; h += 2) { s1_unit(F, (l), gc, h, pa, h + 1, pb2); s1_unit(F, (l), gc, h + 1, pb2, (h + 2 < NH) ? h + 2 : h + 1, pa); } LDS_BAR(); } } \
        SEAM(pb + 1); \
        if (IN(pb + 2)) { s2_phase(F, (l)); } \
        SEAM(pb + 2); \
        if (IN(pb + 3)) { s3_phase(F, (l)); } \
        SEAM(pb + 3); \
        if (IN(pb + 4)) { pg8::DenseSched S; S.init(M / 256, D / 256, F.G, F.wg); S.A = (const char*)MIX; S.Bt = (const char*)(ws + WS_WOUT) + (size_t)(l) * D * D * 2; S.tstep = (size_t)256 * D * 2; \
            if ((l) == 0) { pg8::EpiResid<true> E{(const void*)F.A->in[I_X], HB, D}; pg8::gemm_phase<pg8::EpiResid<true>, pg8::DenseSched, true, true>(F.lds, D, S, E); } \
            else { pg8::EpiResid<false> E{(const void*)HB, HB, D}; pg8::gemm_phase<pg8::EpiResid<false>, pg8::DenseSched, true, true>(F.lds, D, S, E); } } \
        SEAM(pb + 4); } while (0)
    LAYER_MIXER(0);
    {
        if (IN(6)) norm_rows_phase_b<false>(F, HB, F.A->in[I_N2G], HN);
        SEAM(6);
        if (IN(7)) { pg8::DenseSched S; S.init(M / 256, 2 * FF / 256, F.G, F.wg); S.A = (const char*)HN; S.Bt = (const char*)(ws + WS_WGU); S.tstep = (size_t)256 * D * 2;
            pg8::EpiSwiglu E{(bf16*)(ws + WS_HID), FF}; pg8::gemm_phase<pg8::EpiSwiglu, pg8::DenseSched, true, true>(F.lds, D, S, E); }
        SEAM(7);
        if (IN(8)) { pg8::DenseSched S; S.init(M / 256, D / 256, F.G, F.wg); S.A = (const char*)(ws + WS_HID); S.Bt = (const char*)(ws + WS_WDN); S.tstep = (size_t)256 * FF * 2;
            pg8::EpiResid<false> E{(const void*)HB, HB, D}; pg8::gemm_phase<pg8::EpiResid<false>, pg8::DenseSched, true, true>(F.lds, FF, S, E); }
        SEAM(8);
        if (IN(9)) norm_rows_phase_b<false>(F, HB, F.A->in[I_N1G] + D, HN);
        SEAM(9);
    }
    LAYER_MIXER(1);
    if (IN(15)) norm2_router_phase(F, HB, F.A->in[I_N2G] + D, F.A->in[I_ROUTER]);
    SEAM(15);
    if (IN(16)) { moe_dispatch_phase(F); moe_weight_convert<1>(F, F.wg * NWAVES + F.wave, F.G * NWAVES, (LAS float*)(F.lds + 32768 + F.wave * 9216)); }
    SEAM(16);
    {
        const int* rowtok = (const int*)(ws + TB_ROWTOK); const float* rowgate = (const float*)(ws + TB_ROWGATE); const int* tile_e = (const int*)(ws + TB_TILEE);
        if (IN(17)) { const int nt = __builtin_amdgcn_readfirstlane(((const int*)(ws + TB_NTILES))[0] + ((const int*)(ws + TB_NTILES))[1]);
            pg8::MoeGuSched S; S.init(nt, 2 * FE / 256, F.G, F.wg); S.wgm = MOE_GU_WGM; S.A = (const char*)HN; S.Bt = (const char*)(ws + WS_WMGU); S.row_tok = rowtok; S.tile_e = tile_e;
            pg8::EpiSwigluF8 E{ws + WS_MHID, FE}; pg8::gemm_phase<pg8::EpiSwigluF8, pg8::MoeGuSched, true, true, true>(F.lds, D / 2, S, E); }
        SEAM(17);
#pragma unroll
        for (int s = 0; s < 2; ++s) {
            if (IN(18 + s)) { const int nt0 = __builtin_amdgcn_readfirstlane(((const int*)(ws + TB_NTILES))[0]), nt = s ? __builtin_amdgcn_readfirstlane(((const int*)(ws + TB_NTILES))[1]) : nt0, t0 = s ? nt0 : 0;
                const int* rt = rowtok + t0 * 256; const float* rg = rowgate + t0 * 256; const int* te = tile_e + t0; const char* hid = (const char*)(ws + WS_MHID) + (size_t)t0 * 256 * FE;
                { pg8::MoeDnSched S; S.init(nt, D / 256, F.G, F.wg); S.A = hid; S.Bt = (const char*)(ws + WS_WMDN); S.tile_e = te; S.tstep = (size_t)256 * FE;
                  pg8::EpiMoeDown E{HB, (s == 0) ? HB : HN, rt, rg, F8_DN_INV}; pg8::gemm_phase<pg8::EpiMoeDown, pg8::MoeDnSched, true, true, true>(F.lds, FE / 2, S, E); }
                { pg8::MoeDnLeftSched S; S.init(nt, D / 256, F.G, F.wg); S.A = hid; S.Bt = (const char*)(ws + WS_WMDN); S.tile_e = te; S.tstep = (size_t)256 * FE;
                  float* part = (float*)(ws + WS_PART); unsigned* cnt = (unsigned*)(ws + WS_CTL) + CW_LEFT + s * 32 * 64;
                  pg8::EpiPartTile E{part + (size_t)F.wg * 65536};
                  pg8::gemm_phase<pg8::EpiPartTile, pg8::MoeDnLeftSched, true, true, true>(F.lds, FE / 2, S, E, pg8::DN_KT);
                  moe_dn_combine(F.wg, nt, F.G, part, cnt, HB, (s == 0) ? HB : HN, rt, rg, F8_DN_INV); } }
            SEAM(18 + s);
        }
    }
    if (IN(20)) norm_rows_phase_b<true>(F, HN, F.A->in[I_FINALG], F.out);
#undef IN
#undef SEAM
}

extern "C" void kernel_launch(void* const* d_in, const int* in_sizes, int n_in, void* d_out, int out_size, void* d_ws, size_t ws_size, hipStream_t stream) {
    static int ready = 0;
    if (ready == 0) {
        if (n_in != 33 || out_size != M * D || ws_size < WS_NEED) { fprintf(stderr, "kernel_launch: unexpected shapes (n_in %d, out %d, ws %zu, need %zu)\n", n_in, out_size, ws_size, (size_t)WS_NEED); ready = -1; return; }
        if (hipFuncSetAttribute((const void*)fwd, hipFuncAttributeMaxDynamicSharedMemorySize, LDS_BYTES) != hipSuccess) { fprintf(stderr, "kernel_launch: hipFuncSetAttribute failed\n"); ready = -1; return; }
        int per_cu = 0; (void)hipOccupancyMaxActiveBlocksPerMultiprocessor(&per_cu, (const void*)fwd, NTHR, LDS_BYTES); (void)hipGetLastError();
        if (per_cu < 1) fprintf(stderr, "kernel_launch: occupancy query reports %d\n", per_cu);
        ready = 1;
    }
    if (ready < 0) return;
    (void)hipMemsetAsync((char*)d_ws + WS_CTL, 0, CTL_ZERO_BYTES, stream);
    Args a{};
    for (int i = 0; i < 33; ++i) a.in[i] = (const float*)d_in[i];
    a.out = (float*)d_out; a.ws = (unsigned char*)d_ws;
#if N_LAUNCH_MODE == 1
    a.ph_lo = 0; a.ph_hi = NPHASES;
    hipLaunchKernelGGL(fwd, dim3(GRID), dim3(NTHR), LDS_BYTES, stream, a);
#else
    for (int p = 0; p < NPHASES; ++p) { a.ph_lo = p; a.ph_hi = p + 1; const int reps = ((PROBE_PHASES >> p) & 1u) ? 2 : 1;
        for (int r = 0; r < reps; ++r) hipLaunchKernelGGL(fwd, dim3(GRID), dim3(NTHR), LDS_BYTES, stream, a); }
#endif
    (void)in_sizes;
}
```
